# Optimizing an MI355X kernel written in HIP

```python
import jax, jax.numpy as jnp
from jax import lax
import numpy as np

D_MODEL = 1024
BATCH = 8
SEQ = 2048
DEPTH = 2

GRID_W = 64
CTX_LEN = 256
EPS = 1e-6
ATTN_Q_BLOCK = 128

NA_HEADS = 4
NA_HEAD_DIM = 64
NA_WIN_H = 8
NA_WIN_W = 16
NA_WIDTH = NA_HEADS * NA_HEAD_DIM

MLA_HEADS = 4
MLA_Q_RANK = 256
MLA_KV_RANK = 128
MLA_NOPE_DIM = 64
MLA_ROPE_DIM = 32
MLA_V_DIM = 64
MLA_WIDTH = MLA_HEADS * MLA_V_DIM
ROPE_THETA = 10000.0

GLA_HEADS = 4
GLA_DK = 64
GLA_DV = 128
GLA_KW = GLA_HEADS * GLA_DK
GLA_VW = GLA_HEADS * GLA_DV
GLA_GATE_RANK = 16
GLA_TAU = 16.0
GLA_CHUNK = 64

N_BRANCH = 3
N_EXPERTS = 16
EXPERT_FF = 1024
EC_CAPACITY = 2

IN_SIZES = (NA_WIDTH, NA_WIDTH, NA_WIDTH,
            MLA_Q_RANK, MLA_KV_RANK, MLA_ROPE_DIM,
            GLA_KW, GLA_KW, GLA_VW, GLA_GATE_RANK, GLA_GATE_RANK, GLA_VW,
            D_MODEL, D_MODEL, D_MODEL)
D_IN = sum(IN_SIZES)

kernel_name = 'hybrid_na_mla_gla_ec_diffusion_block'


def rms_norm(x, g):
    xf = x.astype(jnp.float32)
    y = xf * lax.rsqrt(jnp.mean(xf * xf, axis=-1, keepdims=True) + EPS)
    return (y * g.astype(jnp.float32)).astype(x.dtype)


def modulate(h, shift, scale):
    return h * (1 + scale) + shift


def split_cols(z, sizes):
    parts, off = [], 0
    for s in sizes:
        parts.append(z[..., off:off + s])
        off += s
    return parts


def to_heads(z, n_heads):
    B, T, W = z.shape
    return z.reshape(B, T, n_heads, W // n_heads).transpose(0, 2, 1, 3)


def from_heads(z):
    B, H, T, d = z.shape
    return z.transpose(0, 2, 1, 3).reshape(B, T, H * d)


def axial_rope(x, rows, cols):
    half = x.shape[-1] // 2
    quarter = half // 2
    inv_freq = ROPE_THETA ** (-jnp.arange(quarter, dtype=jnp.float32) / quarter)

    def rot(xa, p):
        ang = p.astype(jnp.float32)[:, None] * inv_freq
        cos = jnp.cos(ang).astype(x.dtype)
        sin = jnp.sin(ang).astype(x.dtype)
        x1, x2 = xa[..., :quarter], xa[..., quarter:]
        return jnp.concatenate([x1 * cos - x2 * sin, x1 * sin + x2 * cos], axis=-1)

    return jnp.concatenate([rot(x[..., :half], rows), rot(x[..., half:], cols)], axis=-1)


def block_attention(q, k, v):
    B, H, T, dq = q.shape
    nb = T // ATTN_Q_BLOCK
    scale = dq ** -0.5
    qb = q.reshape(B, H, nb, ATTN_Q_BLOCK, dq).transpose(2, 0, 1, 3, 4)

    def one_block(qi):
        s = jnp.einsum('bhqd,bhkd->bhqk', qi, k).astype(jnp.float32) * scale
        p = jax.nn.softmax(s, axis=-1).astype(v.dtype)
        return jnp.einsum('bhqk,bhkd->bhqd', p, v)

    o = lax.map(one_block, qb)
    return o.transpose(1, 2, 0, 3, 4).reshape(B, H, T, v.shape[-1])


def neighbourhood_attention(q, k, v, k_ctx, v_ctx, rpb):
    B, H, T, dh = q.shape
    rows = T // GRID_W
    kh = min(NA_WIN_H, rows)
    kw = NA_WIN_W
    scale = dh ** -0.5
    qg = q.reshape(B, H, rows, GRID_W, dh)
    kg = k.reshape(B, H, rows, GRID_W, dh)
    vg = v.reshape(B, H, rows, GRID_W, dh)
    col = jnp.arange(GRID_W)
    col_start = jnp.clip(col - kw // 2, 0, GRID_W - kw)
    col_idx = col_start[:, None] + jnp.arange(kw)[None, :]
    col_off = col_idx - col[:, None] + (NA_WIN_W - 1)
    rpb_c = rpb[:, :, col_off]

    def one_row(r):
        rs = jnp.clip(r - kh // 2, 0, rows - kh)
        kb = lax.dynamic_slice_in_dim(kg, rs, kh, axis=2)[:, :, :, col_idx, :]
        vb = lax.dynamic_slice_in_dim(vg, rs, kh, axis=2)[:, :, :, col_idx, :]
        qr = lax.dynamic_index_in_dim(qg, r, axis=2, keepdims=False)
        s_loc = jnp.einsum('bhcd,bhicjd->bhcij', qr, kb).astype(jnp.float32) * scale
        row_off = rs + jnp.arange(kh) - r + (NA_WIN_H - 1)
        bias = jnp.take(rpb_c, row_off, axis=1).transpose(0, 2, 1, 3)
        s_loc = s_loc + bias[None].astype(jnp.float32)
        s_ctx = jnp.einsum('bhcd,bhnd->bhcn', qr, k_ctx).astype(jnp.float32) * scale
        s = jnp.concatenate([s_loc.reshape(B, H, GRID_W, kh * kw), s_ctx], axis=-1)
        p = jax.nn.softmax(s, axis=-1).astype(v.dtype)
        p_loc = p[..., :kh * kw].reshape(B, H, GRID_W, kh, kw)
        p_ctx = p[..., kh * kw:]
        return (jnp.einsum('bhcij,bhicjd->bhcd', p_loc, vb)
                + jnp.einsum('bhcn,bhnd->bhcd', p_ctx, v_ctx))

    o = lax.map(one_row, jnp.arange(rows))
    return o.transpose(1, 2, 0, 3, 4).reshape(B, H, T, dh)


def mla_heads(dq, dkv, kr, q_norm, w_uq, kv_norm, w_ukv, pos):
    B, T, _ = dq.shape
    qh = (rms_norm(dq, q_norm) @ w_uq).reshape(B, T, MLA_HEADS, MLA_NOPE_DIM + MLA_ROPE_DIM).transpose(0, 2, 1, 3)
    q_nope, q_rope = qh[..., :MLA_NOPE_DIM], qh[..., MLA_NOPE_DIM:]
    kvh = (rms_norm(dkv, kv_norm) @ w_ukv).reshape(B, T, MLA_HEADS, MLA_NOPE_DIM + MLA_V_DIM).transpose(0, 2, 1, 3)
    k_nope, v = kvh[..., :MLA_NOPE_DIM], kvh[..., MLA_NOPE_DIM:]
    k_rope = kr[:, None]
    if pos is not None:
        q_rope = axial_rope(q_rope, pos[0], pos[1])
        k_rope = axial_rope(k_rope, pos[0], pos[1])
    k_rope = jnp.broadcast_to(k_rope, (B, MLA_HEADS, T, MLA_ROPE_DIM))
    q = jnp.concatenate([q_nope, q_rope], axis=-1)
    k = jnp.concatenate([k_nope, k_rope], axis=-1)
    return q, k, v


def gla_log_decay(a_low, w2, b2):
    z = (a_low @ w2 + b2).astype(jnp.float32)
    return to_heads(jax.nn.log_sigmoid(z) / GLA_TAU, GLA_HEADS)


def gla_heads(q, k, v, a_f, a_b, w_af, b_af, w_ab, b_ab):
    return (to_heads(q, GLA_HEADS), to_heads(k, GLA_HEADS), to_heads(v, GLA_HEADS),
            gla_log_decay(a_f, w_af, b_af), gla_log_decay(a_b, w_ab, b_ab))


def gla_chunked(q, k, v, g, s0):
    B, H, T, dk = q.shape
    dv = v.shape[-1]
    C = GLA_CHUNK
    N = T // C
    qf = q.astype(jnp.float32).reshape(B, H, N, C, dk) * dk ** -0.5
    kf = k.astype(jnp.float32).reshape(B, H, N, C, dk)
    vf = v.astype(jnp.float32).reshape(B, H, N, C, dv)
    b = jnp.cumsum(g.reshape(B, H, N, C, dk), axis=3)
    b_last = b[:, :, :, -1:, :]
    q_dec = qf * jnp.exp(b)
    k_dec = kf * jnp.exp(-b)
    k_to_end = kf * jnp.exp(b_last - b)
    mask = jnp.tril(jnp.ones((C, C), dtype=bool))
    a = jnp.where(mask, jnp.einsum('bhntd,bhnsd->bhnts', q_dec, k_dec), 0.0)
    o_intra = jnp.einsum('bhnts,bhnsv->bhntv', a, vf)
    kv_chunk = jnp.einsum('bhnsd,bhnsv->bhndv', k_to_end, vf)
    decay = jnp.exp(b_last[:, :, :, 0, :])

    def step(s, inp):
        dec, kv = inp
        return dec[..., None] * s + kv, s

    s_fin, s_prev = lax.scan(step, s0, (jnp.moveaxis(decay, 2, 0), jnp.moveaxis(kv_chunk, 2, 0)))
    o_inter = jnp.einsum('bhntd,bhndv->bhntv', q_dec, jnp.moveaxis(s_prev, 0, 2))
    o = (o_intra + o_inter).reshape(B, H, T, dv)
    return o.astype(v.dtype), s_fin


def gla_bidirectional(qc, kc, vc, gfc, gbc, ql, kl, vl, gfl, gbl):
    B, H, _, dk = qc.shape
    s0 = jnp.zeros((B, H, dk, vc.shape[-1]), jnp.float32)
    rev = lambda u: jnp.flip(u, axis=2)
    oc_f, sc_f = gla_chunked(qc, kc, vc, gfc, s0)
    oc_b, sc_b = gla_chunked(rev(qc), rev(kc), rev(vc), rev(gbc), s0)
    ol_f, _ = gla_chunked(ql, kl, vl, gfl, sc_f)
    ol_b, _ = gla_chunked(rev(ql), rev(kl), rev(vl), rev(gbl), sc_b)
    return ol_f + rev(ol_b), oc_f + rev(oc_b)


def gla_output(o, og, o_norm):
    return from_heads(rms_norm(o, o_norm)) * jax.nn.silu(og)


def gated_merge(o_a, o_b, o_c, m_a, m_b, m_c, w_br_a, w_br_b, w_br_c, w_out):
    y = (jax.nn.sigmoid(m_a) * (o_a @ w_br_a)
         + jax.nn.sigmoid(m_b) * (o_b @ w_br_b)
         + jax.nn.sigmoid(m_c) * (o_c @ w_br_c))
    return y @ w_out


def expert_choice_moe(h, w_router, w_gate, w_up, w_down):
    B, T, D = h.shape
    cap = EC_CAPACITY * T // N_EXPERTS
    aff = jax.nn.softmax((h @ w_router).astype(jnp.float32), axis=-1)
    top_w, top_idx = lax.top_k(aff.transpose(0, 2, 1), cap)
    xg = jax.vmap(lambda hb, ib: hb[ib])(h, top_idx)
    hid = jax.nn.silu(jnp.einsum('becd,edf->becf', xg, w_gate)) * jnp.einsum('becd,edf->becf', xg, w_up)
    ye = jnp.einsum('becf,efd->becd', hid, w_down) * top_w[..., None].astype(h.dtype)
    return jax.vmap(lambda ib, yb: jnp.zeros((T, D), h.dtype).at[ib.reshape(-1)].add(yb.reshape(-1, D)))(top_idx, ye)


def hybrid_layer(x, ctx, c, c_ctx, ada_w, ada_b, norm1, norm2, w_in, na_rpb,
                 mla_q_norm, mla_w_uq, mla_kv_norm, mla_w_ukv,
                 gla_w_af, gla_b_af, gla_w_ab, gla_b_ab, gla_o_norm,
                 w_br_a, w_br_b, w_br_c, w_out,
                 moe_router, moe_w_gate, moe_w_up, moe_w_down, ctx_out):
    B, T, D = x.shape
    L = ctx.shape[1]
    t = jnp.arange(T)
    pos = (t // GRID_W, t % GRID_W)
    mod_l = [m[:, None, :] for m in jnp.split(jax.nn.silu(c) @ ada_w + ada_b, 6, axis=-1)]
    mod_c = jnp.split(jax.nn.silu(c_ctx) @ ada_w + ada_b, 6, axis=-1)

    h_l = modulate(rms_norm(x, norm1), mod_l[0], mod_l[1])
    h_c = modulate(rms_norm(ctx, norm1), mod_c[0], mod_c[1])
    z = jnp.concatenate([h_c, h_l], axis=1) @ w_in
    zc = split_cols(z[:, :L], IN_SIZES)
    zl = split_cols(z[:, L:], IN_SIZES)

    qa_l, ka_l, va_l = (to_heads(u, NA_HEADS) for u in zl[0:3])
    qa_c, ka_c, va_c = (to_heads(u, NA_HEADS) for u in zc[0:3])
    oa_l = from_heads(neighbourhood_attention(qa_l, ka_l, va_l, ka_c, va_c, na_rpb))

    qb_l, kb_l, vb_l = mla_heads(zl[3], zl[4], zl[5], mla_q_norm, mla_w_uq, mla_kv_norm, mla_w_ukv, pos)
    qb_c, kb_c, vb_c = mla_heads(zc[3], zc[4], zc[5], mla_q_norm, mla_w_uq, mla_kv_norm, mla_w_ukv, None)
    ob_l = from_heads(block_attention(qb_l, jnp.concatenate([kb_c, kb_l], axis=2),
                                      jnp.concatenate([vb_c, vb_l], axis=2)))

    gc = gla_heads(zc[6], zc[7], zc[8], zc[9], zc[10], gla_w_af, gla_b_af, gla_w_ab, gla_b_ab)
    gl = gla_heads(zl[6], zl[7], zl[8], zl[9], zl[10], gla_w_af, gla_b_af, gla_w_ab, gla_b_ab)
    oc_l_raw, oc_c_raw = gla_bidirectional(*gc, *gl)
    oc_l = gla_output(oc_l_raw, zl[11], gla_o_norm)

    y_l = gated_merge(oa_l, ob_l, oc_l, zl[12], zl[13], zl[14], w_br_a, w_br_b, w_br_c, w_out)
    x = x + mod_l[2] * y_l
    x = x + mod_l[5] * expert_choice_moe(modulate(rms_norm(x, norm2), mod_l[3], mod_l[4]),
                                         moe_router, moe_w_gate, moe_w_up, moe_w_down)

    if ctx_out:
        oa_c = from_heads(block_attention(qa_c, ka_c, va_c))
        ob_c = from_heads(block_attention(qb_c, kb_c, vb_c))
        oc_c = gla_output(oc_c_raw, zc[11], gla_o_norm)
        y_c = gated_merge(oa_c, ob_c, oc_c, zc[12], zc[13], zc[14], w_br_a, w_br_b, w_br_c, w_out)
        ctx = ctx + mod_c[2] * y_c
        ctx = ctx + mod_c[5] * expert_choice_moe(modulate(rms_norm(ctx, norm2), mod_c[3], mod_c[4]),
                                                 moe_router, moe_w_gate, moe_w_up, moe_w_down)
    return x, ctx


def setup_inputs(seed: int = 0) -> dict:
    key = jax.random.key(seed)
    ks = iter(jax.random.split(key, 32))

    def nrm(shape, std):
        return jax.random.normal(next(ks), shape, jnp.float32) * std

    def gain(shape):
        return 1.0 + nrm(shape, 0.02)

    D = D_MODEL
    return {
        'x': nrm((BATCH, SEQ, D), 1.0),
        'c': nrm((BATCH, D), 1.0),
        'ctx': nrm((BATCH, CTX_LEN, D), 1.0),
        'c_ctx': nrm((D,), 1.0),
        'ada_w': nrm((DEPTH, D, 6 * D), 0.5 * D ** -0.5),
        'ada_b': nrm((DEPTH, 6 * D), 0.01),
        'norm1': gain((DEPTH, D)),
        'norm2': gain((DEPTH, D)),
        'w_in': nrm((DEPTH, D, D_IN), D ** -0.5),
        'na_rpb': nrm((DEPTH, NA_HEADS, 2 * NA_WIN_H - 1, 2 * NA_WIN_W - 1), 0.1),
        'mla_q_norm': gain((DEPTH, MLA_Q_RANK)),
        'mla_w_uq': nrm((DEPTH, MLA_Q_RANK, MLA_HEADS * (MLA_NOPE_DIM + MLA_ROPE_DIM)), MLA_Q_RANK ** -0.5),
        'mla_kv_norm': gain((DEPTH, MLA_KV_RANK)),
        'mla_w_ukv': nrm((DEPTH, MLA_KV_RANK, MLA_HEADS * (MLA_NOPE_DIM + MLA_V_DIM)), MLA_KV_RANK ** -0.5),
        'gla_w_af': nrm((DEPTH, GLA_GATE_RANK, GLA_KW), GLA_GATE_RANK ** -0.5),
        'gla_b_af': 1.0 + nrm((DEPTH, GLA_KW), 0.5),
        'gla_w_ab': nrm((DEPTH, GLA_GATE_RANK, GLA_KW), GLA_GATE_RANK ** -0.5),
        'gla_b_ab': 1.0 + nrm((DEPTH, GLA_KW), 0.5),
        'gla_o_norm': gain((DEPTH, GLA_DV)),
        'w_br_a': nrm((DEPTH, NA_WIDTH, D), NA_WIDTH ** -0.5),
        'w_br_b': nrm((DEPTH, MLA_WIDTH, D), MLA_WIDTH ** -0.5),
        'w_br_c': nrm((DEPTH, GLA_VW, D), GLA_VW ** -0.5),
        'w_out': nrm((DEPTH, D, D), D ** -0.5),
        'moe_router': nrm((DEPTH, D, N_EXPERTS), D ** -0.5),
        'moe_w_gate': nrm((DEPTH, N_EXPERTS, D, EXPERT_FF), D ** -0.5),
        'moe_w_up': nrm((DEPTH, N_EXPERTS, D, EXPERT_FF), D ** -0.5),
        'moe_w_down': nrm((DEPTH, N_EXPERTS, EXPERT_FF, D), EXPERT_FF ** -0.5),
        'final_norm': gain((D,)),
    }


def reference(x, c, ctx, c_ctx, ada_w, ada_b, norm1, norm2, w_in, na_rpb,
              mla_q_norm, mla_w_uq, mla_kv_norm, mla_w_ukv,
              gla_w_af, gla_b_af, gla_w_ab, gla_b_ab, gla_o_norm,
              w_br_a, w_br_b, w_br_c, w_out,
              moe_router, moe_w_gate, moe_w_up, moe_w_down, final_norm):
    for l in range(DEPTH):
        x, ctx = hybrid_layer(x, ctx, c, c_ctx, ada_w[l], ada_b[l], norm1[l], norm2[l], w_in[l], na_rpb[l],
                              mla_q_norm[l], mla_w_uq[l], mla_kv_norm[l], mla_w_ukv[l],
                              gla_w_af[l], gla_b_af[l], gla_w_ab[l], gla_b_ab[l], gla_o_norm[l],
                              w_br_a[l], w_br_b[l], w_br_c[l], w_out[l],
                              moe_router[l], moe_w_gate[l], moe_w_up[l], moe_w_down[l],
                              ctx_out=(l < DEPTH - 1))
    return rms_norm(x, final_norm)
```

```cpp
#ifndef EMU
#include <hip/hip_runtime.h>
#include <hip/hip_cooperative_groups.h>
#include <cstdio>
#endif
#include <stdint.h>

#ifndef MK_ONE_LAUNCH
#define MK_ONE_LAUNCH 0
#endif

#ifdef EMU_SMALL
constexpr int D_MODEL = 256, BATCH = 2, SEQ = 1024, CTX_LEN = 128, N_EXPERTS = 4, EXPERT_FF = 256;
#else
constexpr int D_MODEL = 1024, BATCH = 8, SEQ = 2048, CTX_LEN = 256, N_EXPERTS = 16, EXPERT_FF = 1024;
#endif
constexpr int DEPTH = 2, GRID_W = 64, ROWS = SEQ / GRID_W;
constexpr int D = D_MODEL, D6 = 6 * D, FF = EXPERT_FF, NE = N_EXPERTS;
constexpr int NTOK = CTX_LEN + SEQ;
constexpr int MTOT = BATCH * NTOK;
constexpr int NCH = NTOK / 64, NCC = CTX_LEN / 64;
constexpr int ZQA = 0, ZKA = 256, ZVA = 512, ZDQ = 768, ZDKV = 1024, ZKR = 1152, ZGQ = 1184, ZGK = 1440, ZGV = 1696, ZAF = 2208, ZAB = 2224, ZOG = 2240, ZMA = 2752;
constexpr int D_IN = 2752 + 3 * D;
constexpr int D_IN_PAD = (D_IN + 127) / 128 * 128;
constexpr int CAPL = 2 * SEQ / NE, CAPC = 2 * CTX_LEN / NE;
constexpr int RPE_L = BATCH * CAPL, RPE_C = BATCH * CAPC, RPE = RPE_L + RPE_C;
constexpr float EPS = 1e-6f;
constexpr int NTHR = 512;
static_assert(ROWS >= 8 && NTOK % 128 == 0 && CTX_LEN % 128 == 0 && RPE_L % 128 == 0 && RPE_C % 128 == 0 && D % 128 == 0 && FF % 128 == 0, "shape");

constexpr size_t al256(size_t x) { return (x + 255) / 256 * 256; }
constexpr size_t WS_BAR = 0;
constexpr size_t WS_BAR_BYTES = 16384;
constexpr size_t WS_MOD = WS_BAR + WS_BAR_BYTES;
constexpr size_t WS_CCUR = WS_MOD + al256((size_t)DEPTH * (BATCH + 1) * D6 * 4);
constexpr size_t WS_H = WS_CCUR + al256((size_t)BATCH * CTX_LEN * D * 4);
constexpr size_t WS_Z = WS_H + al256((size_t)MTOT * D * 2);
constexpr size_t WS_Z_BYTES = al256((size_t)MTOT * D_IN_PAD * 2);
static_assert((size_t)NE * RPE * FF * 2 <= WS_Z_BYTES, "hid alias");
constexpr size_t WS_WIN = WS_Z + WS_Z_BYTES;
constexpr size_t WS_WUQ = WS_WIN + al256((size_t)DEPTH * D_IN_PAD * D * 2);
constexpr size_t WS_WUKV = WS_WUQ + al256((size_t)DEPTH * 384 * 256 * 2);
constexpr size_t WS_WBR = WS_WUKV + al256((size_t)DEPTH * 512 * 128 * 2);
constexpr size_t WS_WOUT = WS_WBR + al256((size_t)DEPTH * D * 1024 * 2);
constexpr size_t WS_EXP = WS_WOUT + al256((size_t)DEPTH * D * D * 2);
constexpr size_t EXP_WGU = 0;
constexpr size_t EXP_WD = al256((size_t)NE * 2 * FF * D * 2);
constexpr size_t EXP_BYTES = EXP_WD + al256((size_t)NE * D * FF * 2);
constexpr size_t GLA_KV = 0;
constexpr size_t GLA_DEC = al256((size_t)BATCH * 4 * 2 * NCH * 64 * 128 * 4);
constexpr size_t GLA_SP = GLA_DEC + al256((size_t)BATCH * 4 * 2 * NCH * 64 * 4);
constexpr size_t GLA_BYTES = GLA_SP + al256((size_t)BATCH * 4 * 2 * NCH * 64 * 128 * 2);
constexpr size_t WS_EXP_BYTES = EXP_BYTES > GLA_BYTES ? EXP_BYTES : GLA_BYTES;
constexpr size_t WS_MQ = WS_EXP + WS_EXP_BYTES;
constexpr size_t WS_MK = WS_MQ + al256((size_t)BATCH * 4 * NTOK * 96 * 2);
constexpr size_t WS_MVT = WS_MK + al256((size_t)BATCH * 4 * NTOK * 96 * 2);
constexpr size_t WS_NAVT = WS_MVT + al256((size_t)BATCH * 4 * 64 * NTOK * 2);
constexpr size_t WS_GVT = WS_NAVT + al256((size_t)BATCH * 4 * 64 * NTOK * 2);
constexpr size_t WS_OCAT = WS_GVT + al256((size_t)BATCH * 4 * 128 * NTOK * 2);
constexpr size_t WS_AFF = WS_OCAT + al256((size_t)MTOT * 1024 * 2);
constexpr size_t WS_RMAP = WS_AFF + al256((size_t)MTOT * NE * 4);
constexpr size_t WS_SLW = WS_RMAP + al256((size_t)NE * RPE * 4);
constexpr size_t WS_TOTAL_BYTES = WS_SLW + al256((size_t)NE * RPE * 4);

typedef unsigned short bf16_t;
typedef short bf16x8 __attribute__((ext_vector_type(8)));
typedef float f32x4 __attribute__((ext_vector_type(4)));
typedef uint32_t U4 __attribute__((ext_vector_type(4)));
typedef uint32_t U2 __attribute__((ext_vector_type(2)));
#define DEV __device__ __forceinline__
#ifdef EMU
DEV int ltid() { return (int)threadIdx.x; }
#else
DEV int ltid() { int t = (int)threadIdx.x; asm volatile("" : "+v"(t)); return t; }
#endif

DEV float bf2f(bf16_t h) { return __builtin_bit_cast(float, (uint32_t)h << 16); }
DEV bf16_t f2bf(float f) { uint32_t u = __builtin_bit_cast(uint32_t, f); u += 0x7FFFu + ((u >> 16) & 1u); return (bf16_t)(u >> 16); }
DEV uint32_t pack2(float a, float b) { return (uint32_t)f2bf(a) | ((uint32_t)f2bf(b) << 16); }
DEV float sigmoidf_(float x) { return 1.0f / (1.0f + __expf(-x)); }
DEV float siluf_(float x) { return x * sigmoidf_(x); }
DEV float logsigmoidf_(float x) { return fminf(x, 0.0f) - log1pf(__expf(-fabsf(x))); }

#ifdef EMU
#define WAVE_SYNC() emu_wave_sync()
#else
#define WAVE_SYNC() do { asm volatile("s_waitcnt lgkmcnt(0)" ::: "memory"); __builtin_amdgcn_wave_barrier(); } while (0)
#endif

struct Params { const float* in[28]; float* out; char* ws; int ph_lo, ph_hi; };
enum { I_X = 0, I_C, I_CTX, I_CCTX, I_ADAW, I_ADAB, I_NORM1, I_NORM2, I_WIN, I_RPB, I_QNORM, I_WUQ, I_KVNORM, I_WUKV, I_WAF, I_BAF, I_WAB, I_BAB, I_ONORM,
       I_WBRA, I_WBRB, I_WBRC, I_WOUT, I_ROUTER, I_WGATE, I_WUP, I_WDOWN, I_FNORM };

#ifndef EMU
#define XB_TMO      128
#define XB_XCNT(j)  (256  + 64 * (j))
#define XB_XSUB(j)  (1280 + 64 * (j))
#define XB_XGEN(j)  (2304 + 64 * (j))
#define XB_TOP      3328
#define XB_TOPGEN   3392
#define XCD_BAR_WORDS 3456
#define XB_SPIN_CAP (1u << 22)
#define LAS __attribute__((address_space(3)))
DEV unsigned xb_ld(unsigned* p)              { return __hip_atomic_load(p, __ATOMIC_RELAXED, __HIP_MEMORY_SCOPE_AGENT); }
DEV unsigned xb_add(unsigned* p, unsigned v) { return __hip_atomic_fetch_add(p, v, __ATOMIC_RELAXED, __HIP_MEMORY_SCOPE_AGENT); }
DEV unsigned xb_xcc_id() { return (unsigned)__builtin_amdgcn_s_getreg((3 << 11) | 20) & 0xFu; }
#define XB_SPIN(cond, bar) do { unsigned _sp = 0; while (cond) { __builtin_amdgcn_s_sleep(1); \
    if ((++_sp & 255u) == 0u) { if (xb_ld(&(bar)[XB_TMO])) break; if (_sp > XB_SPIN_CAP) { atomicAdd(&(bar)[XB_TMO], 1u); break; } } } } while (0)
struct XcdBarrier { unsigned* bar; unsigned x; volatile LAS unsigned* st; };
DEV XcdBarrier xcd_barrier_post(unsigned* bar, volatile LAS unsigned* st) {
    XcdBarrier b; b.bar = bar; b.x = xb_xcc_id(); b.st = st;
    if (ltid() == 0) (void)xb_add(&bar[XB_XCNT(b.x)], 1u);
    return b;
}
DEV void xcd_barrier_complete(unsigned* bar, unsigned x, unsigned& nloc, unsigned& nx) {
    const unsigned G = gridDim.x * gridDim.y * gridDim.z;
    unsigned sum, cnt, mine, sp = 0u;
    for (;;) {
        sum = 0u; cnt = 0u; mine = 0u;
#pragma unroll
        for (unsigned j = 0; j < 16; ++j) { const unsigned c = xb_ld(&bar[XB_XCNT(j)]); sum += c; cnt += (c > 0u) ? 1u : 0u; mine = (j == x) ? c : mine; }
        if (sum == G) break;
        __builtin_amdgcn_s_sleep(1);
        if ((++sp & 255u) == 0u) { if (xb_ld(&bar[XB_TMO])) break; if (sp > XB_SPIN_CAP) { atomicAdd(&bar[XB_TMO], 1u); break; } }
    }
    nloc = mine > 0u ? mine : 1u; nx = cnt > 0u ? cnt : 1u;
}
DEV void xcd_barrier(const XcdBarrier& b) {
    asm volatile("s_waitcnt vmcnt(0)" ::: "memory");
    __syncthreads();
    if (ltid() == 0) {
        unsigned* bar = b.bar;
        __builtin_amdgcn_s_waitcnt(0);
        unsigned nloc = b.st[0], nx = b.st[1];
        if (nloc == 0u) { xcd_barrier_complete(bar, b.x, nloc, nx); b.st[0] = nloc; b.st[1] = nx; }
        const unsigned old = xb_add(&bar[XB_XSUB(b.x)], 1u);
        const unsigned gen = old / nloc;
        if (old + 1u == (gen + 1u) * nloc) {
            __builtin_amdgcn_fence(__ATOMIC_RELEASE, "agent");
            asm volatile("s_waitcnt vmcnt(0)" ::: "memory");
            const unsigned og = xb_add(&bar[XB_TOP], 1u);
            const unsigned tg = og / nx;
            if (og + 1u == (tg + 1u) * nx) xb_add(&bar[XB_TOPGEN], 1u);
            else XB_SPIN(xb_ld(&bar[XB_TOPGEN]) == tg, bar);
            __builtin_amdgcn_fence(__ATOMIC_ACQUIRE, "agent");
            xb_add(&bar[XB_XGEN(b.x)], 1u);
            asm volatile("s_waitcnt vmcnt(0)" ::: "memory");
        } else {
            XB_SPIN(xb_ld(&bar[XB_XGEN(b.x)]) == gen, bar);
            __builtin_amdgcn_fence(__ATOMIC_ACQUIRE, "agent");
            asm volatile("s_waitcnt vmcnt(0)" ::: "memory");
        }
    }
    __syncthreads();
}
#endif

constexpr int LDS_BYTES = 147456;
constexpr int LDS_MISC = LDS_BYTES - 64;
constexpr int GS = 72;

DEV void gemm_mainloop(f32x4 (&acc)[4][2], char* smem, const bf16_t* pa0, const bf16_t* pa1, const bf16_t* pb0, const bf16_t* pb1, int kbeg, int kend) {
    bf16_t* As = (bf16_t*)smem; bf16_t* Bs = (bf16_t*)(smem + 128 * GS * 2);
    const int tid = ltid(), lane = tid & 63, wave = tid >> 6, wr = wave >> 2, wc = wave & 3;
    const int lrow = tid >> 3, lcol = (tid & 7) * 8;
    U4 ra0 = *(const U4*)(pa0 + kbeg), ra1 = *(const U4*)(pa1 + kbeg), rb0 = *(const U4*)(pb0 + kbeg), rb1 = *(const U4*)(pb1 + kbeg);
    for (int k0 = kbeg; k0 < kend; k0 += 64) {
        __syncthreads();
        *(U4*)(As + lrow * GS + lcol) = ra0; *(U4*)(As + (lrow + 64) * GS + lcol) = ra1;
        *(U4*)(Bs + lrow * GS + lcol) = rb0; *(U4*)(Bs + (lrow + 64) * GS + lcol) = rb1;
        __syncthreads();
        if (k0 + 64 < kend) { ra0 = *(const U4*)(pa0 + k0 + 64); ra1 = *(const U4*)(pa1 + k0 + 64); rb0 = *(const U4*)(pb0 + k0 + 64); rb1 = *(const U4*)(pb1 + k0 + 64); }
#pragma unroll
        for (int kk = 0; kk < 2; ++kk) {
            bf16x8 a[4], b[2];
#pragma unroll
            for (int mi = 0; mi < 4; ++mi) a[mi] = *(const bf16x8*)(As + (wr * 64 + mi * 16 + (lane & 15)) * GS + kk * 32 + (lane >> 4) * 8);
#pragma unroll
            for (int ni = 0; ni < 2; ++ni) b[ni] = *(const bf16x8*)(Bs + (wc * 32 + ni * 16 + (lane & 15)) * GS + kk * 32 + (lane >> 4) * 8);
#pragma unroll
            for (int mi = 0; mi < 4; ++mi)
#pragma unroll
                for (int ni = 0; ni < 2; ++ni) acc[mi][ni] = __builtin_amdgcn_mfma_f32_16x16x32_bf16(a[mi], b[ni], acc[mi][ni], 0, 0, 0);
        }
    }
}
DEV void acc_zero(f32x4 (&acc)[4][2]) {
#pragma unroll
    for (int mi = 0; mi < 4; ++mi)
#pragma unroll
        for (int ni = 0; ni < 2; ++ni) acc[mi][ni] = f32x4{0.f, 0.f, 0.f, 0.f};
}

#ifdef EMU
static Params emu_params;
DEV const Params* KP() { return &emu_params; }
#else
typedef const Params __attribute__((address_space(4))) CParams;
DEV CParams* KP() { CParams* p = (CParams*)__builtin_amdgcn_kernarg_segment_ptr(); asm volatile("" : "+s"(p)); return p; }
#endif
struct Ctx {
    char* smem; int layer;
    DEV const float* in(int i) const { return KP()->in[i]; }
    DEV float* out() const { return KP()->out; }
    DEV char* ws() const { return KP()->ws; }
    DEV float* mod(int l, int brow) const { return (float*)(ws() + WS_MOD) + ((size_t)l * (BATCH + 1) + brow) * D6; }
};

DEV void p0_mod_item(const Ctx& c, int item) {
    const int l = item / (D6 / 64), cc = item % (D6 / 64);
    float* sc = (float*)c.smem;
    float* red = sc + (BATCH + 1) * D;
    const int tid = ltid();
    __syncthreads();
    for (int i = tid; i < (BATCH + 1) * D; i += NTHR) { int r = i / D, k = i % D; float v = (r < BATCH) ? c.in(I_C)[r * D + k] : c.in(I_CCTX)[k]; sc[i] = siluf_(v); }
    __syncthreads();
    const int col = tid & 63, kg = tid >> 6;
    const float* W = c.in(I_ADAW) + (size_t)l * D * D6 + cc * 64 + col;
    typedef float f32x16 __attribute__((ext_vector_type(16)));
    static_assert(BATCH + 1 <= 16, "mod rows");
    f32x16 a = {0.f, 0.f, 0.f, 0.f, 0.f, 0.f, 0.f, 0.f, 0.f, 0.f, 0.f, 0.f, 0.f, 0.f, 0.f, 0.f};
    for (int k = kg; k < D; k += 8) { float w = W[(size_t)k * D6];
#pragma unroll
        for (int r = 0; r <= BATCH; ++r) a[r] += sc[r * D + k] * w; }
#pragma unroll
    for (int r = 0; r <= BATCH; ++r) red[(kg * (BATCH + 1) + r) * 64 + col] = a[r];
    __syncthreads();
    for (int i = tid; i < (BATCH + 1) * 64; i += NTHR) { int r = i / 64, cl = i % 64; float s = 0.f;
        for (int g = 0; g < 8; ++g) s += red[(g * (BATCH + 1) + r) * 64 + cl];
        c.mod(l, r)[cc * 64 + cl] = s + c.in(I_ADAB)[(size_t)l * D6 + cc * 64 + cl]; }
}

template <class Map> DEV void convT_tile(char* smem, const float* src, int sstride, const float* gain, bf16_t* dst, int dstride, int n0, int k0, Map map) {
    float* t = (float*)smem;
    const int tid = ltid();
    __syncthreads();
    for (int i = tid; i < 4096; i += NTHR) { int k = i >> 6, n = i & 63; int sc = map(n0 + n); float v = 0.f; if (sc >= 0) { v = src[(size_t)(k0 + k) * sstride + sc]; if (gain) v *= gain[k0 + k]; } t[k * 65 + n] = v; }
    __syncthreads();
    { int n = tid >> 3, kc = (tid & 7) * 8; U4 o;
      o.x = pack2(t[(kc + 0) * 65 + n], t[(kc + 1) * 65 + n]); o.y = pack2(t[(kc + 2) * 65 + n], t[(kc + 3) * 65 + n]);
      o.z = pack2(t[(kc + 4) * 65 + n], t[(kc + 5) * 65 + n]); o.w = pack2(t[(kc + 6) * 65 + n], t[(kc + 7) * 65 + n]);
      *(U4*)(dst + (size_t)(n0 + n) * dstride + k0 + kc) = o; }
}
DEV int rope_perm32(int j) { int blk = j >> 3; blk = (blk == 1) ? 2 : (blk == 2) ? 1 : blk; return blk * 8 + (j & 7); }
struct MapWin { DEV int operator()(int n) const { if (n >= D_IN) return -1; if (n >= ZKR && n < ZKR + 32) return ZKR + rope_perm32(n - ZKR); return n; } };
struct MapUq { DEV int operator()(int n) const { int h = n / 96, w = n % 96; return (w < 64) ? n : h * 96 + 64 + rope_perm32(w - 64); } };
struct MapId { DEV int operator()(int n) const { return n; } };
struct MapGU { int which; DEV int operator()(int r) const { int q = r >> 5, w = r & 31; if (which == 0) return (w < 16) ? 16 * q + w : -2; return (w >= 16) ? 16 * q + w - 16 : -2; } };

constexpr int CW_WIN = (D_IN_PAD / 64) * (D / 64), CW_UQ = 6 * 4, CW_UKV = 8 * 2, CW_BRA = (D / 64) * 4, CW_BRC = (D / 64) * 8, CW_OUT = (D / 64) * (D / 64);
constexpr int CW_PER_LAYER = CW_WIN + CW_UQ + CW_UKV + 2 * CW_BRA + CW_BRC + CW_OUT;
DEV void p0_convw_item(const Ctx& c, int item) {
    const int l = item / CW_PER_LAYER; int r = item % CW_PER_LAYER;
    if (r < CW_WIN) { int tn = r / (D / 64), tk = r % (D / 64);
        convT_tile(c.smem, c.in(I_WIN) + (size_t)l * D * D_IN, D_IN, nullptr, (bf16_t*)(c.ws() + WS_WIN) + (size_t)l * D_IN_PAD * D, D, tn * 64, tk * 64, MapWin()); return; }
    r -= CW_WIN;
    if (r < CW_UQ) { int tn = r / 4, tk = r % 4;
        convT_tile(c.smem, c.in(I_WUQ) + (size_t)l * 256 * 384, 384, c.in(I_QNORM) + l * 256, (bf16_t*)(c.ws() + WS_WUQ) + (size_t)l * 384 * 256, 256, tn * 64, tk * 64, MapUq()); return; }
    r -= CW_UQ;
    if (r < CW_UKV) { int tn = r / 2, tk = r % 2;
        convT_tile(c.smem, c.in(I_WUKV) + (size_t)l * 128 * 512, 512, c.in(I_KVNORM) + l * 128, (bf16_t*)(c.ws() + WS_WUKV) + (size_t)l * 512 * 128, 128, tn * 64, tk * 64, MapId()); return; }
    r -= CW_UKV;
    bf16_t* wbr = (bf16_t*)(c.ws() + WS_WBR) + (size_t)l * D * 1024;
    if (r < CW_BRA) { int tn = r / 4, tk = r % 4; convT_tile(c.smem, c.in(I_WBRA) + (size_t)l * 256 * D, D, nullptr, wbr, 1024, tn * 64, tk * 64, MapId()); return; }
    r -= CW_BRA;
    if (r < CW_BRA) { int tn = r / 4, tk = r % 4; convT_tile(c.smem, c.in(I_WBRB) + (size_t)l * 256 * D, D, nullptr, wbr + 256, 1024, tn * 64, tk * 64, MapId()); return; }
    r -= CW_BRA;
    if (r < CW_BRC) { int tn = r / 8, tk = r % 8; convT_tile(c.smem, c.in(I_WBRC) + (size_t)l * 512 * D, D, nullptr, wbr + 512, 1024, tn * 64, tk * 64, MapId()); return; }
    r -= CW_BRC;
    { int tn = r / (D / 64), tk = r % (D / 64); convT_tile(c.smem, c.in(I_WOUT) + (size_t)l * D * D, D, nullptr, (bf16_t*)(c.ws() + WS_WOUT) + (size_t)l * D * D, D, tn * 64, tk * 64, MapId()); }
}
constexpr int CE_GU = (2 * FF / 64) * (D / 64), CE_D = (D / 64) * (FF / 64), CE_PER_E = CE_GU + CE_D, CE_ITEMS = NE * CE_PER_E;
DEV void convexp_item(const Ctx& c, int l, int item) {
    const int e = item / CE_PER_E; int r = item % CE_PER_E;
    if (r < CE_GU) { int tn = r / (D / 64), tk = r % (D / 64);
        float* t = (float*)c.smem; const int tid = ltid();
        const float* g = c.in(I_WGATE) + ((size_t)l * NE + e) * D * FF; const float* u = c.in(I_WUP) + ((size_t)l * NE + e) * D * FF;
        __syncthreads();
        for (int i = tid; i < 4096; i += NTHR) { int k = i >> 6, n = i & 63; int rr = tn * 64 + n, q = rr >> 5, w = rr & 31;
            float v = (w < 16) ? g[(size_t)(tk * 64 + k) * FF + 16 * q + w] : u[(size_t)(tk * 64 + k) * FF + 16 * q + w - 16]; t[k * 65 + n] = v; }
        __syncthreads();
        { int n = tid >> 3, kc = (tid & 7) * 8; U4 o;
          o.x = pack2(t[(kc + 0) * 65 + n], t[(kc + 1) * 65 + n]); o.y = pack2(t[(kc + 2) * 65 + n], t[(kc + 3) * 65 + n]);
          o.z = pack2(t[(kc + 4) * 65 + n], t[(kc + 5) * 65 + n]); o.w = pack2(t[(kc + 6) * 65 + n], t[(kc + 7) * 65 + n]);
          *(U4*)((bf16_t*)(c.ws() + WS_EXP + EXP_WGU) + ((size_t)e * 2 * FF + tn * 64 + n) * D + tk * 64 + kc) = o; }
        return; }
    r -= CE_GU;
    { int tn = r / (FF / 64), tk = r % (FF / 64);
      convT_tile(c.smem, c.in(I_WDOWN) + ((size_t)l * NE + e) * FF * D, D, nullptr, (bf16_t*)(c.ws() + WS_EXP + EXP_WD) + (size_t)e * D * FF, FF, tn * 64, tk * 64, MapId()); }
}

DEV const float* xrow_src(const Ctx& c, int grow) {
    const int b = grow / NTOK, p = grow % NTOK;
    if (p < CTX_LEN) return (c.layer == 0 ? c.in(I_CTX) : (const float*)(c.ws() + WS_CCUR)) + ((size_t)b * CTX_LEN + p) * D;
    return (c.layer == 0 ? c.in(I_X) : (const float*)c.out()) + ((size_t)b * SEQ + (p - CTX_LEN)) * D;
}
DEV float* xrow_dst(const Ctx& c, int grow) {
    const int b = grow / NTOK, p = grow % NTOK;
    if (p < CTX_LEN) return (float*)(c.ws() + WS_CCUR) + ((size_t)b * CTX_LEN + p) * D;
    return c.out() + ((size_t)b * SEQ + (p - CTX_LEN)) * D;
}
DEV float wave_sum(float v) { for (int m = 1; m < 64; m <<= 1) v += __shfl_xor(v, m); return v; }

DEV void p1_norm_row(const Ctx& c, int grow) {
    const int lane = ltid() & 63, l = c.layer;
    const int b = grow / NTOK, p = grow % NTOK;
    const float* x = xrow_src(c, grow);
    const float* md = c.mod(l, p < CTX_LEN ? BATCH : b);
    const float* g = c.in(I_NORM1) + l * D;
    float ss = 0.f;
    for (int cc = lane * 4; cc < D; cc += 256) { f32x4 v = *(const f32x4*)(x + cc); ss += v[0] * v[0] + v[1] * v[1] + v[2] * v[2] + v[3] * v[3]; }
    ss = wave_sum(ss);
    const float r = rsqrtf(ss / D + EPS);
    bf16_t* h = (bf16_t*)(c.ws() + WS_H) + (size_t)grow * D;
    for (int cc = lane * 4; cc < D; cc += 256) { f32x4 v = *(const f32x4*)(x + cc); float o[4];
#pragma unroll
        for (int i = 0; i < 4; ++i) o[i] = v[i] * r * g[cc + i] * (1.f + md[D + cc + i]) + md[cc + i];
        U2 pk; pk.x = pack2(o[0], o[1]); pk.y = pack2(o[2], o[3]); *(U2*)(h + cc) = pk; }
}

constexpr int P2_TN = D_IN_PAD / 128, P2_TILES = (MTOT / 128) * P2_TN;
DEV void p2_tile(const Ctx& c, int tile) {
    const int tm = tile / P2_TN, tn = tile % P2_TN, m0 = tm * 128, n0 = tn * 128, l = c.layer;
    const int tid = ltid(), lane = tid & 63, wave = tid >> 6, wr = wave >> 2, wc = wave & 3;
    const bf16_t* A = (const bf16_t*)(c.ws() + WS_H); const bf16_t* Bt = (const bf16_t*)(c.ws() + WS_WIN) + (size_t)l * D_IN_PAD * D;
    const int lrow = tid >> 3, lcol = (tid & 7) * 8;
    f32x4 acc[4][2]; acc_zero(acc);
    gemm_mainloop(acc, c.smem, A + (size_t)(m0 + lrow) * D + lcol, A + (size_t)(m0 + lrow + 64) * D + lcol, Bt + (size_t)(n0 + lrow) * D + lcol, Bt + (size_t)(n0 + lrow + 64) * D + lcol, 0, D);
    bf16_t* Z = (bf16_t*)(c.ws() + WS_Z);
    const int b = m0 / NTOK, pbase = m0 % NTOK;
#pragma unroll
    for (int ni = 0; ni < 2; ++ni) {
        const int colb = n0 + wc * 32 + ni * 16;
        const int col = colb + (lane & 15);
        if (colb >= D_IN) continue;
        if (colb >= ZVA && colb < ZDQ) {
            const int hh = (col - ZVA) >> 6, dd = (col - ZVA) & 63;
            bf16_t* vt = (bf16_t*)(c.ws() + WS_NAVT) + (((size_t)b * 4 + hh) * 64 + dd) * NTOK + pbase;
#pragma unroll
            for (int mi = 0; mi < 4; ++mi) { int rl = wr * 64 + mi * 16 + (lane >> 4) * 4; U2 pk; pk.x = pack2(acc[mi][ni][0], acc[mi][ni][1]); pk.y = pack2(acc[mi][ni][2], acc[mi][ni][3]); *(U2*)(vt + rl) = pk; }
        } else if (colb >= ZGV && colb < ZAF) {
            const int hh = (col - ZGV) >> 7, dd = (col - ZGV) & 127;
            bf16_t* vt = (bf16_t*)(c.ws() + WS_GVT) + (((size_t)b * 4 + hh) * 128 + dd) * NTOK + pbase;
#pragma unroll
            for (int mi = 0; mi < 4; ++mi) { int rl = wr * 64 + mi * 16 + (lane >> 4) * 4; U2 pk; pk.x = pack2(acc[mi][ni][0], acc[mi][ni][1]); pk.y = pack2(acc[mi][ni][2], acc[mi][ni][3]); *(U2*)(vt + rl) = pk; }
        } else {
#pragma unroll
            for (int mi = 0; mi < 4; ++mi)
#pragma unroll
                for (int j = 0; j < 4; ++j) { int row = m0 + wr * 64 + mi * 16 + (lane >> 4) * 4 + j; Z[(size_t)row * D_IN_PAD + col] = f2bf(acc[mi][ni][j]); }
        }
    }
}

DEV void rowscale_to_lds(char* smem, const bf16_t* A, int lda, int m0, int K) {
    float* rs = (float*)(smem + 2 * 128 * GS * 2);
    const int tid = ltid(), r = tid >> 2, part = tid & 3;
    const bf16_t* a = A + (size_t)(m0 + r) * lda + part * (K / 4);
    float ss = 0.f;
    for (int k = 0; k < K / 4; k += 8) { U4 v = *(const U4*)(a + k);
#pragma unroll
        for (int i = 0; i < 4; ++i) { float lo = bf2f((bf16_t)(v[i] & 0xFFFF)), hi = bf2f((bf16_t)(v[i] >> 16)); ss += lo * lo + hi * hi; } }
    ss += __shfl_xor(ss, 1); ss += __shfl_xor(ss, 2);
    __syncthreads();
    if (part == 0) rs[r] = rsqrtf(ss / K + EPS);
    __syncthreads();
}
constexpr int MT_ALL = MTOT / 128;
constexpr int MT_LAT = BATCH * (SEQ / 128);
DEV int lat_tile_m0(int t) { int b = t / (SEQ / 128), w = t % (SEQ / 128); return b * NTOK + CTX_LEN + w * 128; }

DEV void p3_qup_tile(const Ctx& c, int m0, int tn) {
    const int n0 = tn * 128, l = c.layer;
    const int tid = ltid(), lane = tid & 63, wave = tid >> 6, wr = wave >> 2, wc = wave & 3;
    const bf16_t* A = (const bf16_t*)(c.ws() + WS_Z) + ZDQ; const bf16_t* Bt = (const bf16_t*)(c.ws() + WS_WUQ) + (size_t)l * 384 * 256;
    const int lrow = tid >> 3, lcol = (tid & 7) * 8;
    rowscale_to_lds(c.smem, A, D_IN_PAD, m0, 256);
    const float* rs = (const float*)(c.smem + 2 * 128 * GS * 2);
    f32x4 acc[4][2]; acc_zero(acc);
    gemm_mainloop(acc, c.smem, A + (size_t)(m0 + lrow) * D_IN_PAD + lcol, A + (size_t)(m0 + lrow + 64) * D_IN_PAD + lcol, Bt + (size_t)(n0 + lrow) * 256 + lcol, Bt + (size_t)(n0 + lrow + 64) * 256 + lcol, 0, 256);
    const int b = m0 / NTOK, pbase = m0 % NTOK;
    const int cb = n0 + wc * 32;
    const int hh = cb / 96, wofs = cb % 96;
    bf16_t* Q = (bf16_t*)(c.ws() + WS_MQ) + ((size_t)b * 4 + hh) * NTOK * 96;
    const float qscale = 0.10206207261596575f;
    const int i8 = lane & 7;
    const float invf = __expf(-(float)i8 * (9.210340371976184f / 8.0f));
#pragma unroll
    for (int mi = 0; mi < 4; ++mi)
#pragma unroll
        for (int j = 0; j < 4; ++j) {
            const int rl = wr * 64 + mi * 16 + (lane >> 4) * 4 + j, p = pbase + rl;
            const float r = rs[rl] * qscale;
            float v0 = acc[mi][0][j] * r, v1 = acc[mi][1][j] * r;
            if (wofs == 64 && p >= CTX_LEN) {
                const int t = p - CTX_LEN; const float pos = (float)(((lane & 15) < 8) ? (t / GRID_W) : (t % GRID_W));
                const float ang = pos * invf, cs = cosf(ang), sn = sinf(ang);
                const float o0 = v0 * cs - v1 * sn, o1 = v0 * sn + v1 * cs; v0 = o0; v1 = o1;
            }
            Q[(size_t)p * 96 + wofs + (lane & 15)] = f2bf(v0);
            Q[(size_t)p * 96 + wofs + 16 + (lane & 15)] = f2bf(v1);
        }
}
DEV void p3_kvup_tile(const Ctx& c, int m0, int tn) {
    const int n0 = tn * 128, l = c.layer;
    const int tid = ltid(), lane = tid & 63, wave = tid >> 6, wr = wave >> 2, wc = wave & 3;
    const bf16_t* A = (const bf16_t*)(c.ws() + WS_Z) + ZDKV; const bf16_t* Bt = (const bf16_t*)(c.ws() + WS_WUKV) + (size_t)l * 512 * 128;
    const int lrow = tid >> 3, lcol = (tid & 7) * 8;
    rowscale_to_lds(c.smem, A, D_IN_PAD, m0, 128);
    const float* rs = (const float*)(c.smem + 2 * 128 * GS * 2);
    f32x4 acc[4][2]; acc_zero(acc);
    gemm_mainloop(acc, c.smem, A + (size_t)(m0 + lrow) * D_IN_PAD + lcol, A + (size_t)(m0 + lrow + 64) * D_IN_PAD + lcol, Bt + (size_t)(n0 + lrow) * 128 + lcol, Bt + (size_t)(n0 + lrow + 64) * 128 + lcol, 0, 128);
    const int b = m0 / NTOK, pbase = m0 % NTOK, hh = tn;
    bf16_t* Kp = (bf16_t*)(c.ws() + WS_MK) + ((size_t)b * 4 + hh) * NTOK * 96;
    bf16_t* Vt = (bf16_t*)(c.ws() + WS_MVT) + ((size_t)b * 4 + hh) * 64 * NTOK;
#pragma unroll
    for (int ni = 0; ni < 2; ++ni) {
        const int cl = wc * 32 + ni * 16 + (lane & 15);
#pragma unroll
        for (int mi = 0; mi < 4; ++mi) {
            const int rl0 = wr * 64 + mi * 16 + (lane >> 4) * 4;
            if (wc < 2) {
#pragma unroll
                for (int j = 0; j < 4; ++j) Kp[(size_t)(pbase + rl0 + j) * 96 + cl] = f2bf(acc[mi][ni][j] * rs[rl0 + j]);
            } else {
                U2 pk; pk.x = pack2(acc[mi][ni][0] * rs[rl0], acc[mi][ni][1] * rs[rl0 + 1]); pk.y = pack2(acc[mi][ni][2] * rs[rl0 + 2], acc[mi][ni][3] * rs[rl0 + 3]);
                *(U2*)(Vt + (size_t)(cl - 64) * NTOK + pbase + rl0) = pk;
            }
        }
    }
}
DEV void p3_krope_item(const Ctx& c, int item) {
    const int tid = ltid(), grow = item * 16 + (tid >> 5), j = tid & 31;
    const int b = grow / NTOK, p = grow % NTOK;
    const bf16_t* z = (const bf16_t*)(c.ws() + WS_Z) + (size_t)grow * D_IN_PAD + ZKR;
    float v = bf2f(z[j]);
    if (p >= CTX_LEN) {
        const float other = bf2f(z[j ^ 16]);
        const int t = p - CTX_LEN; const float pos = (float)(((j & 15) < 8) ? (t / GRID_W) : (t % GRID_W));
        const float invf = __expf(-(float)(j & 7) * (9.210340371976184f / 8.0f));
        const float ang = pos * invf, cs = cosf(ang), sn = sinf(ang);
        v = (j < 16) ? (v * cs - other * sn) : (other * sn + v * cs);
    }
    const bf16_t o = f2bf(v);
#pragma unroll
    for (int hh = 0; hh < 4; ++hh) ((bf16_t*)(c.ws() + WS_MK))[(((size_t)b * 4 + hh) * NTOK + p) * 96 + 64 + j] = o;
}

struct FlashSt { f32x4 o[4]; float m[4]; float l[4]; };
DEV void flash_init(FlashSt& s) {
#pragma unroll
    for (int i = 0; i < 4; ++i) { s.o[i] = f32x4{0.f, 0.f, 0.f, 0.f}; s.m[i] = -1e30f; s.l[i] = 0.f; }
}
struct NaLoc { const float* rpb; int r, rs, i0, cb, cw0; };
template <int NKQ, bool LOCAL> DEV void flash_chunk(FlashSt& st, const bf16x8 (&q)[NKQ], const bf16_t* k0, const bf16_t* k1, int kstride,
                                                     const bf16_t* vt0, const bf16_t* vt1, int vtstride, bf16_t* pl, float scale, const NaLoc& na) {
    const int lane = ltid() & 63, lr = lane & 15, lq = lane >> 4;
    f32x4 s[4];
#pragma unroll
    for (int nt = 0; nt < 4; ++nt) {
        s[nt] = f32x4{0.f, 0.f, 0.f, 0.f};
        const bf16_t* kb = ((nt < 2) ? k0 : k1) + (size_t)((nt & 1) * 16 + lr) * kstride + lq * 8;
#pragma unroll
        for (int ks = 0; ks < NKQ; ++ks) { bf16x8 kf = *(const bf16x8*)(kb + ks * 32); s[nt] = __builtin_amdgcn_mfma_f32_16x16x32_bf16(q[ks], kf, s[nt], 0, 0, 0); }
    }
    float mx[4];
#pragma unroll
    for (int j = 0; j < 4; ++j) mx[j] = -1e30f;
#pragma unroll
    for (int nt = 0; nt < 4; ++nt)
#pragma unroll
        for (int j = 0; j < 4; ++j) {
            float v = s[nt][j] * scale;
            if (LOCAL) {
                const int c = na.cb * 16 + lq * 4 + j; int cs = c - 8; cs = cs < 0 ? 0 : (cs > GRID_W - 16 ? GRID_W - 16 : cs);
                const int kc = na.cw0 + (nt & 1) * 16 + lr, kr = na.rs + na.i0 + (nt >> 1);
                if (kc >= cs && kc < cs + 16) v += na.rpb[(kr - na.r + 7) * 31 + (kc - c + 15)]; else v = -1e30f;
            }
            s[nt][j] = v; mx[j] = fmaxf(mx[j], v);
        }
    float alpha[4];
#pragma unroll
    for (int j = 0; j < 4; ++j) {
        float v = mx[j]; v = fmaxf(v, __shfl_xor(v, 1)); v = fmaxf(v, __shfl_xor(v, 2)); v = fmaxf(v, __shfl_xor(v, 4)); v = fmaxf(v, __shfl_xor(v, 8));
        const float mn = fmaxf(st.m[j], v); alpha[j] = __expf(st.m[j] - mn); st.m[j] = mn;
    }
    float rsum[4] = {0.f, 0.f, 0.f, 0.f};
#pragma unroll
    for (int nt = 0; nt < 4; ++nt)
#pragma unroll
        for (int j = 0; j < 4; ++j) { const bf16_t pb = f2bf(__expf(s[nt][j] - st.m[j])); rsum[j] += bf2f(pb); pl[(lq * 4 + j) * GS + nt * 16 + lr] = pb; }
#pragma unroll
    for (int j = 0; j < 4; ++j) st.l[j] = st.l[j] * alpha[j] + rsum[j];
#pragma unroll
    for (int dt = 0; dt < 4; ++dt)
#pragma unroll
        for (int j = 0; j < 4; ++j) st.o[dt][j] *= alpha[j];
    WAVE_SYNC();
#pragma unroll
    for (int ks = 0; ks < 2; ++ks) {
        const bf16x8 pa = *(const bf16x8*)(pl + lr * GS + ks * 32 + lq * 8);
        const bf16_t* vb = (ks == 0 ? vt0 : vt1) + lq * 8;
#pragma unroll
        for (int dt = 0; dt < 4; ++dt) { bf16x8 vf = *(const bf16x8*)(vb + (size_t)(dt * 16 + lr) * vtstride); st.o[dt] = __builtin_amdgcn_mfma_f32_16x16x32_bf16(pa, vf, st.o[dt], 0, 0, 0); }
    }
    WAVE_SYNC();
}
DEV void flash_finish_store(FlashSt& st, bf16_t* out, int ostride) {
    const int lane = ltid() & 63, lr = lane & 15, lq = lane >> 4;
#pragma unroll
    for (int j = 0; j < 4; ++j) { float v = st.l[j]; v += __shfl_xor(v, 1); v += __shfl_xor(v, 2); v += __shfl_xor(v, 4); v += __shfl_xor(v, 8); const float inv = 1.0f / v;
#pragma unroll
        for (int dt = 0; dt < 4; ++dt) out[(size_t)(lq * 4 + j) * ostride + dt * 16 + lr] = f2bf(st.o[dt][j] * inv); }
}

constexpr int NA_LAT_ITEMS = BATCH * 4 * ROWS * 4, NA_CTX_ITEMS = BATCH * 4 * (CTX_LEN / 16);
DEV void p3_na_item(const Ctx& c, int item, bf16_t* pl) {
    const int lane = ltid() & 63, lr = lane & 15, lq = lane >> 4, l = c.layer;
    const bf16_t* Z = (const bf16_t*)(c.ws() + WS_Z);
    FlashSt st; flash_init(st); NaLoc na{};
    if (item < NA_LAT_ITEMS) {
        const int cb = item & 3, r = (item >> 2) % ROWS, hh = ((item >> 2) / ROWS) & 3, b = (item >> 2) / ROWS / 4;
        int rs = r - 4; rs = rs < 0 ? 0 : (rs > ROWS - 8 ? ROWS - 8 : rs);
        int cw0 = cb * 16 - 8; cw0 = cw0 < 0 ? 0 : (cw0 > GRID_W - 32 ? GRID_W - 32 : cw0);
        const size_t tok0 = (size_t)b * NTOK;
        const int q0 = CTX_LEN + r * GRID_W + cb * 16;
        bf16x8 q[2];
#pragma unroll
        for (int ks = 0; ks < 2; ++ks) q[ks] = *(const bf16x8*)(Z + (tok0 + q0 + lr) * D_IN_PAD + ZQA + hh * 64 + ks * 32 + lq * 8);
        const bf16_t* Kb = Z + tok0 * D_IN_PAD + ZKA + hh * 64;
        const bf16_t* Vt = (const bf16_t*)(c.ws() + WS_NAVT) + ((size_t)b * 4 + hh) * 64 * NTOK;
        na.rpb = c.in(I_RPB) + ((size_t)l * 4 + hh) * 15 * 31; na.r = r; na.rs = rs; na.cb = cb; na.cw0 = cw0;
        for (int ch = 0; ch < 4; ++ch) {
            na.i0 = ch * 2;
            const int t0 = CTX_LEN + (rs + ch * 2) * GRID_W + cw0, t1 = t0 + GRID_W;
            flash_chunk<2, true>(st, q, Kb + (size_t)t0 * D_IN_PAD, Kb + (size_t)t1 * D_IN_PAD, D_IN_PAD, Vt + t0, Vt + t1, NTOK, pl, 0.125f, na);
        }
        for (int ch = 0; ch < CTX_LEN / 64; ++ch) {
            const int t0 = ch * 64, t1 = t0 + 32;
            flash_chunk<2, false>(st, q, Kb + (size_t)t0 * D_IN_PAD, Kb + (size_t)t1 * D_IN_PAD, D_IN_PAD, Vt + t0, Vt + t1, NTOK, pl, 0.125f, na);
        }
        flash_finish_store(st, (bf16_t*)(c.ws() + WS_OCAT) + (tok0 + q0) * 1024 + hh * 64, 1024);
    } else {
        const int it = item - NA_LAT_ITEMS; const int qb = it % (CTX_LEN / 16), hh = (it / (CTX_LEN / 16)) & 3, b = it / (CTX_LEN / 16) / 4;
        const size_t tok0 = (size_t)b * NTOK; const int q0 = qb * 16;
        bf16x8 q[2];
#pragma unroll
        for (int ks = 0; ks < 2; ++ks) q[ks] = *(const bf16x8*)(Z + (tok0 + q0 + lr) * D_IN_PAD + ZQA + hh * 64 + ks * 32 + lq * 8);
        const bf16_t* Kb = Z + tok0 * D_IN_PAD + ZKA + hh * 64;
        const bf16_t* Vt = (const bf16_t*)(c.ws() + WS_NAVT) + ((size_t)b * 4 + hh) * 64 * NTOK;
        for (int ch = 0; ch < CTX_LEN / 64; ++ch) {
            const int t0 = ch * 64, t1 = t0 + 32;
            flash_chunk<2, false>(st, q, Kb + (size_t)t0 * D_IN_PAD, Kb + (size_t)t1 * D_IN_PAD, D_IN_PAD, Vt + t0, Vt + t1, NTOK, pl, 0.125f, na);
        }
        flash_finish_store(st, (bf16_t*)(c.ws() + WS_OCAT) + (tok0 + q0) * 1024 + hh * 64, 1024);
    }
}
constexpr int MLA_LAT_ITEMS = BATCH * 4 * (SEQ / 16), MLA_CTX_ITEMS = BATCH * 4 * (CTX_LEN / 16);
DEV void p4_mla_item(const Ctx& c, int item, bf16_t* pl) {
    const int lane = ltid() & 63, lr = lane & 15, lq = lane >> 4;
    int b, hh, q0, nkeys;
    if (item < MLA_LAT_ITEMS) { const int qb = item % (SEQ / 16); hh = (item / (SEQ / 16)) & 3; b = item / (SEQ / 16) / 4; q0 = CTX_LEN + qb * 16; nkeys = NTOK; }
    else { const int it = item - MLA_LAT_ITEMS; const int qb = it % (CTX_LEN / 16); hh = (it / (CTX_LEN / 16)) & 3; b = it / (CTX_LEN / 16) / 4; q0 = qb * 16; nkeys = CTX_LEN; }
    const bf16_t* Q = (const bf16_t*)(c.ws() + WS_MQ) + ((size_t)b * 4 + hh) * NTOK * 96;
    const bf16_t* K = (const bf16_t*)(c.ws() + WS_MK) + ((size_t)b * 4 + hh) * NTOK * 96;
    const bf16_t* Vt = (const bf16_t*)(c.ws() + WS_MVT) + ((size_t)b * 4 + hh) * 64 * NTOK;
    bf16x8 q[3];
#pragma unroll
    for (int ks = 0; ks < 3; ++ks) q[ks] = *(const bf16x8*)(Q + (size_t)(q0 + lr) * 96 + ks * 32 + lq * 8);
    FlashSt st; flash_init(st); NaLoc na{};
    for (int t0 = 0; t0 < nkeys; t0 += 64)
        flash_chunk<3, false>(st, q, K + (size_t)t0 * 96, K + (size_t)(t0 + 32) * 96, 96, Vt + t0, Vt + t0 + 32, NTOK, pl, 1.0f, na);
    flash_finish_store(st, (bf16_t*)(c.ws() + WS_OCAT) + ((size_t)b * NTOK + q0) * 1024 + 256 + hh * 64, 1024);
}

constexpr int GL_B = 0;
constexpr int GL_W = 32768;
constexpr int GL_A = GL_W + 2 * 16 * 64 * 4 + 2 * 64 * 4;
constexpr int GL_X0 = 53248;
DEV void gla_gates(const Ctx& c, int b, int hh, int ch) {
    const int tid = ltid(), l = c.layer;
    float* bc = (float*)(c.smem + GL_B); float* w = (float*)(c.smem + GL_W); float* bias = w + 2 * 16 * 64; float* al = (float*)(c.smem + GL_A);
    const bf16_t* Z = (const bf16_t*)(c.ws() + WS_Z) + ((size_t)b * NTOK + ch * 64) * D_IN_PAD;
    __syncthreads();
    for (int i = tid; i < 2 * 16 * 64; i += NTHR) { int dir = i >> 10, rr = (i >> 6) & 15, d = i & 63; w[i] = (dir == 0 ? c.in(I_WAF) : c.in(I_WAB))[((size_t)l * 16 + rr) * 256 + hh * 64 + d]; }
    if (tid < 128) { int dir = tid >> 6, d = tid & 63; bias[tid] = (dir == 0 ? c.in(I_BAF) : c.in(I_BAB))[l * 256 + hh * 64 + d]; }
    for (int i = tid; i < 2 * 64 * 16; i += NTHR) { int dir = i >> 10, t = (i >> 4) & 63, rr = i & 15; al[i] = bf2f(Z[(size_t)t * D_IN_PAD + (dir == 0 ? ZAF : ZAB) + rr]); }
    __syncthreads();
    for (int i = tid; i < 2 * 64 * 64; i += NTHR) { int dir = i >> 12, t = (i >> 6) & 63, d = i & 63; float z = bias[dir * 64 + d];
#pragma unroll
        for (int rr = 0; rr < 16; ++rr) z += al[(dir * 64 + t) * 16 + rr] * w[(dir * 16 + rr) * 64 + d];
        bc[i] = logsigmoidf_(z) * (1.0f / 16.0f); }
    __syncthreads();
    if (tid < 128) { int dir = tid >> 6, d = tid & 63; float s = 0.f;
        if (dir == 0) { for (int t = 0; t < 64; ++t) { s += bc[(t) * 64 + d]; bc[t * 64 + d] = s; } }
        else { for (int t = 63; t >= 0; --t) { s += bc[4096 + t * 64 + d]; bc[4096 + t * 64 + d] = s; } } }
    __syncthreads();
}
constexpr int G1_ITEMS = BATCH * 4 * NCH;
DEV void p3_gla_g1_item(const Ctx& c, int item) {
    const int ch = item % NCH, hh = (item / NCH) & 3, b = item / NCH / 4;
    const int tid = ltid(), lane = tid & 63, wave = tid >> 6, lr = lane & 15, lq = lane >> 4;
    gla_gates(c, b, hh, ch);
    const float* bc = (const float*)(c.smem + GL_B);
    bf16_t* kte = (bf16_t*)(c.smem + GL_X0);
    const bf16_t* Z = (const bf16_t*)(c.ws() + WS_Z) + ((size_t)b * NTOK + ch * 64) * D_IN_PAD + ZGK + hh * 64;
    for (int i = tid; i < 2 * 64 * 64; i += NTHR) { int dir = i >> 12, s = (i >> 6) & 63, d = i & 63;
        const float bl = (dir == 0) ? bc[63 * 64 + d] : bc[4096 + d];
        kte[(dir * 64 + d) * GS + s] = f2bf(bf2f(Z[(size_t)s * D_IN_PAD + d]) * __expf(bl - bc[dir * 4096 + s * 64 + d])); }
    __syncthreads();
    const int dir = wave >> 2, mt = wave & 3;
    const bf16_t* Vt = (const bf16_t*)(c.ws() + WS_GVT) + ((size_t)b * 4 + hh) * 128 * NTOK + ch * 64;
    f32x4 acc[8];
#pragma unroll
    for (int nt = 0; nt < 8; ++nt) acc[nt] = f32x4{0.f, 0.f, 0.f, 0.f};
#pragma unroll
    for (int ks = 0; ks < 2; ++ks) {
        const bf16x8 a = *(const bf16x8*)(kte + (dir * 64 + mt * 16 + lr) * GS + ks * 32 + lq * 8);
#pragma unroll
        for (int nt = 0; nt < 8; ++nt) { bf16x8 vf = *(const bf16x8*)(Vt + (size_t)(nt * 16 + lr) * NTOK + ks * 32 + lq * 8); acc[nt] = __builtin_amdgcn_mfma_f32_16x16x32_bf16(a, vf, acc[nt], 0, 0, 0); }
    }
    float* KV = (float*)(c.ws() + WS_EXP + GLA_KV) + ((((size_t)b * 4 + hh) * 2 + dir) * NCH + ch) * 64 * 128;
#pragma unroll
    for (int nt = 0; nt < 8; ++nt)
#pragma unroll
        for (int j = 0; j < 4; ++j) KV[(size_t)(mt * 16 + lq * 4 + j) * 128 + nt * 16 + lr] = acc[nt][j];
    if (tid < 128) { int dr = tid >> 6, d = tid & 63; ((float*)(c.ws() + WS_EXP + GLA_DEC))[((((size_t)b * 4 + hh) * 2 + dr) * NCH + ch) * 64 + d] = __expf(dr == 0 ? bc[63 * 64 + d] : bc[4096 + d]); }
}
constexpr int G2_ITEMS = BATCH * 4 * 2 * 4;
DEV int gla_order_chunk(int dir, int i) { if (dir == 0) return i; return (i < NCC) ? (NCC - 1 - i) : (NCH - 1 - (i - NCC)); }
DEV void p4_gla_g2_item(const Ctx& c, int item) {
    const int vq = item & 3, seq = item >> 2, dir = seq & 1;
    const int tid = ltid(), d = tid >> 3, v0 = vq * 32 + (tid & 7) * 4;
    const float* KV = (const float*)(c.ws() + WS_EXP + GLA_KV) + (size_t)seq * NCH * 64 * 128;
    const float* DEC = (const float*)(c.ws() + WS_EXP + GLA_DEC) + (size_t)seq * NCH * 64;
    bf16_t* SP = (bf16_t*)(c.ws() + WS_EXP + GLA_SP) + (size_t)seq * NCH * 64 * 128;
    f32x4 s = f32x4{0.f, 0.f, 0.f, 0.f};
    int n = gla_order_chunk(dir, 0);
    f32x4 kv = *(const f32x4*)(KV + ((size_t)n * 64 + d) * 128 + v0); float dec = DEC[n * 64 + d];
    for (int i = 0; i < NCH; ++i) {
        f32x4 kvn = kv; float decn = dec; int nn = n;
        if (i + 1 < NCH) { nn = gla_order_chunk(dir, i + 1); kvn = *(const f32x4*)(KV + ((size_t)nn * 64 + d) * 128 + v0); decn = DEC[nn * 64 + d]; }
        U2 pk; pk.x = pack2(s[0], s[1]); pk.y = pack2(s[2], s[3]);
        *(U2*)(SP + ((size_t)n * 64 + d) * 128 + v0) = pk;
        if (dir == 1 && i == NCC - 1) { }
#pragma unroll
        for (int q = 0; q < 4; ++q) s[q] = dec * s[q] + kv[q];
        kv = kvn; dec = decn; n = nn;
    }
}
constexpr int G3_QD = GL_X0;
constexpr int G3_KD = G3_QD + 2 * 64 * GS * 2;
constexpr int G3_AM = G3_KD + 2 * 64 * GS * 2;
constexpr int G3_ST = G3_AM + 2 * 64 * GS * 2;
constexpr int G3_SS = G3_ST + 2 * 128 * GS * 2;
static_assert(G3_SS + 64 * 2 * 4 <= LDS_MISC, "lds");
DEV void p5_gla_g3_item(const Ctx& c, int b, int hh, int ch) {
    const int tid = ltid(), lane = tid & 63, wave = tid >> 6, lr = lane & 15, lq = lane >> 4, l = c.layer;
    gla_gates(c, b, hh, ch);
    const float* bc = (const float*)(c.smem + GL_B);
    bf16_t* qd = (bf16_t*)(c.smem + G3_QD); bf16_t* kd = (bf16_t*)(c.smem + G3_KD); bf16_t* am = (bf16_t*)(c.smem + G3_AM); bf16_t* stt = (bf16_t*)(c.smem + G3_ST);
    float* ssq = (float*)(c.smem + G3_SS);
    const size_t row0 = (size_t)b * NTOK + ch * 64;
    const bf16_t* Z = (const bf16_t*)(c.ws() + WS_Z) + row0 * D_IN_PAD;
    for (int i = tid; i < 2 * 64 * 64; i += NTHR) { int dir = i >> 12, t = (i >> 6) & 63, d = i & 63; const float bb = bc[i];
        qd[(dir * 64 + t) * GS + d] = f2bf(bf2f(Z[(size_t)t * D_IN_PAD + ZGQ + hh * 64 + d]) * 0.125f * __expf(bb));
        kd[(dir * 64 + t) * GS + d] = f2bf(bf2f(Z[(size_t)t * D_IN_PAD + ZGK + hh * 64 + d]) * __expf(-bb)); }
    { const bf16_t* SP = (const bf16_t*)(c.ws() + WS_EXP + GLA_SP);
      for (int i = tid; i < 2 * 64 * 32; i += NTHR) { int dir = i >> 11, d = (i >> 5) & 63, v4 = (i & 31) * 4;
          U2 pk = *(const U2*)(SP + (((((size_t)b * 4 + hh) * 2 + dir) * NCH + ch) * 64 + d) * 128 + v4);
          stt[(dir * 128 + v4 + 0) * GS + d] = (bf16_t)(pk.x & 0xFFFF); stt[(dir * 128 + v4 + 1) * GS + d] = (bf16_t)(pk.x >> 16);
          stt[(dir * 128 + v4 + 2) * GS + d] = (bf16_t)(pk.y & 0xFFFF); stt[(dir * 128 + v4 + 3) * GS + d] = (bf16_t)(pk.y >> 16); } }
    __syncthreads();
    { const int dir = wave >> 2, mt = wave & 3;
      f32x4 a4[4];
#pragma unroll
      for (int nt = 0; nt < 4; ++nt) a4[nt] = f32x4{0.f, 0.f, 0.f, 0.f};
#pragma unroll
      for (int ks = 0; ks < 2; ++ks) { const bf16x8 a = *(const bf16x8*)(qd + (dir * 64 + mt * 16 + lr) * GS + ks * 32 + lq * 8);
#pragma unroll
          for (int nt = 0; nt < 4; ++nt) { bf16x8 kf = *(const bf16x8*)(kd + (dir * 64 + nt * 16 + lr) * GS + ks * 32 + lq * 8); a4[nt] = __builtin_amdgcn_mfma_f32_16x16x32_bf16(a, kf, a4[nt], 0, 0, 0); } }
#pragma unroll
      for (int nt = 0; nt < 4; ++nt)
#pragma unroll
          for (int j = 0; j < 4; ++j) { const int t = mt * 16 + lq * 4 + j, s = nt * 16 + lr; const bool keep = (dir == 0) ? (s <= t) : (s >= t);
              am[(dir * 64 + t) * GS + s] = f2bf(keep ? a4[nt][j] : 0.f); } }
    __syncthreads();
    const int mt = wave & 3, nb = (wave >> 2) * 4;
    const bf16_t* Vt = (const bf16_t*)(c.ws() + WS_GVT) + ((size_t)b * 4 + hh) * 128 * NTOK + ch * 64;
    f32x4 o[4];
#pragma unroll
    for (int nt = 0; nt < 4; ++nt) o[nt] = f32x4{0.f, 0.f, 0.f, 0.f};
#pragma unroll
    for (int dir = 0; dir < 2; ++dir)
#pragma unroll
        for (int ks = 0; ks < 2; ++ks) {
            const bf16x8 aa = *(const bf16x8*)(am + (dir * 64 + mt * 16 + lr) * GS + ks * 32 + lq * 8);
            const bf16x8 aq = *(const bf16x8*)(qd + (dir * 64 + mt * 16 + lr) * GS + ks * 32 + lq * 8);
#pragma unroll
            for (int nt = 0; nt < 4; ++nt) {
                bf16x8 vf = *(const bf16x8*)(Vt + (size_t)((nb + nt) * 16 + lr) * NTOK + ks * 32 + lq * 8);
                o[nt] = __builtin_amdgcn_mfma_f32_16x16x32_bf16(aa, vf, o[nt], 0, 0, 0);
                bf16x8 sf = *(const bf16x8*)(stt + (dir * 128 + (nb + nt) * 16 + lr) * GS + ks * 32 + lq * 8);
                o[nt] = __builtin_amdgcn_mfma_f32_16x16x32_bf16(aq, sf, o[nt], 0, 0, 0);
            }
        }
#pragma unroll
    for (int j = 0; j < 4; ++j) { float ss = 0.f;
#pragma unroll
        for (int nt = 0; nt < 4; ++nt) ss += o[nt][j] * o[nt][j];
        ss += __shfl_xor(ss, 1); ss += __shfl_xor(ss, 2); ss += __shfl_xor(ss, 4); ss += __shfl_xor(ss, 8);
        if (lr == 0) ssq[(mt * 16 + lq * 4 + j) * 2 + (wave >> 2)] = ss; }
    __syncthreads();
    const float* on = c.in(I_ONORM) + l * 128;
    bf16_t* oc = (bf16_t*)(c.ws() + WS_OCAT) + row0 * 1024 + 512 + hh * 128;
#pragma unroll
    for (int j = 0; j < 4; ++j) { const int t = mt * 16 + lq * 4 + j; const float r = rsqrtf((ssq[t * 2] + ssq[t * 2 + 1]) * (1.0f / 128.0f) + EPS);
#pragma unroll
        for (int nt = 0; nt < 4; ++nt) { const int v = (nb + nt) * 16 + lr; const float og = bf2f(Z[(size_t)t * D_IN_PAD + ZOG + hh * 128 + v]);
            oc[(size_t)t * 1024 + v] = f2bf(o[nt][j] * r * on[v] * siluf_(og)); } }
}

DEV void p6_merge_tile(const Ctx& c, int m0, int tn) {
    const int n0 = tn * 128, l = c.layer;
    const int tid = ltid(), lane = tid & 63, wave = tid >> 6, wr = wave >> 2, wc = wave & 3;
    const bf16_t* A = (const bf16_t*)(c.ws() + WS_OCAT); const bf16_t* Bt = (const bf16_t*)(c.ws() + WS_WBR) + (size_t)l * D * 1024;
    const int lrow = tid >> 3, lcol = (tid & 7) * 8;
    const bf16_t* Z = (const bf16_t*)(c.ws() + WS_Z);
    f32x4 y[4][2]; acc_zero(y);
#pragma unroll 1
    for (int seg = 0; seg < 3; ++seg) {
        const int kb = (seg == 0) ? 0 : (seg == 1 ? 256 : 512), ke = (seg == 0) ? 256 : (seg == 1 ? 512 : 1024);
        f32x4 acc[4][2]; acc_zero(acc);
        bf16_t* gt = (bf16_t*)(c.smem + 40960);
        __syncthreads();
#pragma unroll
        for (int i = 0; i < 4; ++i) { const int ch = tid + i * NTHR, rr = ch >> 4, cc8 = (ch & 15) * 8;
            *(U4*)(gt + rr * 136 + cc8) = *(const U4*)(Z + (size_t)(m0 + rr) * D_IN_PAD + ZMA + seg * D + n0 + cc8); }
        gemm_mainloop(acc, c.smem, A + (size_t)(m0 + lrow) * 1024 + lcol, A + (size_t)(m0 + lrow + 64) * 1024 + lcol, Bt + (size_t)(n0 + lrow) * 1024 + lcol, Bt + (size_t)(n0 + lrow + 64) * 1024 + lcol, kb, ke);
        const bf16_t* gb = gt + (wr * 64 + (lane >> 4) * 4) * 136 + wc * 32 + (lane & 15);
#pragma unroll
        for (int mi = 0; mi < 4; ++mi)
#pragma unroll
            for (int ni = 0; ni < 2; ++ni)
#pragma unroll
                for (int j = 0; j < 4; ++j) y[mi][ni][j] += sigmoidf_(bf2f(gb[(mi * 16 + j) * 136 + ni * 16])) * acc[mi][ni][j];
    }
    bf16_t* Y = (bf16_t*)(c.ws() + WS_H);
#pragma unroll
    for (int mi = 0; mi < 4; ++mi)
#pragma unroll
        for (int ni = 0; ni < 2; ++ni)
#pragma unroll
            for (int j = 0; j < 4; ++j) { const int row = m0 + wr * 64 + mi * 16 + (lane >> 4) * 4 + j, col = n0 + wc * 32 + ni * 16 + (lane & 15); Y[(size_t)row * D + col] = f2bf(y[mi][ni][j]); }
}
DEV void p7_wout_tile(const Ctx& c, int m0, int tn) {
    const int n0 = tn * 128, l = c.layer;
    const int tid = ltid(), lane = tid & 63, wave = tid >> 6, wr = wave >> 2, wc = wave & 3;
    const bf16_t* A = (const bf16_t*)(c.ws() + WS_H); const bf16_t* Bt = (const bf16_t*)(c.ws() + WS_WOUT) + (size_t)l * D * D;
    const int lrow = tid >> 3, lcol = (tid & 7) * 8;
    f32x4 acc[4][2]; acc_zero(acc);
    gemm_mainloop(acc, c.smem, A + (size_t)(m0 + lrow) * D + lcol, A + (size_t)(m0 + lrow + 64) * D + lcol, Bt + (size_t)(n0 + lrow) * D + lcol, Bt + (size_t)(n0 + lrow + 64) * D + lcol, 0, D);
    const int b = m0 / NTOK, pb = m0 % NTOK;
    const float* gate = c.mod(l, pb < CTX_LEN ? BATCH : b) + 2 * D;
#pragma unroll
    for (int mi = 0; mi < 4; ++mi)
#pragma unroll
        for (int j = 0; j < 4; ++j) { const int row = m0 + wr * 64 + mi * 16 + (lane >> 4) * 4 + j; const float* xs = xrow_src(c, row); float* xd = xrow_dst(c, row);
#pragma unroll
            for (int ni = 0; ni < 2; ++ni) { const int col = n0 + wc * 32 + ni * 16 + (lane & 15); xd[col] = xs[col] + gate[col] * acc[mi][ni][j]; } }
}
DEV void p8_norm2_row(const Ctx& c, int grow) {
    const int lane = ltid() & 63, l = c.layer;
    const int b = grow / NTOK, p = grow % NTOK;
    const float* x = xrow_dst(c, grow);
    const float* md = c.mod(l, p < CTX_LEN ? BATCH : b);
    const float* g = c.in(I_NORM2) + l * D;
    const float* wr = c.in(I_ROUTER) + (size_t)l * D * NE;
    float ss = 0.f;
    for (int cc = lane * 4; cc < D; cc += 256) { f32x4 v = *(const f32x4*)(x + cc); ss += v[0] * v[0] + v[1] * v[1] + v[2] * v[2] + v[3] * v[3]; }
    ss = wave_sum(ss);
    const float r = rsqrtf(ss / D + EPS);
    bf16_t* h = (bf16_t*)(c.ws() + WS_OCAT) + (size_t)grow * D;
    float lg[NE];
#pragma unroll
    for (int e = 0; e < NE; ++e) lg[e] = 0.f;
    for (int cc = lane * 4; cc < D; cc += 256) { f32x4 v = *(const f32x4*)(x + cc); float o[4];
#pragma unroll
        for (int i = 0; i < 4; ++i) { o[i] = v[i] * r * g[cc + i] * (1.f + md[4 * D + cc + i]) + md[3 * D + cc + i];
#pragma unroll
            for (int e = 0; e < NE; ++e) lg[e] += o[i] * wr[(size_t)(cc + i) * NE + e]; }
        U2 pk; pk.x = pack2(o[0], o[1]); pk.y = pack2(o[2], o[3]); *(U2*)(h + cc) = pk; }
    float mx = -1e30f;
#pragma unroll
    for (int e = 0; e < NE; ++e) { lg[e] = wave_sum(lg[e]); mx = fmaxf(mx, lg[e]); }
    float sum = 0.f;
#pragma unroll
    for (int e = 0; e < NE; ++e) { lg[e] = expf(lg[e] - mx); sum += lg[e]; }
    const float inv = 1.0f / sum;
    float mine = 0.f;
#pragma unroll
    for (int e = 0; e < NE; ++e) if (lane == e) mine = lg[e] * inv;
    if (lane < NE) ((float*)(c.ws() + WS_AFF))[(size_t)grow * NE + lane] = mine;
}
DEV void p9_topk_item(const Ctx& c, int set, int b, int e) {
    float* v = (float*)c.smem;
    const int tid = ltid();
    const int n = set == 0 ? SEQ : CTX_LEN, cap = set == 0 ? CAPL : CAPC, p0 = set == 0 ? CTX_LEN : 0;
    const float* aff = (const float*)(c.ws() + WS_AFF) + ((size_t)b * NTOK + p0) * NE + e;
    __syncthreads();
    for (int i = tid; i < n; i += NTHR) v[i] = aff[(size_t)i * NE];
    __syncthreads();
    int* rmap = (int*)(c.ws() + WS_RMAP) + (size_t)e * RPE + (set == 0 ? b * CAPL : RPE_L + b * CAPC);
    float* slw = (float*)(c.ws() + WS_SLW) + (size_t)e * RPE + (set == 0 ? b * CAPL : RPE_L + b * CAPC);
    for (int i = tid; i < n; i += NTHR) { const float vi = v[i]; int rank = 0;
        for (int j = 0; j < n; ++j) { const float vj = v[j]; rank += (vj > vi || (vj == vi && j < i)) ? 1 : 0; }
        if (rank < cap) { rmap[rank] = b * NTOK + p0 + i; slw[rank] = vi; } }
}
DEV void p10_moe1_tile(const Ctx& c, int e, int tm, int tn) {
    const int m0 = tm * 128, n0 = tn * 128;
    const int tid = ltid(), lane = tid & 63, wave = tid >> 6, wr = wave >> 2, wc = wave & 3;
    const bf16_t* A = (const bf16_t*)(c.ws() + WS_OCAT); const bf16_t* Bt = (const bf16_t*)(c.ws() + WS_EXP + EXP_WGU) + (size_t)e * 2 * FF * D;
    const int* rmap = (const int*)(c.ws() + WS_RMAP) + (size_t)e * RPE;
    const int lrow = tid >> 3, lcol = (tid & 7) * 8;
    f32x4 acc[4][2]; acc_zero(acc);
    gemm_mainloop(acc, c.smem, A + (size_t)rmap[m0 + lrow] * D + lcol, A + (size_t)rmap[m0 + lrow + 64] * D + lcol, Bt + (size_t)(n0 + lrow) * D + lcol, Bt + (size_t)(n0 + lrow + 64) * D + lcol, 0, D);
    bf16_t* hid = (bf16_t*)(c.ws() + WS_Z) + (size_t)e * RPE * FF;
    const int hc = (n0 + wc * 32) / 2 + (lane & 15);
#pragma unroll
    for (int mi = 0; mi < 4; ++mi)
#pragma unroll
        for (int j = 0; j < 4; ++j) { const int row = m0 + wr * 64 + mi * 16 + (lane >> 4) * 4 + j; hid[(size_t)row * FF + hc] = f2bf(siluf_(acc[mi][0][j]) * acc[mi][1][j]); }
}
DEV void p11_moe2_tile(const Ctx& c, int e, int tm, int tn) {
    const int m0 = tm * 128, n0 = tn * 128, l = c.layer;
    const int tid = ltid(), lane = tid & 63, wave = tid >> 6, wr = wave >> 2, wc = wave & 3;
    const bf16_t* A = (const bf16_t*)(c.ws() + WS_Z) + (size_t)e * RPE * FF; const bf16_t* Bt = (const bf16_t*)(c.ws() + WS_EXP + EXP_WD) + (size_t)e * D * FF;
    const int* rmap = (const int*)(c.ws() + WS_RMAP) + (size_t)e * RPE; const float* slw = (const float*)(c.ws() + WS_SLW) + (size_t)e * RPE;
    const int lrow = tid >> 3, lcol = (tid & 7) * 8;
    f32x4 acc[4][2]; acc_zero(acc);
    gemm_mainloop(acc, c.smem, A + (size_t)(m0 + lrow) * FF + lcol, A + (size_t)(m0 + lrow + 64) * FF + lcol, Bt + (size_t)(n0 + lrow) * FF + lcol, Bt + (size_t)(n0 + lrow + 64) * FF + lcol, 0, FF);
#pragma unroll
    for (int mi = 0; mi < 4; ++mi)
#pragma unroll
        for (int j = 0; j < 4; ++j) { const int r = m0 + wr * 64 + mi * 16 + (lane >> 4) * 4 + j; const int tok = rmap[r]; const float w = slw[r];
            const int b = tok / NTOK, p = tok % NTOK; const float* gate = c.mod(l, p < CTX_LEN ? BATCH : b) + 5 * D; float* xd = xrow_dst(c, tok);
#pragma unroll
            for (int ni = 0; ni < 2; ++ni) { const int col = n0 + wc * 32 + ni * 16 + (lane & 15); atomicAdd(xd + col, gate[col] * w * acc[mi][ni][j]); } }
}
DEV void pf_final_row(const Ctx& c, int lrow) {
    const int lane = ltid() & 63;
    float* x = c.out() + (size_t)lrow * D; const float* g = c.in(I_FNORM);
    float ss = 0.f;
    for (int cc = lane * 4; cc < D; cc += 256) { f32x4 v = *(const f32x4*)(x + cc); ss += v[0] * v[0] + v[1] * v[1] + v[2] * v[2] + v[3] * v[3]; }
    ss = wave_sum(ss);
    const float r = rsqrtf(ss / D + EPS);
    for (int cc = lane * 4; cc < D; cc += 256) { f32x4 v = *(const f32x4*)(x + cc); f32x4 o;
#pragma unroll
        for (int i = 0; i < 4; ++i) o[i] = v[i] * r * g[cc + i];
        *(f32x4*)(x + cc) = o; }
}

constexpr int PH_PER_LAYER = 11, N_PHASES = 1 + DEPTH * PH_PER_LAYER + 1;
__global__ void __launch_bounds__(NTHR) mk_forward(Params prm) {
#ifdef EMU
    char* smem = emu_lds();
#else
    extern __shared__ __attribute__((aligned(16))) char smem[];
#endif
    Ctx c; c.smem = smem; c.layer = 0;
    const int bid = blockIdx.x, G = gridDim.x, tid = threadIdx.x;
#define wave (ltid() >> 6)
    const int lo = prm.ph_lo, hi = prm.ph_hi;
#ifdef EMU
    emu_params = prm;
#endif
#ifdef EMU
#define GRID_BAR() emu_grid_sync()
#else
    XcdBarrier bar; bar.bar = (unsigned*)(prm.ws + WS_BAR); bar.x = 0; bar.st = nullptr;
    if (hi - lo > 1) {
        if (tid < 4) ((volatile LAS unsigned*)(smem + LDS_MISC))[tid] = 0u;
        __syncthreads();
        bar = xcd_barrier_post((unsigned*)(prm.ws + WS_BAR), (volatile LAS unsigned*)(smem + LDS_MISC));
    }
#define GRID_BAR() xcd_barrier(bar)
#endif
#ifdef PH_ONLY
#define PHSEL(j) ((j) == PH_ONLY)
#elif defined(PH_SKIP)
#define PHSEL(j) ((j) != PH_SKIP)
#else
#define PHSEL(j) true
#endif
#define IN(k) (lo <= (k) && (k) < hi)
#define SEAM(k) do { if (IN(k) && IN((k) + 1)) GRID_BAR(); } while (0)
#define pl ((bf16_t*)(smem + wave * (16 * GS * 2)))

    if (PHSEL(100) && IN(0)) {
        const int n_mod = DEPTH * (D6 / 64), n_cw = DEPTH * CW_PER_LAYER;
        for (int it = bid; it < n_mod + n_cw; it += G) { if (it < n_mod) p0_mod_item(c, it); else p0_convw_item(c, it - n_mod); }
    }
    SEAM(0);
    for (int l = 0; l < DEPTH; ++l) {
        c.layer = l;
        const int P = 1 + l * PH_PER_LAYER;
        const bool ctxo = (l < DEPTH - 1);
        const int mt_n = ctxo ? MT_ALL : MT_LAT;
        if (PHSEL(0) && IN(P + 0)) { for (int it = bid; it < MTOT / 8; it += G) p1_norm_row(c, it * 8 + wave); }
        SEAM(P + 0);
        if (PHSEL(1) && IN(P + 1)) { for (int it = bid; it < P2_TILES; it += G) p2_tile(c, it); }
        SEAM(P + 1);
        if (PHSEL(2) && IN(P + 2)) {
            const int n_q = mt_n * 3, n_kv = MT_ALL * 4, n_g1 = G1_ITEMS, n_na = (NA_LAT_ITEMS + (ctxo ? NA_CTX_ITEMS : 0) + 7) / 8, n_kr = MTOT / 16;
            const int tot = n_g1 + n_q + n_kv + n_na + n_kr;
            for (int it = bid; it < tot; it += G) {
                int r = it;
                if (r < n_g1) { p3_gla_g1_item(c, r); continue; } r -= n_g1;
                if (r < n_q) { const int t = r / 3; p3_qup_tile(c, ctxo ? t * 128 : lat_tile_m0(t), r % 3); continue; } r -= n_q;
                if (r < n_kv) { p3_kvup_tile(c, (r / 4) * 128, r % 4); continue; } r -= n_kv;
                if (r < n_na) { const int wi = r * 8 + wave; __syncthreads(); if (wi < NA_LAT_ITEMS + (ctxo ? NA_CTX_ITEMS : 0)) p3_na_item(c, wi, pl); __syncthreads(); continue; } r -= n_na;
                p3_krope_item(c, r);
            }
        }
        SEAM(P + 2);
        if (PHSEL(3) && IN(P + 3)) {
            const int n_g2 = G2_ITEMS, n_att = (MLA_LAT_ITEMS + (ctxo ? MLA_CTX_ITEMS : 0)) / 8;
            for (int it = bid; it < n_g2 + n_att; it += G) {
                if (it < n_g2) { p4_gla_g2_item(c, it); continue; }
                __syncthreads(); p4_mla_item(c, (it - n_g2) * 8 + wave, pl); __syncthreads();
            }
        }
        SEAM(P + 3);
        if (PHSEL(4) && IN(P + 4)) {
            const int chs = ctxo ? NCH : (NCH - NCC);
            for (int it = bid; it < BATCH * 4 * chs; it += G) { const int ch = (it % chs) + (ctxo ? 0 : NCC), hh = (it / chs) & 3, b = it / chs / 4; p5_gla_g3_item(c, b, hh, ch); }
        }
        SEAM(P + 4);
        if (PHSEL(5) && IN(P + 5)) {
            const int n_mg = mt_n * (D / 128);
            for (int it = bid; it < n_mg + CE_ITEMS; it += G) {
                if (it < n_mg) { const int t = it / (D / 128); p6_merge_tile(c, ctxo ? t * 128 : lat_tile_m0(t), it % (D / 128)); }
                else convexp_item(c, l, it - n_mg);
            }
        }
        SEAM(P + 5);
        if (PHSEL(6) && IN(P + 6)) { for (int it = bid; it < mt_n * (D / 128); it += G) { const int t = it / (D / 128); p7_wout_tile(c, ctxo ? t * 128 : lat_tile_m0(t), it % (D / 128)); } }
        SEAM(P + 6);
        if (PHSEL(7) && IN(P + 7)) {
            if (ctxo) { for (int it = bid; it < MTOT / 8; it += G) p8_norm2_row(c, it * 8 + wave); }
            else { for (int it = bid; it < BATCH * SEQ / 8; it += G) { const int lr = it * 8 + wave; p8_norm2_row(c, (lr / SEQ) * NTOK + CTX_LEN + lr % SEQ); } }
        }
        SEAM(P + 7);
        if (PHSEL(8) && IN(P + 8)) { const int tot = BATCH * NE * (ctxo ? 2 : 1); for (int it = bid; it < tot; it += G) { const int set = it / (BATCH * NE), r = it % (BATCH * NE); p9_topk_item(c, set, r / NE, r % NE); } }
        SEAM(P + 8);
        const int mt_e = (ctxo ? RPE : RPE_L) / 128;
        if (PHSEL(9) && IN(P + 9)) { const int per_e = mt_e * (2 * FF / 128); for (int it = bid; it < NE * per_e; it += G) { const int e = it / per_e, r = it % per_e; p10_moe1_tile(c, e, r / (2 * FF / 128), r % (2 * FF / 128)); } }
        SEAM(P + 9);
        if (PHSEL(10) && IN(P + 10)) { const int per_e = mt_e * (D / 128); for (int it = bid; it < NE * per_e; it += G) { const int e = it / per_e, r = it % per_e; p11_moe2_tile(c, e, r / (D / 128), r % (D / 128)); } }
        SEAM(P + 10);
    }
    if (PHSEL(101) && IN(N_PHASES - 1)) { for (int it = bid; it < BATCH * SEQ / 8; it += G) pf_final_row(c, it * 8 + wave); }
#undef wave
#undef pl
}

#ifdef EMU
static void emu_dump_map(FILE* f) {
    fprintf(f, "MOD %zu\nCCUR %zu\nH %zu\nZ %zu\nWIN %zu\nWUQ %zu\nWUKV %zu\nWBR %zu\nWOUT %zu\nEXP %zu\nMQ %zu\nMK %zu\nMVT %zu\nNAVT %zu\nGVT %zu\nOCAT %zu\nAFF %zu\nRMAP %zu\nSLW %zu\nTOTAL %zu\n",
            WS_MOD, WS_CCUR, WS_H, WS_Z, WS_WIN, WS_WUQ, WS_WUKV, WS_WBR, WS_WOUT, WS_EXP, WS_MQ, WS_MK, WS_MVT, WS_NAVT, WS_GVT, WS_OCAT, WS_AFF, WS_RMAP, WS_SLW, WS_TOTAL_BYTES);
    fprintf(f, "D_IN_PAD %d\nNTOK %d\nMTOT %d\nRPE %d\n", D_IN_PAD, NTOK, MTOT, RPE);
}
#endif

extern "C" void kernel_launch(void* const* d_in, const int* in_sizes, int n_in, void* d_out, int out_size, void* d_ws, size_t ws_size, hipStream_t stream) {
    Params p{};
    for (int i = 0; i < 28; ++i) p.in[i] = (const float*)d_in[i];
    p.out = (float*)d_out; p.ws = (char*)d_ws;
#ifdef EMU
    int emu_stop = N_PHASES; if (getenv("EMU_STOP")) emu_stop = atoi(getenv("EMU_STOP"));
    hipMemsetAsync((char*)d_ws + WS_BAR, 0, WS_BAR_BYTES, stream);
    if (getenv("EMU_ONE")) { p.ph_lo = 0; p.ph_hi = emu_stop; emu_launch(mk_forward, 3, NTHR, LDS_BYTES, p, true); }
    else for (int k = 0; k < emu_stop; ++k) { p.ph_lo = k; p.ph_hi = k + 1; emu_launch(mk_forward, 5, NTHR, LDS_BYTES, p, false); }
#else
    static int grid = 0;
    if (grid == 0) {
        if (n_in != 28 || out_size != BATCH * SEQ * D || ws_size < WS_TOTAL_BYTES) { fprintf(stderr, "kernel_launch: unexpected shapes (n_in %d out %d ws %zu need %zu)\n", n_in, out_size, ws_size, (size_t)WS_TOTAL_BYTES); grid = -1; return; }
        int dev = 0, cus = 0, per_cu = 0;
        hipGetDevice(&dev); hipDeviceGetAttribute(&cus, hipDeviceAttributeMultiprocessorCount, dev);
        hipFuncSetAttribute((const void*)mk_forward, hipFuncAttributeMaxDynamicSharedMemorySize, LDS_BYTES);
        hipOccupancyMaxActiveBlocksPerMultiprocessor(&per_cu, (const void*)mk_forward, NTHR, LDS_BYTES);
        if (per_cu < 1) { fprintf(stderr, "kernel_launch: occupancy query says %d blocks/CU\n", per_cu); grid = -1; return; }
        grid = cus;
    }
    if (grid < 0) return;
    hipMemsetAsync((char*)d_ws + WS_BAR, 0, WS_BAR_BYTES, stream);
#if MK_ONE_LAUNCH
    p.ph_lo = 0; p.ph_hi = N_PHASES;
    void* args[] = {&p};
    hipError_t e = hipLaunchCooperativeKernel((const void*)mk_forward, dim3(grid), dim3(NTHR), args, LDS_BYTES, stream);
    if (e != hipSuccess) fprintf(stderr, "cooperative launch failed: %s (grid %d)\n", hipGetErrorString(e), grid);
#else
    for (int k = 0; k < N_PHASES; ++k) { p.ph_lo = k; p.ph_hi = k + 1; hipLaunchKernelGGL(mk_forward, dim3(grid), dim3(NTHR), LDS_BYTES, stream, p); }
#endif
#endif
}
```

```cpp
#ifndef EMU
#include <hip/hip_runtime.h>
#include <hip/hip_cooperative_groups.h>
#include <cstdio>
#endif
#include <stdint.h>

#ifndef MK_ONE_LAUNCH
#define MK_ONE_LAUNCH 1
#endif

#ifdef EMU_SMALL
constexpr int D_MODEL = 256, BATCH = 2, SEQ = 1024, CTX_LEN = 256, N_EXPERTS = 4, EXPERT_FF = 256;
#else
constexpr int D_MODEL = 1024, BATCH = 8, SEQ = 2048, CTX_LEN = 256, N_EXPERTS = 16, EXPERT_FF = 1024;
#endif
constexpr int DEPTH = 2, GRID_W = 64, ROWS = SEQ / GRID_W;
constexpr int D = D_MODEL, D6 = 6 * D, FF = EXPERT_FF, NE = N_EXPERTS;
constexpr int NTOK = CTX_LEN + SEQ;
constexpr int MTOT = BATCH * NTOK;
constexpr int NCH = NTOK / 64, NCC = CTX_LEN / 64;
constexpr int ZKA = 0, ZGK = 256, ZDKV = 512, ZKR = 640, ZAF = 672, ZAB = 688, ZQA = 768, ZDQ = 1024, ZGQ = 1280, ZOG = 1536, ZMA = 2048;
constexpr int D_IN = 2752 + 3 * D;
constexpr int ZROW = ZMA + 3 * D;
constexpr int ZS = (ZROW + 255) / 256 * 256;
constexpr int NIN = ZS + 768;
constexpr int D_IN_PAD = ZS;
constexpr int CAPL = 2 * SEQ / NE, CAPC = 2 * CTX_LEN / NE;
constexpr int RPE_L = BATCH * CAPL, RPE_C = BATCH * CAPC, RPE = RPE_L + RPE_C;
constexpr float EPS = 1e-6f;
constexpr int NTHR = 512;
static_assert(ROWS >= 8 && NTOK % 256 == 0 && CTX_LEN % 256 == 0 && SEQ % 256 == 0 && RPE_L % 256 == 0 && RPE_C % 256 == 0 && D % 256 == 0 && FF % 256 == 0, "shape");

constexpr size_t al256(size_t x) { return (x + 255) / 256 * 256; }
constexpr size_t WS_BAR = 0;
constexpr size_t WS_BAR_BYTES = 16384;
constexpr size_t WS_MOD = WS_BAR + WS_BAR_BYTES;
constexpr size_t WS_CCUR = WS_MOD + al256((size_t)DEPTH * (BATCH + 1) * D6 * 4);
constexpr size_t WS_H = WS_CCUR + al256((size_t)BATCH * CTX_LEN * D * 4);
constexpr size_t WS_Z = WS_H + al256((size_t)MTOT * D * 2);
constexpr size_t WS_Z_BYTES = al256((size_t)MTOT * D_IN_PAD * 2);
static_assert((size_t)NE * RPE * FF * 2 <= WS_Z_BYTES, "hid alias");
constexpr size_t WS_WIN = WS_Z + WS_Z_BYTES;
constexpr size_t WS_WUQ = WS_WIN + al256((size_t)DEPTH * NIN * D * 2);
constexpr size_t WS_WUKV = WS_WUQ + al256((size_t)DEPTH * 384 * 256 * 2);
constexpr size_t WS_WGT = WS_WUKV + al256((size_t)DEPTH * 512 * 128 * 2);
constexpr size_t WS_WBR = WS_WGT + al256((size_t)DEPTH * 2 * 2 * 256 * 16 * 2);
constexpr size_t WS_WOUT = WS_WBR + al256((size_t)DEPTH * D * 1024 * 2);
constexpr size_t WS_EXP = WS_WOUT + al256((size_t)DEPTH * D * D * 2);
constexpr size_t EXP_WGU = 0;
constexpr size_t EXP_WD = al256((size_t)NE * 2 * FF * D * 2);
constexpr size_t EXP_BYTES = EXP_WD + al256((size_t)NE * D * FF * 2);
constexpr size_t GLA_KV = 0;
constexpr size_t GLA_DEC = al256((size_t)BATCH * 4 * 2 * NCH * 64 * 128 * 4);
constexpr size_t GLA_SP = GLA_DEC + al256((size_t)BATCH * 4 * 2 * NCH * 64 * 4);
constexpr size_t GLA_BYTES = GLA_SP + al256((size_t)BATCH * 4 * 2 * NCH * 64 * 128 * 2);
constexpr size_t WS_EXP_BYTES = EXP_BYTES > GLA_BYTES ? EXP_BYTES : GLA_BYTES;
constexpr size_t WS_MQ = WS_EXP + WS_EXP_BYTES;
constexpr size_t WS_MK = WS_MQ + al256((size_t)BATCH * 4 * NTOK * 96 * 2);
constexpr size_t WS_MVT = WS_MK + al256((size_t)BATCH * 4 * NTOK * 96 * 2);
constexpr size_t WS_NAVT = WS_MVT + al256((size_t)BATCH * 4 * 64 * NTOK * 2);
constexpr size_t WS_GVT = WS_NAVT + al256((size_t)BATCH * 4 * 64 * NTOK * 2);
constexpr size_t WS_OCAT = WS_GVT + al256((size_t)BATCH * 4 * 128 * NTOK * 2);
constexpr size_t WS_AFF = WS_OCAT + al256((size_t)MTOT * 1024 * 2);
constexpr size_t WS_RMAP = WS_AFF + al256((size_t)MTOT * NE * 4);
constexpr size_t WS_SLW = WS_RMAP + al256((size_t)NE * RPE * 4);
constexpr size_t WS_INV = WS_SLW + al256((size_t)NE * RPE * 4);
constexpr size_t WS_TOTAL_BYTES = WS_INV + al256((size_t)MTOT * NE * 4);
constexpr size_t WS_YE = WS_MQ;
static_assert((size_t)NE * RPE * D * 2 <= WS_AFF - WS_MQ, "ye alias");

typedef unsigned short bf16_t;
typedef short bf16x8 __attribute__((ext_vector_type(8)));
typedef float f32x4 __attribute__((ext_vector_type(4)));
typedef uint32_t U4 __attribute__((ext_vector_type(4)));
typedef uint32_t U2 __attribute__((ext_vector_type(2)));
#define DEV __device__ __forceinline__
#ifdef EMU
DEV int ltid() { return (int)threadIdx.x; }
#else
DEV int ltid() { int t = (int)threadIdx.x; asm volatile("" : "+v"(t)); return t; }
#endif

#ifdef EMU
#define NT_LOAD4(p) (*(const f32x4*)(p))
#define NT_LOAD1(p) (*(const float*)(p))
#define NT_STORE4(p, v) (*(f32x4*)(p) = (v))
#else
#define NT_LOAD4(p) __builtin_nontemporal_load((const f32x4*)(p))
#define NT_LOAD1(p) __builtin_nontemporal_load((const float*)(p))
#define NT_STORE4(p, v) __builtin_nontemporal_store((v), (f32x4*)(p))
#endif
DEV float bf2f(bf16_t h) { return __builtin_bit_cast(float, (uint32_t)h << 16); }
DEV bf16_t f2bf(float f) { uint32_t u = __builtin_bit_cast(uint32_t, f); u += 0x7FFFu + ((u >> 16) & 1u); return (bf16_t)(u >> 16); }
DEV uint32_t pack2(float a, float b) { return (uint32_t)f2bf(a) | ((uint32_t)f2bf(b) << 16); }
#ifdef EMU
DEV float fast_exp2(float x) { return exp2f(x); }
#else
DEV float fast_exp2(float x) { return __builtin_amdgcn_exp2f(x); }
#endif
#ifdef EMU
DEV float fast_rcp(float x) { return 1.0f / x; }
#else
DEV float fast_rcp(float x) { return __builtin_amdgcn_rcpf(x); }
#endif
#ifdef EMU
#define SCHED_FENCE()
#else
#define SCHED_FENCE() __builtin_amdgcn_sched_barrier(0)
#endif
DEV float sigmoidf_(float x) { return fast_rcp(1.0f + __expf(-x)); }
DEV float siluf_(float x) { return x * sigmoidf_(x); }

#ifdef EMU
#define WAVE_SYNC() emu_wave_sync()
#else
#define WAVE_SYNC() do { asm volatile("s_waitcnt lgkmcnt(0)" ::: "memory"); __builtin_amdgcn_wave_barrier(); } while (0)
#endif

struct Params { const float* in[28]; float* out; char* ws; int ph_lo, ph_hi; };
enum { I_X = 0, I_C, I_CTX, I_CCTX, I_ADAW, I_ADAB, I_NORM1, I_NORM2, I_WIN, I_RPB, I_QNORM, I_WUQ, I_KVNORM, I_WUKV, I_WAF, I_BAF, I_WAB, I_BAB, I_ONORM,
       I_WBRA, I_WBRB, I_WBRC, I_WOUT, I_ROUTER, I_WGATE, I_WUP, I_WDOWN, I_FNORM };

#ifndef EMU
#define XB_TMO      128
#define XB_XCNT(j)  (256  + 64 * (j))
#define XB_XSUB(j)  (1280 + 64 * (j))
#define XB_XGEN(j)  (2304 + 64 * (j))
#define XB_TOP      3328
#define XB_TOPGEN   3392
#define XCD_BAR_WORDS 3456
#define XB_SPIN_CAP (1u << 22)
#define LAS __attribute__((address_space(3)))
DEV unsigned xb_ld(unsigned* p)              { return __hip_atomic_load(p, __ATOMIC_RELAXED, __HIP_MEMORY_SCOPE_AGENT); }
DEV unsigned xb_add(unsigned* p, unsigned v) { return __hip_atomic_fetch_add(p, v, __ATOMIC_RELAXED, __HIP_MEMORY_SCOPE_AGENT); }
DEV unsigned xb_xcc_id() { return (unsigned)__builtin_amdgcn_s_getreg((3 << 11) | 20) & 0xFu; }
#define XB_SPIN(cond, bar) do { unsigned _sp = 0; while (cond) { __builtin_amdgcn_s_sleep(1); \
    if ((++_sp & 255u) == 0u) { if (xb_ld(&(bar)[XB_TMO])) break; if (_sp > XB_SPIN_CAP) { atomicAdd(&(bar)[XB_TMO], 1u); break; } } } } while (0)
struct XcdBarrier { unsigned* bar; unsigned x; volatile LAS unsigned* st; };
DEV XcdBarrier xcd_barrier_post(unsigned* bar, volatile LAS unsigned* st) {
    XcdBarrier b; b.bar = bar; b.x = xb_xcc_id(); b.st = st;
    if (ltid() == 0) (void)xb_add(&bar[XB_XCNT(b.x)], 1u);
    return b;
}
DEV void xcd_barrier_complete(unsigned* bar, unsigned x, unsigned& nloc, unsigned& nx) {
    const unsigned G = gridDim.x * gridDim.y * gridDim.z;
    unsigned sum, cnt, mine, sp = 0u;
    for (;;) {
        sum = 0u; cnt = 0u; mine = 0u;
#pragma unroll
        for (unsigned j = 0; j < 16; ++j) { const unsigned c = xb_ld(&bar[XB_XCNT(j)]); sum += c; cnt += (c > 0u) ? 1u : 0u; mine = (j == x) ? c : mine; }
        if (sum == G) break;
        __builtin_amdgcn_s_sleep(1);
        if ((++sp & 255u) == 0u) { if (xb_ld(&bar[XB_TMO])) break; if (sp > XB_SPIN_CAP) { atomicAdd(&bar[XB_TMO], 1u); break; } }
    }
    nloc = mine > 0u ? mine : 1u; nx = cnt > 0u ? cnt : 1u;
}
DEV void xcd_barrier(const XcdBarrier& b) {
    asm volatile("s_waitcnt vmcnt(0)" ::: "memory");
    __syncthreads();
    if (ltid() == 0) {
        unsigned* bar = b.bar;
        __builtin_amdgcn_s_waitcnt(0);
        unsigned nloc = b.st[0], nx = b.st[1];
        if (nloc == 0u) { xcd_barrier_complete(bar, b.x, nloc, nx); b.st[0] = nloc; b.st[1] = nx; }
        const unsigned old = xb_add(&bar[XB_XSUB(b.x)], 1u);
        const unsigned gen = old / nloc;
        if (old + 1u == (gen + 1u) * nloc) {
            __builtin_amdgcn_fence(__ATOMIC_RELEASE, "agent");
            asm volatile("s_waitcnt vmcnt(0)" ::: "memory");
            const unsigned og = xb_add(&bar[XB_TOP], 1u);
            const unsigned tg = og / nx;
            if (og + 1u == (tg + 1u) * nx) xb_add(&bar[XB_TOPGEN], 1u);
            else XB_SPIN(xb_ld(&bar[XB_TOPGEN]) == tg, bar);
            __builtin_amdgcn_fence(__ATOMIC_ACQUIRE, "agent");
            xb_add(&bar[XB_XGEN(b.x)], 1u);
            asm volatile("s_waitcnt vmcnt(0)" ::: "memory");
        } else {
            XB_SPIN(xb_ld(&bar[XB_XGEN(b.x)]) == gen, bar);
            __builtin_amdgcn_fence(__ATOMIC_ACQUIRE, "agent");
            asm volatile("s_waitcnt vmcnt(0)" ::: "memory");
        }
    }
    __syncthreads();
}
#endif

constexpr int LDS_BYTES = 147456;
constexpr int LDS_MISC = LDS_BYTES - 64;
constexpr int GS = 72;

DEV void acc_zero(f32x4 (&acc)[4][2]) {
#pragma unroll
    for (int mi = 0; mi < 4; ++mi)
#pragma unroll
        for (int ni = 0; ni < 2; ++ni) acc[mi][ni] = f32x4{0.f, 0.f, 0.f, 0.f};
}

#ifdef EMU
static Params emu_params;
DEV const Params* KP() { return &emu_params; }
#else
typedef const Params __attribute__((address_space(4))) CParams;
DEV CParams* KP() { CParams* p = (CParams*)__builtin_amdgcn_kernarg_segment_ptr(); asm volatile("" : "+s"(p)); return p; }
#endif
struct Ctx {
    char* smem; int layer;
    DEV const float* in(int i) const { return KP()->in[i]; }
    DEV float* out() const { return KP()->out; }
    DEV char* ws() const { return KP()->ws; }
    DEV float* mod(int l, int brow) const { return (float*)(ws() + WS_MOD) + ((size_t)l * (BATCH + 1) + brow) * D6; }
};

DEV void p0_mod_item(const Ctx& c, int item) {
    const int l = item / (D6 / 64), cc = item % (D6 / 64);
    float* sc = (float*)c.smem;
    float* red = sc + (BATCH + 1) * D;
    const int tid = ltid();
    __syncthreads();
    { constexpr int NC4 = BATCH * D / 4, NL = (NC4 + NTHR - 1) / NTHR;
      const f32x4* c4 = (const f32x4*)c.in(I_C); f32x4 cv[NL];
#pragma unroll
      for (int i = 0; i < NL; ++i) { const int ix = tid + i * NTHR; cv[i] = c4[ix < NC4 ? ix : NC4 - 1]; }
      const f32x4 cx = ((const f32x4*)c.in(I_CCTX))[tid & (D / 4 - 1)];
#pragma unroll
      for (int i = 0; i < NL; ++i) { const int ix = tid + i * NTHR; if (ix < NC4) { f32x4 o; o[0] = siluf_(cv[i][0]); o[1] = siluf_(cv[i][1]); o[2] = siluf_(cv[i][2]); o[3] = siluf_(cv[i][3]); *(f32x4*)(sc + ix * 4) = o; } }
      if (tid < D / 4) { f32x4 o; o[0] = siluf_(cx[0]); o[1] = siluf_(cx[1]); o[2] = siluf_(cx[2]); o[3] = siluf_(cx[3]); *(f32x4*)(sc + BATCH * D + tid * 4) = o; } }
    __syncthreads();
    const int col = tid & 63, kg = tid >> 6;
    const float* W = c.in(I_ADAW) + (size_t)l * D * D6 + cc * 64 + col;
    typedef float f32x16 __attribute__((ext_vector_type(16)));
    static_assert(BATCH + 1 <= 16, "mod rows");
    float a[BATCH + 1];
#pragma unroll
    for (int r = 0; r <= BATCH; ++r) a[r] = 0.f;
    {
        constexpr int UB = 16, NB = D / 8 / UB;
        static_assert(NB % 2 == 0, "mod batches");
        float w[UB], wn[UB];
#ifdef EMU
#define MOD_FMAC(acc, x, y) acc += (x) * (y)
#else
#define MOD_FMAC(acc, x, y) asm("v_fmac_f32 %0, %1, %2" : "+v"(acc) : "v"(x), "v"(y))
#endif
#define MOD_LD(dst, kbase) _Pragma("unroll") for (int u = 0; u < UB; ++u) dst[u] = NT_LOAD1(W + (size_t)((kbase) + 8 * u) * D6);
#define MOD_FMA(src, kbase) _Pragma("unroll") for (int u = 0; u < UB; ++u) { _Pragma("unroll") for (int r = 0; r <= BATCH; ++r) MOD_FMAC(a[r], sc[r * D + (kbase) + 8 * u], src[u]); }
        MOD_LD(w, kg)
        for (int bt = 0; bt < NB - 2; bt += 2) {
            const int kb = kg + bt * 8 * UB;
            MOD_LD(wn, kb + 8 * UB) SCHED_FENCE(); MOD_FMA(w, kb) SCHED_FENCE();
            MOD_LD(w, kb + 16 * UB) SCHED_FENCE(); MOD_FMA(wn, kb + 8 * UB) SCHED_FENCE();
        }
        { const int kb = kg + (NB - 2) * 8 * UB;
          MOD_LD(wn, kb + 8 * UB) SCHED_FENCE(); MOD_FMA(w, kb) SCHED_FENCE(); MOD_FMA(wn, kb + 8 * UB) }
#undef MOD_LD
#undef MOD_FMA
#undef MOD_FMAC
    }
#pragma unroll
    for (int r = 0; r <= BATCH; ++r) red[(kg * (BATCH + 1) + r) * 64 + col] = a[r];
    __syncthreads();
    for (int i = tid; i < (BATCH + 1) * 64; i += NTHR) { int r = i / 64, cl = i % 64; float s = 0.f;
        for (int g = 0; g < 8; ++g) s += red[(g * (BATCH + 1) + r) * 64 + cl];
        c.mod(l, r)[cc * 64 + cl] = s + c.in(I_ADAB)[(size_t)l * D6 + cc * 64 + cl]; }
}

template <class Map> DEV void convT_tile(char* smem, const float* src, int sstride, const float* gain, bf16_t* dst, int dstride, int n0, int k0, Map map) {
    float* t = (float*)smem;
    const int tid = ltid();
    __syncthreads();
    for (int i = tid; i < 4096; i += NTHR) { int k = i >> 6, n = i & 63; int sc = map(n0 + n); float v = 0.f; if (sc >= 0) { v = src[(size_t)(k0 + k) * sstride + sc]; if (gain) v *= gain[k0 + k]; } t[k * 65 + n] = v; }
    __syncthreads();
    { int n = tid >> 3, kc = (tid & 7) * 8; U4 o;
      o.x = pack2(t[(kc + 0) * 65 + n], t[(kc + 1) * 65 + n]); o.y = pack2(t[(kc + 2) * 65 + n], t[(kc + 3) * 65 + n]);
      o.z = pack2(t[(kc + 4) * 65 + n], t[(kc + 5) * 65 + n]); o.w = pack2(t[(kc + 6) * 65 + n], t[(kc + 7) * 65 + n]);
      *(U4*)(dst + (size_t)(n0 + n) * dstride + k0 + kc) = o; }
}
DEV int rope_perm32(int j) { int blk = j >> 3; blk = (blk == 1) ? 2 : (blk == 2) ? 1 : blk; return blk * 8 + (j & 7); }
struct MapWin { DEV int operator()(int n) const {
    if (n < 256) return 256 + n;
    if (n < 512) return 1440 + (n - 256);
    if (n < 640) return 1024 + (n - 512);
    if (n < 672) return 1152 + rope_perm32(n - 640);
    if (n < 688) return 2208 + (n - 672);
    if (n < 704) return 2224 + (n - 688);
    if (n < 768) return -1;
    if (n < 1024) return n - 768;
    if (n < 1280) return 768 + (n - 1024);
    if (n < 1536) return 1184 + (n - 1280);
    if (n < 2048) return 2240 + (n - 1536);
    if (n < ZROW) return 2752 + (n - ZMA);
    if (n < ZS) return -1;
    if (n < ZS + 256) return 512 + (n - ZS);
    return 1696 + (n - ZS - 256); } };
struct MapUq { DEV int operator()(int n) const { int h = n / 96, w = n % 96; return (w < 64) ? n : h * 96 + 64 + rope_perm32(w - 64); } };
struct MapId { DEV int operator()(int n) const { return n; } };
struct MapGU { int which; DEV int operator()(int r) const { int q = r >> 5, w = r & 31; if (which == 0) return (w < 16) ? 16 * q + w : -2; return (w >= 16) ? 16 * q + w - 16 : -2; } };

constexpr int CW_UQ = 6 * 4, CW_UKV = 8 * 2, CW_PER_LAYER = CW_UQ + CW_UKV;
DEV void p0_gatew_item(const Ctx& c, int l) {
    bf16_t* o = (bf16_t*)(c.ws() + WS_WGT) + (size_t)l * 2 * 2 * 256 * 16;
    for (int i = ltid(); i < 2 * 256 * 16; i += NTHR) { const int dir = i >> 12, d = (i >> 4) & 255, r = i & 15;
        const float w = (dir == 0 ? c.in(I_WAF) : c.in(I_WAB))[((size_t)l * 16 + r) * 256 + d]; const bf16_t hi = f2bf(w); const bf16_t lo = f2bf(w - bf2f(hi));
        o[((dir * 2 + 0) * 256 + d) * 16 + r] = hi; o[((dir * 2 + 1) * 256 + d) * 16 + r] = lo; }
}
DEV void p0_convw_item(const Ctx& c, int item) {
    const int l = item / CW_PER_LAYER; int r = item % CW_PER_LAYER;
    if (r < CW_UQ) { int tn = r / 4, tk = r % 4;
        convT_tile(c.smem, c.in(I_WUQ) + (size_t)l * 256 * 384, 384, c.in(I_QNORM) + l * 256, (bf16_t*)(c.ws() + WS_WUQ) + (size_t)l * 384 * 256, 256, tn * 64, tk * 64, MapUq()); return; }
    r -= CW_UQ;
    { int tn = r / 2, tk = r % 2;
      convT_tile(c.smem, c.in(I_WUKV) + (size_t)l * 128 * 512, 512, c.in(I_KVNORM) + l * 128, (bf16_t*)(c.ws() + WS_WUKV) + (size_t)l * 512 * 128, 128, tn * 64, tk * 64, MapId()); }
}
struct ConvJob { const float* src; bf16_t* dst; int sstride, dstride, k0, n0, mode; };
DEV int conv_row(int mode, int n) { return mode >= 2 ? n : 8 * (n >> 2) + (mode == 1 ? 4 : 0) + (n & 3); }
constexpr int CE_G = (D / 64) * (FF / 256), CE_D = (FF / 64) * (D / 256), CE_PER_E = 2 * CE_G + CE_D, CE_ITEMS = NE * CE_PER_E;
DEV ConvJob convexp_job(const Ctx& c, int l, int item) {
    ConvJob j; const int e = item / CE_PER_E; int r = item % CE_PER_E;
    bf16_t* wgu = (bf16_t*)(c.ws() + WS_EXP + EXP_WGU) + (size_t)e * 2 * FF * D;
    if (r < 2 * CE_G) { const int up = r >= CE_G; r -= up * CE_G; j.src = (up ? c.in(I_WUP) : c.in(I_WGATE)) + ((size_t)l * NE + e) * D * FF; j.sstride = FF; j.k0 = (r / (FF / 256)) * 64; j.n0 = (r % (FF / 256)) * 256; j.dst = wgu; j.dstride = D; j.mode = up; return j; }
    r -= 2 * CE_G;
    j.src = c.in(I_WDOWN) + ((size_t)l * NE + e) * FF * D; j.sstride = D; j.k0 = (r / (D / 256)) * 64; j.n0 = (r % (D / 256)) * 256; j.dst = (bf16_t*)(c.ws() + WS_EXP + EXP_WD) + (size_t)e * D * FF; j.dstride = FF; j.mode = 2; return j;
}
DEV void conv_load(const ConvJob& j, f32x4 (&v)[2][4]) {
    const int tid = ltid(), lane = tid & 63, wv = tid >> 6;
#pragma unroll
    for (int i = 0; i < 2; ++i)
#pragma unroll
        for (int r = 0; r < 4; ++r) { int col = j.n0 + lane * 4; if (j.mode == 3) col = MapWin()(col);
            v[i][r] = col >= 0 ? NT_LOAD4(j.src + (size_t)(j.k0 + (wv + 8 * i) * 4 + r) * j.sstride + col) : f32x4{0.f, 0.f, 0.f, 0.f}; }
}
DEV void conv_finish(char* smem, const ConvJob& j, const f32x4 (&v)[2][4]) {
    constexpr int RS = 68;
    bf16_t* t = (bf16_t*)smem;
    const int tid = ltid(), lane = tid & 63, wv = tid >> 6;
    __syncthreads();
#pragma unroll
    for (int i = 0; i < 2; ++i)
#pragma unroll
        for (int q = 0; q < 4; ++q) { U2 w; w.x = pack2(v[i][0][q], v[i][1][q]); w.y = pack2(v[i][2][q], v[i][3][q]); *(U2*)(t + (q * 64 + lane) * RS + (wv + 8 * i) * 4) = w; }
    __syncthreads();
#pragma unroll
    for (int i = 0; i < 4; ++i) { const int ch = tid + i * NTHR, n = ch >> 3, kc = (ch & 7) * 8; const bf16_t* rp = t + ((n & 3) * 64 + (n >> 2)) * RS + kc;
        const U2 a = *(const U2*)rp, bq = *(const U2*)(rp + 4); U4 o; o.x = a.x; o.y = a.y; o.z = bq.x; o.w = bq.y;
        *(U4*)(j.dst + (size_t)conv_row(j.mode, j.n0 + n) * j.dstride + j.k0 + kc) = o; }
}
template <class JobFn> DEV void conv_range(const Ctx& c, JobFn jobfn, int lo, int hi, int rank, int nb) {
    int it = lo + rank; if (it >= hi) return;
    ConvJob j = jobfn(it); f32x4 v[2][4]; conv_load(j, v);
    for (;;) {
        const int nx = it + nb; const bool more = nx < hi;
        ConvJob jn = j; f32x4 vn[2][4];
        if (more) { jn = jobfn(nx); conv_load(jn, vn); }
        conv_finish(c.smem, j, v);
        if (!more) break;
#pragma unroll
        for (int i = 0; i < 2; ++i)
#pragma unroll
            for (int r = 0; r < 4; ++r) v[i][r] = vn[i][r];
        j = jn; it = nx;
    }
}
struct ExpJobFn { const Ctx* c; int l; DEV ConvJob operator()(int item) const { return convexp_job(*c, l, item); } };
DEV void convexp_range(const Ctx& c, int l, int lo, int hi, int rank, int nb) { ExpJobFn f; f.c = &c; f.l = l; conv_range(c, f, lo, hi, rank, nb); }
constexpr int PJ_WIN = (NIN / 256) * (D / 64), PJ_BRA = (D / 256) * 4, PJ_BRC = (D / 256) * 8, PJ_OUT = (D / 256) * (D / 64), PJ_PER_L = PJ_WIN + 2 * PJ_BRA + PJ_BRC + PJ_OUT;
struct PrepJobFn { const Ctx* c; DEV ConvJob operator()(int item) const {
    ConvJob j; const int l = item / PJ_PER_L; int r = item % PJ_PER_L; const Ctx& cc = *c;
    if (r < PJ_WIN) { j.src = cc.in(I_WIN) + (size_t)l * D * D_IN; j.sstride = D_IN; j.k0 = (r % (D / 64)) * 64; j.n0 = (r / (D / 64)) * 256; j.dst = (bf16_t*)(cc.ws() + WS_WIN) + (size_t)l * NIN * D; j.dstride = D; j.mode = 3; return j; }
    r -= PJ_WIN; bf16_t* wbr = (bf16_t*)(cc.ws() + WS_WBR) + (size_t)l * D * 1024; j.mode = 2; j.sstride = D;
    if (r < PJ_BRA) { j.src = cc.in(I_WBRA) + (size_t)l * 256 * D; j.k0 = (r % 4) * 64; j.n0 = (r / 4) * 256; j.dst = wbr; j.dstride = 1024; return j; }
    r -= PJ_BRA;
    if (r < PJ_BRA) { j.src = cc.in(I_WBRB) + (size_t)l * 256 * D; j.k0 = (r % 4) * 64; j.n0 = (r / 4) * 256; j.dst = wbr + 256; j.dstride = 1024; return j; }
    r -= PJ_BRA;
    if (r < PJ_BRC) { j.src = cc.in(I_WBRC) + (size_t)l * 512 * D; j.k0 = (r % 8) * 64; j.n0 = (r / 8) * 256; j.dst = wbr + 512; j.dstride = 1024; return j; }
    r -= PJ_BRC;
    j.src = cc.in(I_WOUT) + (size_t)l * D * D; j.k0 = (r % (D / 64)) * 64; j.n0 = (r / (D / 64)) * 256; j.dst = (bf16_t*)(cc.ws() + WS_WOUT) + (size_t)l * D * D; j.dstride = D; return j; } };

DEV const float* xrow_src(const Ctx& c, int grow) {
    const int b = grow / NTOK, p = grow % NTOK;
    if (p < CTX_LEN) return (c.layer == 0 ? c.in(I_CTX) : (const float*)(c.ws() + WS_CCUR)) + ((size_t)b * CTX_LEN + p) * D;
    return (c.layer == 0 ? c.in(I_X) : (const float*)c.out()) + ((size_t)b * SEQ + (p - CTX_LEN)) * D;
}
DEV float* xrow_dst(const Ctx& c, int grow) {
    const int b = grow / NTOK, p = grow % NTOK;
    if (p < CTX_LEN) return (float*)(c.ws() + WS_CCUR) + ((size_t)b * CTX_LEN + p) * D;
    return c.out() + ((size_t)b * SEQ + (p - CTX_LEN)) * D;
}
DEV float wave_sum(float v) { for (int m = 1; m < 64; m <<= 1) v += __shfl_xor(v, m); return v; }

constexpr int NV = D / 256;
struct MoePre { int mine; f32x4 gt[NV]; };
DEV MoePre moe_prefetch(const Ctx& c, int grow, int lprev) {
    const int lane = ltid() & 63;
    const int b = grow / NTOK, p = grow % NTOK;
    const float* gate = c.mod(lprev, p < CTX_LEN ? BATCH : b) + 5 * D;
    const int* inv = (const int*)(c.ws() + WS_INV) + (size_t)grow * NE;
    MoePre m; m.mine = inv[lane & (NE - 1)];
#pragma unroll
    for (int i = 0; i < NV; ++i) m.gt[i] = *(const f32x4*)(gate + lane * 4 + i * 256);
    return m;
}
DEV void moe_combine_regs(const Ctx& c, const MoePre& mp, f32x4 (&xv)[NV]) {
    const int lane = ltid() & 63;
    const bf16_t* ye = (const bf16_t*)(c.ws() + WS_YE);
    f32x4 a[NV];
#pragma unroll
    for (int i = 0; i < NV; ++i) a[i] = f32x4{0.f, 0.f, 0.f, 0.f};
    const int mine = (lane < NE) ? mp.mine : -1;
    unsigned long long msk = __ballot(mine >= 0);
    while (msk) {
        const int e0 = __builtin_ctzll(msk); msk &= msk - 1;
        int e1 = -1; if (msk) { e1 = __builtin_ctzll(msk); msk &= msk - 1; }
        const int i0 = __shfl(mine, e0), i1 = __shfl(mine, e1 < 0 ? e0 : e1);
        U2 p0[NV], p1[NV];
#pragma unroll
        for (int i = 0; i < NV; ++i) { p0[i] = *(const U2*)(ye + (size_t)i0 * D + lane * 4 + i * 256); p1[i] = *(const U2*)(ye + (size_t)i1 * D + lane * 4 + i * 256); }
#pragma unroll
        for (int i = 0; i < NV; ++i) {
            a[i][0] += bf2f((bf16_t)(p0[i].x & 0xFFFF)); a[i][1] += bf2f((bf16_t)(p0[i].x >> 16)); a[i][2] += bf2f((bf16_t)(p0[i].y & 0xFFFF)); a[i][3] += bf2f((bf16_t)(p0[i].y >> 16));
            if (e1 >= 0) { a[i][0] += bf2f((bf16_t)(p1[i].x & 0xFFFF)); a[i][1] += bf2f((bf16_t)(p1[i].x >> 16)); a[i][2] += bf2f((bf16_t)(p1[i].y & 0xFFFF)); a[i][3] += bf2f((bf16_t)(p1[i].y >> 16)); } }
    }
#pragma unroll
    for (int i = 0; i < NV; ++i) xv[i] += mp.gt[i] * a[i];
}
struct P1Pre { f32x4 xv[NV], scv[NV], shv[NV]; MoePre mp; };
DEV P1Pre p1_prefetch(const Ctx& c, int grow) {
    const int lane = ltid() & 63, l = c.layer;
    const int b = grow / NTOK, p = grow % NTOK;
    const float* x = xrow_src(c, grow);
    const float* md = c.mod(l, p < CTX_LEN ? BATCH : b);
    P1Pre r;
#pragma unroll
    for (int i = 0; i < NV; ++i) r.xv[i] = *(const f32x4*)(x + lane * 4 + i * 256);
#pragma unroll
    for (int i = 0; i < NV; ++i) { const int cc = lane * 4 + i * 256; r.scv[i] = *(const f32x4*)(md + D + cc); r.shv[i] = *(const f32x4*)(md + cc); }
    if (l > 0) r.mp = moe_prefetch(c, grow, l - 1);
    else { r.mp.mine = -1;
#pragma unroll
        for (int i = 0; i < NV; ++i) r.mp.gt[i] = f32x4{0.f, 0.f, 0.f, 0.f}; }
    return r;
}
DEV void p1_norm_row(const Ctx& c, int grow, const P1Pre& pre, const f32x4 (&gv)[NV]) {
    const int lane = ltid() & 63, l = c.layer;
    f32x4 xv[NV];
#pragma unroll
    for (int i = 0; i < NV; ++i) xv[i] = pre.xv[i];
    if (l > 0) { moe_combine_regs(c, pre.mp, xv); float* xw = xrow_dst(c, grow);
#pragma unroll
        for (int i = 0; i < NV; ++i) *(f32x4*)(xw + lane * 4 + i * 256) = xv[i]; }
    float ss = 0.f;
#pragma unroll
    for (int i = 0; i < NV; ++i) ss += xv[i][0] * xv[i][0] + xv[i][1] * xv[i][1] + xv[i][2] * xv[i][2] + xv[i][3] * xv[i][3];
    ss = wave_sum(ss);
    const float r = rsqrtf(ss / D + EPS);
    bf16_t* h = (bf16_t*)(c.ws() + WS_H) + (size_t)grow * D;
#pragma unroll
    for (int i = 0; i < NV; ++i) { const int cc = lane * 4 + i * 256; float o[4];
#pragma unroll
        for (int k = 0; k < 4; ++k) o[k] = xv[i][k] * r * gv[i][k] * (1.f + pre.scv[i][k]) + pre.shv[i][k];
        U2 pk; pk.x = pack2(o[0], o[1]); pk.y = pack2(o[2], o[3]); *(U2*)(h + cc) = pk; }
}
DEV void p1_rows(const Ctx& c, int it, int n, int G, int wave) {
    if (it >= n) return;
    const int lane = ltid() & 63;
    const float* g = c.in(I_NORM1) + c.layer * D;
    f32x4 gv[NV];
#pragma unroll
    for (int i = 0; i < NV; ++i) gv[i] = *(const f32x4*)(g + lane * 4 + i * 256);
    P1Pre cur = p1_prefetch(c, it * 8 + wave);
    for (;;) {
        const int itn = it + G; const bool more = itn < n;
        const P1Pre nxt = p1_prefetch(c, (more ? itn : it) * 8 + wave);
        SCHED_FENCE();
        p1_norm_row(c, it * 8 + wave, cur, gv);
        if (!more) break;
        SCHED_FENCE();
        cur = nxt; it = itn;
    }
}

#ifdef EMU
#define LDSP
#define G8_GLDS(gptr, ldsptr) memcpy((char*)(ldsptr) + (ltid() & 63) * 16, (const void*)(gptr), 16)
#define G8_WAIT_V(n)
#define G8_WAIT_L(n)
#define G8_BAR __syncthreads()
#define G8_SCHED
#define G8_PRIO(x)
#define G8_LAUNDER(v)
DEV unsigned cvt_pk_bf16(float lo, float hi) { return pack2(lo, hi); }
#else
#define LDSP __attribute__((address_space(3)))
#define G8_GLDS(gptr, ldsptr) __builtin_amdgcn_global_load_lds((const unsigned*)(gptr), (LDSP unsigned*)(ldsptr), 16, 0, 0)
#define G8_WAIT_V(n) asm volatile("s_waitcnt vmcnt(" #n ")" ::: "memory")
#define G8_WAIT_L(n) asm volatile("s_waitcnt lgkmcnt(" #n ")" ::: "memory")
#define G8_BAR __builtin_amdgcn_s_barrier()
#define G8_SCHED __builtin_amdgcn_sched_barrier(0)
#define G8_PRIO(x) __builtin_amdgcn_s_setprio(x)
#define G8_LAUNDER(v) asm volatile("" : "+v"(v))
DEV unsigned cvt_pk_bf16(float lo, float hi) { unsigned r; asm("v_cvt_pk_bf16_f32 %0, %1, %2" : "=v"(r) : "v"(lo), "v"(hi)); return r; }
#endif
namespace g8 {
constexpr int BM = 256, BK = 64, HALF = 128, HTB = HALF * BK * 2, STAGE_BYTES = 8 * HTB, NXCD = 8, WGM = 8;
DEV int lds_byte(int r, int c) { const int st = (r >> 4) * 2 + (c >> 5), rr = r & 15, cc = c & 31, ob = rr * 64 + cc * 2; return st * 1024 + (ob ^ (((ob >> 9) & 1) << 5)); }
DEV void stage_rc(int b, int& R, int& C) { const int st = b / 1024, sb = b % 1024, swz = sb ^ (((sb >> 9) & 1) << 5); R = (st >> 1) * 16 + swz / 64; C = (st & 1) * 32 + (swz % 64) / 2; }
DEV int perm32(int rho) { const int n = rho >> 4, i = rho & 15; return 8 * (i >> 2) + 4 * n + (i & 3); }
struct Unit { int pm, pn, aux, idx; };
DEV void order_map(int L, int nM, int nN, int& pm, int& pn) {
    const int nwg = nM * nN; int wgid = L;
    { const int q = nwg / NXCD, r = nwg % NXCD, xcd = wgid % NXCD, off = wgid / NXCD; wgid = (xcd < r ? xcd * (q + 1) : r * (q + 1) + (xcd - r) * q) + off; }
    const int nig = WGM * nN, gid = wgid / nig, fm = gid * WGM, gsz = (nM - fm) < WGM ? (nM - fm) : WGM;
    pm = fm + ((wgid % nig) % gsz); pn = (wgid % nig) / gsz;
}
typedef f32x4 Acc[2][2][4][2];
template <class P> DEV void gemm_phase(LDSP unsigned char* lds, const P& prob) {
    const int tid = ltid(), wid = __builtin_amdgcn_readfirstlane(tid >> 6), lane = tid & 63, wr = wid >> 2, wc = wid & 3, fr = lane & 15, fq = lane >> 4;
    unsigned voffB[2][2];
    prob.prologue(lds);
#define G8_RC(i, R, C) int R, C; stage_rc(ltid() * 16 + (i) * 8192, R, C)
#pragma unroll
    for (int i = 0; i < 2; ++i) { int R, C; stage_rc(tid * 16 + i * 8192, R, C); const int Rb = P::PERM ? ((R & ~31) + perm32(R & 31)) : R;
        voffB[0][i] = (unsigned)Rb * prob.ldb() + (unsigned)C * 2u; voffB[1][i] = voffB[0][i] + 128u * prob.ldb(); }
    const size_t kstep = (size_t)(BK * 2);
    const unsigned ldsw = (unsigned)wid * 1024u;
    const int aoff = lds_byte(wr * 64 + fr, fq * 8), boff = lds_byte(wc * 32 + fr, fq * 8);
#define G8_SA(b, h) (((b) * 2 + (h)) * HTB)
#define G8_SB(b, h) ((4 + (b) * 2 + (h)) * HTB)
#define G8_STAGE(bufoff, gbase, v0, v1) do { unsigned _v0 = (v0), _v1 = (v1); G8_LAUNDER(_v0); G8_LAUNDER(_v1); G8_GLDS((const char*)(gbase) + _v0, lds + (bufoff) + ldsw); G8_GLDS((const char*)(gbase) + _v1, lds + (bufoff) + ldsw + 8192); } while (0)
#define G8_LDA(dst, b, h) do { _Pragma("unroll") for (int m = 0; m < 4; ++m) _Pragma("unroll") for (int k = 0; k < 2; ++k) dst[m][k] = *(const LDSP bf16x8*)(lds + G8_SA(b, h) + aoff + m * 2048 + k * 1024); } while (0)
#define G8_LDB(dst, b, h) do { _Pragma("unroll") for (int n = 0; n < 2; ++n) _Pragma("unroll") for (int k = 0; k < 2; ++k) dst[n][k] = *(const LDSP bf16x8*)(lds + G8_SB(b, h) + boff + n * 2048 + k * 1024); } while (0)
#define G8_MMA(ai, bj, At, Bt) do { G8_PRIO(1); _Pragma("unroll") for (int m = 0; m < 4; ++m) _Pragma("unroll") for (int n = 0; n < 2; ++n) _Pragma("unroll") for (int k = 0; k < 2; ++k) \
        acc[ai][bj][m][n] = __builtin_amdgcn_mfma_f32_16x16x32_bf16(Bt[n][k], At[m][k], acc[ai][bj][m][n], 0, 0, 0); G8_PRIO(0); } while (0)
#define G8_ZERO() do { _Pragma("unroll") for (int a = 0; a < 2; ++a) _Pragma("unroll") for (int b = 0; b < 2; ++b) _Pragma("unroll") for (int m = 0; m < 4; ++m) _Pragma("unroll") for (int n = 0; n < 2; ++n) acc[a][b][m][n] = f32x4{0.f, 0.f, 0.f, 0.f}; } while (0)
    Unit cur, nxt; int ui = 0;
    if (!prob.next(0, cur)) return;
    Acc acc; G8_ZERO();
    bf16x8 At[4][2], B0[2][2], B1[2][2];
    const char* cA = prob.a_base(cur); const char* cB = prob.b_base(cur); int ntc = prob.nt(cur);
    unsigned vc00, vc01, vc10, vc11;
    { G8_RC(0, R0, C0); G8_RC(1, R1, C1); vc00 = prob.a_voff(lds, cur, 0, R0, C0); vc01 = prob.a_voff(lds, cur, 0, R1, C1); vc10 = prob.a_voff(lds, cur, 1, R0, C0); vc11 = prob.a_voff(lds, cur, 1, R1, C1); }
    G8_STAGE(G8_SB(0, 0), cB, voffB[0][0], voffB[0][1]); G8_STAGE(G8_SA(0, 0), cA, vc00, vc01); G8_STAGE(G8_SB(0, 1), cB, voffB[1][0], voffB[1][1]); G8_STAGE(G8_SA(0, 1), cA, vc10, vc11);
    if (wr == 1) G8_BAR;
    G8_WAIT_V(4); G8_BAR;
    G8_STAGE(G8_SB(1, 0), cB + kstep, voffB[0][0], voffB[0][1]); G8_STAGE(G8_SA(1, 0), cA + kstep, vc00, vc01); G8_STAGE(G8_SB(1, 1), cB + kstep, voffB[1][0], voffB[1][1]);
    G8_WAIT_V(6); G8_BAR;
    for (;;) {
        const bool has_next = prob.next(ui + 1, nxt);
        const char* nA = has_next ? prob.a_base(nxt) : cA; const char* nB = has_next ? prob.b_base(nxt) : cB;
        unsigned vn00 = vc00, vn01 = vc01, vn10 = vc10, vn11 = vc11;
        for (int t = 0; t < ntc; t += 2) {
            const bool last = (t == ntc - 2);
            if (P::GATHER && last && has_next) { G8_RC(0, R0, C0); G8_RC(1, R1, C1); vn00 = prob.a_voff(lds, nxt, 0, R0, C0); vn01 = prob.a_voff(lds, nxt, 0, R1, C1); vn10 = prob.a_voff(lds, nxt, 1, R0, C0); vn11 = prob.a_voff(lds, nxt, 1, R1, C1); }
            const char* a1 = cA + (size_t)(t + 1) * kstep;
            const char* a2 = last ? nA : cA + (size_t)(t + 2) * kstep; const char* b2 = last ? nB : cB + (size_t)(t + 2) * kstep;
            const char* a3 = a2 + kstep; const char* b3 = b2 + kstep;
            const unsigned w00 = last ? vn00 : vc00, w01 = last ? vn01 : vc01, w10 = last ? vn10 : vc10, w11 = last ? vn11 : vc11;
            G8_LDB(B0, 0, 0); G8_SCHED; G8_LDA(At, 0, 0); G8_STAGE(G8_SA(1, 1), a1, vc10, vc11);
            G8_WAIT_L(8); G8_BAR; G8_WAIT_L(0); G8_MMA(0, 0, At, B0); G8_BAR; G8_SCHED;
            G8_LDB(B1, 0, 1); G8_STAGE(G8_SB(0, 0), b2, voffB[0][0], voffB[0][1]);
            G8_BAR; G8_WAIT_L(0); G8_MMA(0, 1, At, B1); G8_BAR;
            G8_LDA(At, 0, 1); G8_STAGE(G8_SA(0, 0), a2, w00, w01);
            G8_BAR; G8_WAIT_L(0); G8_MMA(1, 0, At, B0); G8_BAR; G8_SCHED;
            G8_STAGE(G8_SB(0, 1), b2, voffB[1][0], voffB[1][1]);
            G8_WAIT_V(6); G8_BAR; G8_MMA(1, 1, At, B1); G8_BAR;
            G8_LDB(B0, 1, 0); G8_SCHED; G8_LDA(At, 1, 0); G8_STAGE(G8_SA(0, 1), a2, w10, w11);
            G8_WAIT_L(8); G8_BAR; G8_WAIT_L(0); G8_MMA(0, 0, At, B0); G8_BAR; G8_SCHED;
            G8_LDB(B1, 1, 1); G8_STAGE(G8_SB(1, 0), b3, voffB[0][0], voffB[0][1]);
            G8_BAR; G8_WAIT_L(0); G8_MMA(0, 1, At, B1); G8_BAR;
            G8_LDA(At, 1, 1); G8_STAGE(G8_SA(1, 0), a3, w00, w01);
            G8_BAR; G8_WAIT_L(0); G8_MMA(1, 0, At, B0); G8_BAR; G8_SCHED;
            G8_STAGE(G8_SB(1, 1), b3, voffB[1][0], voffB[1][1]);
            G8_WAIT_V(6); G8_BAR; G8_MMA(1, 1, At, B1); G8_BAR;
        }
        if (wr == 0) G8_BAR;
        prob.epi(acc, cur, wr, wc, fr, fq);
        if (!has_next) break;
        if (!prob.keep_acc(cur)) G8_ZERO();
        cur = nxt; cA = nA; cB = nB; vc00 = vn00; vc01 = vn01; vc10 = vn10; vc11 = vn11; ntc = prob.nt(cur); ++ui;
        if (wr == 1) G8_BAR;
    }
    G8_WAIT_V(0);
    G8_BAR;
#undef G8_RC
#undef G8_SA
#undef G8_SB
#undef G8_STAGE
#undef G8_LDA
#undef G8_LDB
#undef G8_MMA
#undef G8_ZERO
}
}

DEV int lat_unit_row0(int pm) { const int b = pm / (SEQ / 256), w = pm % (SEQ / 256); return b * NTOK + CTX_LEN + w * 256; }
struct ProbInproj {
    static constexpr bool PERM = true, GATHER = false;
    const char* A; const char* Bt; bf16_t* Z; bf16_t* navt; bf16_t* gvt; int G, c, lastl;
    DEV bool next(int i, g8::Unit& u) const { const int L = i * G + c; u.aux = 0; u.idx = i;
        if (!lastl) { if (L >= (MTOT / 256) * (NIN / 256)) return false; g8::order_map(L, MTOT / 256, NIN / 256, u.pm, u.pn); return true; }
        constexpr int NL = BATCH * (SEQ / 256) * (NIN / 256), NC = BATCH * (CTX_LEN / 256) * 6;
        if (L >= NL + NC) return false;
        if (L < NL) { int pml; g8::order_map(L, BATCH * (SEQ / 256), NIN / 256, pml, u.pn); u.pm = lat_unit_row0(pml) / 256; return true; }
        const int Lc = L - NL, bc = Lc / 6, j = Lc % 6; u.pm = ((bc / (CTX_LEN / 256)) * NTOK + (bc % (CTX_LEN / 256)) * 256) / 256; u.pn = j < 3 ? j : ZS / 256 + (j - 3); return true; }
    DEV const char* a_base(const g8::Unit& u) const { return A + (size_t)u.pm * 256 * D * 2; }
    DEV const char* b_base(const g8::Unit& u) const { return Bt + (size_t)u.pn * 256 * D * 2; }
    DEV int nt(const g8::Unit&) const { return D / 64; }
    DEV void prologue(LDSP unsigned char*) const {}
    DEV unsigned a_voff(LDSP unsigned char*, const g8::Unit&, int h, int R, int C) const { return (unsigned)((h * 128 + R) * D + C) * 2u; }
    DEV unsigned ldb() const { return D * 2; }
    DEV bool keep_acc(const g8::Unit&) const { return false; }
    DEV void epi(g8::Acc& acc, const g8::Unit& u, int wr, int wc, int fr, int fq) const {
        if (u.pn * 256 < ZS) {
            bf16_t* base = Z + (size_t)(u.pm * 256 + wr * 64 + fr) * ZS + u.pn * 256 + wc * 32 + fq * 8;
            if (u.pn * 256 >= ZMA) {
#pragma unroll
                for (int ai = 0; ai < 2; ++ai)
#pragma unroll
                    for (int bj = 0; bj < 2; ++bj)
#pragma unroll
                        for (int m = 0; m < 4; ++m)
#pragma unroll
                            for (int n = 0; n < 2; ++n)
#pragma unroll
                                for (int j = 0; j < 4; ++j) acc[ai][bj][m][n][j] = fast_exp2(acc[ai][bj][m][n][j] * -1.4426950408889634f);
            }
#pragma unroll
            for (int ai = 0; ai < 2; ++ai)
#pragma unroll
                for (int m = 0; m < 4; ++m)
#pragma unroll
                    for (int bj = 0; bj < 2; ++bj) { U4 w; w.x = cvt_pk_bf16(acc[ai][bj][m][0][0], acc[ai][bj][m][0][1]); w.y = cvt_pk_bf16(acc[ai][bj][m][0][2], acc[ai][bj][m][0][3]);
                        w.z = cvt_pk_bf16(acc[ai][bj][m][1][0], acc[ai][bj][m][1][1]); w.w = cvt_pk_bf16(acc[ai][bj][m][1][2], acc[ai][bj][m][1][3]);
                        *(U4*)(base + (size_t)(ai * 128 + m * 16) * ZS + bj * 128) = w; }
        } else {
            const int b = (u.pm * 256) / NTOK, p0 = (u.pm * 256) % NTOK + wr * 64 + fr;
            const int cc0 = u.pn * 256 - ZS + wc * 32 + fq * 8;
            bf16_t* base = (cc0 < 256) ? navt + (size_t)(b * 256 + cc0) * NTOK : gvt + (size_t)(b * 512 + cc0 - 256) * NTOK;
#pragma unroll
            for (int ai = 0; ai < 2; ++ai)
#pragma unroll
                for (int m = 0; m < 4; ++m)
#pragma unroll
                    for (int bj = 0; bj < 2; ++bj)
#pragma unroll
                        for (int n = 0; n < 2; ++n)
#pragma unroll
                            for (int j = 0; j < 4; ++j) base[(size_t)(bj * 128 + n * 4 + j) * NTOK + p0 + ai * 128 + m * 16] = f2bf(acc[ai][bj][m][n][j]);
        }
    }
};

constexpr int MT_ALL = MTOT / 128;
constexpr int MT_LAT = BATCH * (SEQ / 128);
DEV int lat_tile_m0(int t) { int b = t / (SEQ / 128), w = t % (SEQ / 128); return b * NTOK + CTX_LEN + w * 128; }

constexpr int UP_RS_OFF = 2 * 128 * (256 + 8) * 2;
static_assert(UP_RS_OFF + 128 * 4 <= LDS_MISC, "lds");
template <int K> struct UpLd { U4 a[K / 32], b[K / 32]; };
template <int K> DEV UpLd<K> up_load(const bf16_t* A, const bf16_t* Bt) {
    const int tid = ltid(), row = tid >> 2, pc = tid & 3; UpLd<K> r;
#pragma unroll
    for (int i = 0; i < K / 32; ++i) { r.a[i] = *(const U4*)(A + (size_t)row * D_IN_PAD + (pc + 4 * i) * 8); r.b[i] = *(const U4*)(Bt + (size_t)row * K + (pc + 4 * i) * 8); }
    return r;
}
template <int K> DEV void up_stage(char* smem, const UpLd<K>& ld) {
    constexpr int RS_ = K + 8;
    bf16_t* As = (bf16_t*)smem; bf16_t* Bs = As + 128 * RS_; float* rs = (float*)(smem + UP_RS_OFF);
    const int tid = ltid(), row = tid >> 2, pc = tid & 3;
    float ss = 0.f;
#pragma unroll
    for (int i = 0; i < K / 32; ++i) { *(U4*)(As + row * RS_ + (pc + 4 * i) * 8) = ld.a[i]; *(U4*)(Bs + row * RS_ + (pc + 4 * i) * 8) = ld.b[i];
#pragma unroll
        for (int q = 0; q < 4; ++q) { const float lo = bf2f((bf16_t)(ld.a[i][q] & 0xFFFF)), hi = bf2f((bf16_t)(ld.a[i][q] >> 16)); ss += lo * lo + hi * hi; } }
    ss += __shfl_xor(ss, 1); ss += __shfl_xor(ss, 2);
    if (pc == 0) rs[row] = rsqrtf(ss / K + EPS);
}
template <int K> DEV void up_mma(f32x4 (&acc)[4][2], const char* smem, bool tr) {
    constexpr int RS_ = K + 8;
    const bf16_t* As = (const bf16_t*)smem; const bf16_t* Bs = As + 128 * RS_;
    const int tid = ltid(), lane = tid & 63, wave = tid >> 6, wr = wave >> 2, wc = wave & 3;
    acc_zero(acc);
    if (tr) {
#pragma unroll
        for (int kk = 0; kk < K / 32; ++kk) { bf16x8 a[4], b[2];
#pragma unroll
            for (int mi = 0; mi < 4; ++mi) a[mi] = *(const bf16x8*)(As + (wr * 64 + mi * 16 + (lane & 15)) * RS_ + kk * 32 + (lane >> 4) * 8);
#pragma unroll
            for (int ni = 0; ni < 2; ++ni) b[ni] = *(const bf16x8*)(Bs + (wc * 32 + ni * 16 + (lane & 15)) * RS_ + kk * 32 + (lane >> 4) * 8);
#pragma unroll
            for (int mi = 0; mi < 4; ++mi)
#pragma unroll
                for (int ni = 0; ni < 2; ++ni) acc[mi][ni] = __builtin_amdgcn_mfma_f32_16x16x32_bf16(b[ni], a[mi], acc[mi][ni], 0, 0, 0); }
    } else {
#pragma unroll
        for (int kk = 0; kk < K / 32; ++kk) { bf16x8 a[4], b[2];
#pragma unroll
            for (int mi = 0; mi < 4; ++mi) a[mi] = *(const bf16x8*)(As + (wr * 64 + mi * 16 + (lane & 15)) * RS_ + kk * 32 + (lane >> 4) * 8);
#pragma unroll
            for (int ni = 0; ni < 2; ++ni) b[ni] = *(const bf16x8*)(Bs + (wc * 32 + ni * 16 + (lane & 15)) * RS_ + kk * 32 + (lane >> 4) * 8);
#pragma unroll
            for (int mi = 0; mi < 4; ++mi)
#pragma unroll
                for (int ni = 0; ni < 2; ++ni) acc[mi][ni] = __builtin_amdgcn_mfma_f32_16x16x32_bf16(a[mi], b[ni], acc[mi][ni], 0, 0, 0); }
    }
}
DEV void p3_qup_epilogue(const Ctx& c, const f32x4 (&acc)[4][2], int m0, int tn) {
    const int n0 = tn * 128;
    const int tid = ltid(), lane = tid & 63, wave = tid >> 6, wr = wave >> 2, wc = wave & 3, q4 = lane >> 4;
    const float* rs = (const float*)(c.smem + UP_RS_OFF);
    const int b = m0 / NTOK, pbase = m0 % NTOK;
    const int cb = n0 + wc * 32;
    const int hh = cb / 96, wofs = cb % 96;
    bf16_t* Q = (bf16_t*)(c.ws() + WS_MQ) + ((size_t)b * 4 + hh) * NTOK * 96;
    const float qscale = 0.10206207261596575f * 1.4426950408889634f;
    float invf[4];
#pragma unroll
    for (int j = 0; j < 4; ++j) invf[j] = __expf(-(float)(((q4 & 1) * 4 + j)) * (9.210340371976184f / 8.0f));
#pragma unroll
    for (int mi = 0; mi < 4; ++mi) {
        const int rl = wr * 64 + mi * 16 + (lane & 15), p = pbase + rl;
        const float r = rs[rl] * qscale;
        float v0[4], v1[4];
#pragma unroll
        for (int j = 0; j < 4; ++j) { v0[j] = acc[mi][0][j] * r; v1[j] = acc[mi][1][j] * r; }
        if (wofs == 64 && p >= CTX_LEN) {
            const int t = p - CTX_LEN; const float pos = (float)((q4 < 2) ? (t / GRID_W) : (t % GRID_W));
#pragma unroll
            for (int j = 0; j < 4; ++j) { const float ang = pos * invf[j], cs = __cosf(ang), sn = __sinf(ang);
                const float o0 = v0[j] * cs - v1[j] * sn, o1 = v0[j] * sn + v1[j] * cs; v0[j] = o0; v1[j] = o1; }
        }
        U2 w0, w1; w0.x = pack2(v0[0], v0[1]); w0.y = pack2(v0[2], v0[3]); w1.x = pack2(v1[0], v1[1]); w1.y = pack2(v1[2], v1[3]);
        *(U2*)(Q + (size_t)p * 96 + wofs + q4 * 4) = w0; *(U2*)(Q + (size_t)p * 96 + wofs + 16 + q4 * 4) = w1;
    }
}
DEV void p3_kvup_epilogue(const Ctx& c, const f32x4 (&acc)[4][2], int m0, int tn) {
    const int tid = ltid(), lane = tid & 63, wave = tid >> 6, wr = wave >> 2, wc = wave & 3, q4 = lane >> 4;
    const float* rs = (const float*)(c.smem + UP_RS_OFF);
    const int b = m0 / NTOK, pbase = m0 % NTOK, hh = tn;
    bf16_t* Kp = (bf16_t*)(c.ws() + WS_MK) + ((size_t)b * 4 + hh) * NTOK * 96;
    bf16_t* Vt = (bf16_t*)(c.ws() + WS_MVT) + ((size_t)b * 4 + hh) * 64 * NTOK;
    if (wc < 2) {
#pragma unroll
        for (int mi = 0; mi < 4; ++mi) { const int rl = wr * 64 + mi * 16 + (lane & 15); const float r = rs[rl];
#pragma unroll
            for (int ni = 0; ni < 2; ++ni) { U2 pk; pk.x = pack2(acc[mi][ni][0] * r, acc[mi][ni][1] * r); pk.y = pack2(acc[mi][ni][2] * r, acc[mi][ni][3] * r);
                *(U2*)(Kp + (size_t)(pbase + rl) * 96 + wc * 32 + ni * 16 + q4 * 4) = pk; } }
    } else {
#pragma unroll
        for (int ni = 0; ni < 2; ++ni) { const int cl = wc * 32 + ni * 16 + (lane & 15);
#pragma unroll
            for (int mi = 0; mi < 4; ++mi) { const int rl0 = wr * 64 + mi * 16 + q4 * 4;
                U2 pk; pk.x = pack2(acc[mi][ni][0] * rs[rl0], acc[mi][ni][1] * rs[rl0 + 1]); pk.y = pack2(acc[mi][ni][2] * rs[rl0 + 2], acc[mi][ni][3] * rs[rl0 + 3]);
                *(U2*)(Vt + (size_t)(cl - 64) * NTOK + pbase + rl0) = pk; } }
    }
}
template <bool Q> DEV void p3_up_range(const Ctx& c, int r, int n, int G, bool ctxo) {
    constexpr int K = Q ? 256 : 128, NT = Q ? 3 : 4;
    const int l = c.layer;
    const bf16_t* A = (const bf16_t*)(c.ws() + WS_Z) + (Q ? ZDQ : ZDKV);
    const bf16_t* Bt = Q ? (const bf16_t*)(c.ws() + WS_WUQ) + (size_t)l * 384 * 256 : (const bf16_t*)(c.ws() + WS_WUKV) + (size_t)l * 512 * 128;
    int m0 = Q ? (ctxo ? (r / NT) * 128 : lat_tile_m0(r / NT)) : (r / NT) * 128, tn = r % NT;
    UpLd<K> cur = up_load<K>(A + (size_t)m0 * D_IN_PAD, Bt + (size_t)tn * 128 * K);
    for (;;) {
        __syncthreads();
        up_stage<K>(c.smem, cur);
        __syncthreads();
        const int rn = r + G; const bool more = rn < n; const int rx = more ? rn : r;
        const int m0n = Q ? (ctxo ? (rx / NT) * 128 : lat_tile_m0(rx / NT)) : (rx / NT) * 128, tnn = rx % NT;
        const UpLd<K> nxt = up_load<K>(A + (size_t)m0n * D_IN_PAD, Bt + (size_t)tnn * 128 * K);
        SCHED_FENCE();
        f32x4 acc[4][2];
        const bool tr = Q || ((ltid() >> 6) & 3) < 2;
        up_mma<K>(acc, c.smem, tr);
        if (Q) p3_qup_epilogue(c, acc, m0, tn); else p3_kvup_epilogue(c, acc, m0, tn);
        if (!more) break;
        SCHED_FENCE();
        cur = nxt; r = rn; m0 = m0n; tn = tnn;
    }
}
DEV void p3_krope_item(const Ctx& c, int item) {
    const int tid = ltid(), grow = item * 16 + (tid >> 5), j = tid & 31;
    const int b = grow / NTOK, p = grow % NTOK;
    const bf16_t* z = (const bf16_t*)(c.ws() + WS_Z) + (size_t)grow * D_IN_PAD + ZKR;
    float v = bf2f(z[j]);
    if (p >= CTX_LEN) {
        const float other = bf2f(z[j ^ 16]);
        const int t = p - CTX_LEN; const float pos = (float)(((j & 15) < 8) ? (t / GRID_W) : (t % GRID_W));
        const float invf = __expf(-(float)(j & 7) * (9.210340371976184f / 8.0f));
        const float ang = pos * invf, cs = __cosf(ang), sn = __sinf(ang);
        v = (j < 16) ? (v * cs - other * sn) : (other * sn + v * cs);
    }
    const bf16_t o = f2bf(v);
#pragma unroll
    for (int hh = 0; hh < 4; ++hh) ((bf16_t*)(c.ws() + WS_MK))[(((size_t)b * 4 + hh) * NTOK + p) * 96 + 64 + j] = o;
}

DEV int xcd_item(int m, int nbh, int nqb) {
    const int xcd = m & 7, slot = m >> 3, bh = xcd * (nbh >> 3) + slot / nqb, qb = slot % nqb; return bh * nqb + qb;
}
static_assert((BATCH * 4) % 8 == 0, "xcd item map");
typedef float f32x16 __attribute__((ext_vector_type(16)));
typedef short bf16x4 __attribute__((ext_vector_type(4)));
constexpr int NA_LAT_ITEMS = BATCH * 4 * (ROWS / 4), NA_CTX_ITEMS = BATCH * 4 * (CTX_LEN / 256);
constexpr int NA_TB = 64 * GS * 2, NA_BUF = 2 * NA_TB;
static_assert(ROWS % 4 == 0, "na rows");
DEV int na_rs(int r) { int rs = r - 4; return rs < 0 ? 0 : (rs > ROWS - 8 ? ROWS - 8 : rs); }
DEV void p3_na_item(const Ctx& c, int item) {
    const int tid = ltid(), lane = tid & 63, wv = tid >> 6, lr = lane & 31, lh = lane >> 5, l = c.layer;
    const bf16_t* Z = (const bf16_t*)(c.ws() + WS_Z);
    int b, hh, q0, r = 0, rs = 0, qcol = 0, wlo = 0, nloc = 0; bool lat;
    if (item < NA_LAT_ITEMS) { lat = true; item = xcd_item(item, BATCH * 4, ROWS / 4); const int rg = item % (ROWS / 4); hh = (item / (ROWS / 4)) & 3; b = item / (ROWS / 4) / 4;
        r = rg * 4 + (wv >> 1); rs = na_rs(r); wlo = na_rs(rg * 4); nloc = na_rs(rg * 4 + 3) + 8 - wlo; q0 = CTX_LEN + r * GRID_W + (wv & 1) * 32; qcol = (wv & 1) * 32 + lr; }
    else { lat = false; const int it = item - NA_LAT_ITEMS; const int qb = it % (CTX_LEN / 256); hh = (it / (CTX_LEN / 256)) & 3; b = it / (CTX_LEN / 256) / 4; q0 = qb * 256 + wv * 32; }
    const size_t tok0 = (size_t)b * NTOK;
    bf16x8 q[4];
#pragma unroll
    for (int ks = 0; ks < 4; ++ks) q[ks] = *(const bf16x8*)(Z + (tok0 + q0 + lr) * ZS + ZQA + hh * 64 + ks * 16 + lh * 8);
    const bf16_t* Kg = Z + tok0 * ZS + ZKA + hh * 64;
    const bf16_t* Vg = (const bf16_t*)(c.ws() + WS_NAVT) + ((size_t)b * 4 + hh) * 64 * NTOK;
    float* rpb = (float*)(c.smem + 2 * NA_BUF);
    const int nstep = nloc + CTX_LEN / 64;
    const int sr = tid >> 3, sc8 = (tid & 7) * 8;
#define NA_TOK(i) ((i) < nloc ? CTX_LEN + (wlo + (i)) * GRID_W : ((i) - nloc) * 64)
    U4 rk, rv;
    { const int t0 = NA_TOK(0); rk = *(const U4*)(Kg + (size_t)(t0 + sr) * ZS + sc8); rv = *(const U4*)(Vg + (size_t)sr * NTOK + t0 + sc8); }
    __syncthreads();
    { bf16_t* kb = (bf16_t*)c.smem; bf16_t* vb = (bf16_t*)(c.smem + NA_TB); *(U4*)(kb + sr * GS + sc8) = rk; *(U4*)(vb + sr * GS + sc8) = rv;
      if (tid < 15 * 31) rpb[tid] = c.in(I_RPB)[((size_t)l * 4 + hh) * 15 * 31 + tid] * 1.4426950408889634f; }
    __syncthreads();
    f32x16 o[2]; float m = -1e30f, lsum = 0.f;
#pragma unroll
    for (int i = 0; i < 16; ++i) { o[0][i] = 0.f; o[1][i] = 0.f; }
    int cs = qcol - 8; cs = cs < 0 ? 0 : (cs > GRID_W - 16 ? GRID_W - 16 : cs);
    for (int i = 0; i < nstep; ++i) {
        const bf16_t* kb = (const bf16_t*)(c.smem + (i & 1) * NA_BUF); const bf16_t* vb = (const bf16_t*)(c.smem + (i & 1) * NA_BUF + NA_TB);
        if (i + 1 < nstep) { const int t1 = NA_TOK(i + 1); rk = *(const U4*)(Kg + (size_t)(t1 + sr) * ZS + sc8); rv = *(const U4*)(Vg + (size_t)sr * NTOK + t1 + sc8); }
        const bool local = i < nloc; const int wrow = wlo + i;
        if (!local || (lat && wrow >= rs && wrow < rs + 8)) {
            f32x16 st[2];
#pragma unroll
            for (int t = 0; t < 2; ++t) {
#pragma unroll
                for (int k = 0; k < 16; ++k) st[t][k] = 0.f;
#pragma unroll
                for (int ks = 0; ks < 4; ++ks) { const bf16x8 a = *(const bf16x8*)(kb + (t * 32 + lr) * GS + ks * 16 + lh * 8); st[t] = __builtin_amdgcn_mfma_f32_32x32x16_bf16(a, q[ks], st[t], 0, 0, 0); }
            }
            const float SCL = 0.125f * 1.4426950408889634f;
            const float* rrow = rpb + (wrow - r + 7) * 31 - qcol + 15;
            float mx = -1e30f;
            if (local) {
#pragma unroll
                for (int t = 0; t < 2; ++t)
#pragma unroll
                    for (int k = 0; k < 16; ++k) { const int kc = t * 32 + (k & 3) + 8 * (k >> 2) + 4 * lh; const int rel = kc - cs;
                        const float bias = rrow[cs + (rel < 0 ? 0 : (rel > 15 ? 15 : rel))];
                        const float pen = (rel >= 0 && rel < 16) ? 0.f : -1e30f;
                        const float v = st[t][k] * SCL + bias + pen; st[t][k] = v; mx = fmaxf(mx, v); }
            } else {
#pragma unroll
                for (int t = 0; t < 2; ++t)
#pragma unroll
                    for (int k = 0; k < 16; ++k) { const float v = st[t][k] * SCL; st[t][k] = v; mx = fmaxf(mx, v); }
            }
            mx = fmaxf(mx, __shfl_xor(mx, 32));
            const float mn = fmaxf(m, mx), alpha = fast_exp2(m - mn); m = mn;
            float rsum = 0.f; bf16x8 pf[4];
#pragma unroll
            for (int t = 0; t < 2; ++t)
#pragma unroll
                for (int s2 = 0; s2 < 2; ++s2) { U4 pk;
#pragma unroll
                    for (int j = 0; j < 4; ++j) { const float p0 = fast_exp2(st[t][s2 * 8 + 2 * j] - mn), p1 = fast_exp2(st[t][s2 * 8 + 2 * j + 1] - mn); rsum += p0 + p1; pk[j] = cvt_pk_bf16(p0, p1); }
                    pf[t * 2 + s2] = __builtin_bit_cast(bf16x8, pk); }
            lsum = lsum * alpha + rsum;
            if (__ballot(alpha != 1.0f) != 0ull) {
#pragma unroll
                for (int k = 0; k < 16; ++k) { o[0][k] *= alpha; o[1][k] *= alpha; } }
#pragma unroll
            for (int ks = 0; ks < 4; ++ks)
#pragma unroll
                for (int dt = 0; dt < 2; ++dt) { const bf16_t* vp = vb + (dt * 32 + lr) * GS + ks * 16 + lh * 4;
                    const bf16x4 v0 = *(const bf16x4*)vp, v1 = *(const bf16x4*)(vp + 8);
                    bf16x8 a; a[0] = v0[0]; a[1] = v0[1]; a[2] = v0[2]; a[3] = v0[3]; a[4] = v1[0]; a[5] = v1[1]; a[6] = v1[2]; a[7] = v1[3];
                    o[dt] = __builtin_amdgcn_mfma_f32_32x32x16_bf16(a, pf[ks], o[dt], 0, 0, 0); }
        }
        if (i + 1 < nstep) { bf16_t* kn = (bf16_t*)(c.smem + ((i + 1) & 1) * NA_BUF); bf16_t* vn = (bf16_t*)(c.smem + ((i + 1) & 1) * NA_BUF + NA_TB); *(U4*)(kn + sr * GS + sc8) = rk; *(U4*)(vn + sr * GS + sc8) = rv; }
        __syncthreads();
    }
#undef NA_TOK
    const float inv = 1.0f / (lsum + __shfl_xor(lsum, 32));
    bf16_t* out = (bf16_t*)(c.ws() + WS_OCAT) + (tok0 + q0 + lr) * 1024 + hh * 64;
#pragma unroll
    for (int dt = 0; dt < 2; ++dt)
#pragma unroll
        for (int rg = 0; rg < 4; ++rg) { U2 w; w.x = pack2(o[dt][rg * 4 + 0] * inv, o[dt][rg * 4 + 1] * inv); w.y = pack2(o[dt][rg * 4 + 2] * inv, o[dt][rg * 4 + 3] * inv);
            *(U2*)(out + dt * 32 + rg * 8 + lh * 4) = w; }
}
constexpr int MLA_KS = 104, MLA_VS = 72;
constexpr int MLA_KBYTES = 64 * MLA_KS * 2, MLA_VBYTES = 64 * MLA_VS * 2, MLA_BUF = MLA_KBYTES + MLA_VBYTES;
constexpr int MLA_LAT_ITEMS = BATCH * 4 * (SEQ / 256), MLA_CTX_ITEMS = BATCH * 4 * (CTX_LEN / 256);
DEV void p4_mla_item(const Ctx& c, int item) {
    const int tid = ltid(), lane = tid & 63, wv = tid >> 6, lr = lane & 31, lh = lane >> 5;
    int b, hh, q0, nkeys;
    if (item < MLA_LAT_ITEMS) { item = xcd_item(item, BATCH * 4, SEQ / 256); const int qb = item % (SEQ / 256); hh = (item / (SEQ / 256)) & 3; b = item / (SEQ / 256) / 4; q0 = CTX_LEN + qb * 256; nkeys = NTOK; }
    else { const int it = item - MLA_LAT_ITEMS; const int qb = it % (CTX_LEN / 256); hh = (it / (CTX_LEN / 256)) & 3; b = it / (CTX_LEN / 256) / 4; q0 = qb * 256; nkeys = CTX_LEN; }
    const bf16_t* Q = (const bf16_t*)(c.ws() + WS_MQ) + ((size_t)b * 4 + hh) * NTOK * 96;
    const bf16_t* K = (const bf16_t*)(c.ws() + WS_MK) + ((size_t)b * 4 + hh) * NTOK * 96;
    const bf16_t* Vt = (const bf16_t*)(c.ws() + WS_MVT) + ((size_t)b * 4 + hh) * 64 * NTOK;
    bf16x8 q[6];
#pragma unroll
    for (int ks = 0; ks < 6; ++ks) q[ks] = *(const bf16x8*)(Q + (size_t)(q0 + wv * 32 + lr) * 96 + ks * 16 + lh * 8);
    const int kr0 = tid / 12, kc0 = (tid % 12) * 8, kr1 = (512 + tid) / 12, kc1 = ((512 + tid) % 12) * 8, vr = tid >> 3, vc = (tid & 7) * 8;
    U4 rk0, rk1, rv;
    rk0 = *(const U4*)(K + (size_t)kr0 * 96 + kc0); if (tid < 256) rk1 = *(const U4*)(K + (size_t)kr1 * 96 + kc1); rv = *(const U4*)(Vt + (size_t)vr * NTOK + vc);
    __syncthreads();
    { bf16_t* kb = (bf16_t*)c.smem; bf16_t* vb = (bf16_t*)(c.smem + MLA_KBYTES);
      *(U4*)(kb + kr0 * MLA_KS + kc0) = rk0; if (tid < 256) *(U4*)(kb + kr1 * MLA_KS + kc1) = rk1; *(U4*)(vb + vr * MLA_VS + vc) = rv; }
    __syncthreads();
    f32x16 o[2]; float m = -1e30f, lsum = 0.f;
#pragma unroll
    for (int i = 0; i < 16; ++i) { o[0][i] = 0.f; o[1][i] = 0.f; }
    const int ntile = nkeys / 64;
    for (int kt = 0; kt < ntile; ++kt) {
        const bf16_t* kb = (const bf16_t*)(c.smem + (kt & 1) * MLA_BUF); const bf16_t* vb = (const bf16_t*)(c.smem + (kt & 1) * MLA_BUF + MLA_KBYTES);
        if (kt + 1 < ntile) { const int t1 = (kt + 1) * 64;
            rk0 = *(const U4*)(K + (size_t)(t1 + kr0) * 96 + kc0); if (tid < 256) rk1 = *(const U4*)(K + (size_t)(t1 + kr1) * 96 + kc1); rv = *(const U4*)(Vt + (size_t)vr * NTOK + t1 + vc); }
        f32x16 st[2];
#pragma unroll
        for (int t = 0; t < 2; ++t) {
#pragma unroll
            for (int i = 0; i < 16; ++i) st[t][i] = 0.f;
#pragma unroll
            for (int ks = 0; ks < 6; ++ks) { const bf16x8 a = *(const bf16x8*)(kb + (t * 32 + lr) * MLA_KS + ks * 16 + lh * 8); st[t] = __builtin_amdgcn_mfma_f32_32x32x16_bf16(a, q[ks], st[t], 0, 0, 0); }
        }
        float mx = st[0][0];
#pragma unroll
        for (int t = 0; t < 2; ++t)
#pragma unroll
            for (int i = 0; i < 16; ++i) mx = fmaxf(mx, st[t][i]);
        mx = fmaxf(mx, __shfl_xor(mx, 32));
        const float mn = fmaxf(m, mx), alpha = fast_exp2(m - mn); m = mn;
        float rs = 0.f;
        bf16x8 pf[4];
#pragma unroll
        for (int t = 0; t < 2; ++t)
#pragma unroll
            for (int s2 = 0; s2 < 2; ++s2) { U4 pk;
#pragma unroll
                for (int j = 0; j < 4; ++j) { const float p0 = fast_exp2(st[t][s2 * 8 + 2 * j] - mn), p1 = fast_exp2(st[t][s2 * 8 + 2 * j + 1] - mn); rs += p0 + p1; pk[j] = cvt_pk_bf16(p0, p1); }
                pf[t * 2 + s2] = __builtin_bit_cast(bf16x8, pk); }
        lsum = lsum * alpha + rs;
        if (__ballot(alpha != 1.0f) != 0ull) {
#pragma unroll
            for (int i = 0; i < 16; ++i) { o[0][i] *= alpha; o[1][i] *= alpha; } }
#pragma unroll
        for (int ks = 0; ks < 4; ++ks)
#pragma unroll
            for (int dt = 0; dt < 2; ++dt) {
                const bf16_t* vp = vb + (dt * 32 + lr) * MLA_VS + ks * 16 + lh * 4;
                const bf16x4 v0 = *(const bf16x4*)vp, v1 = *(const bf16x4*)(vp + 8);
                bf16x8 a; a[0] = v0[0]; a[1] = v0[1]; a[2] = v0[2]; a[3] = v0[3]; a[4] = v1[0]; a[5] = v1[1]; a[6] = v1[2]; a[7] = v1[3];
                o[dt] = __builtin_amdgcn_mfma_f32_32x32x16_bf16(a, pf[ks], o[dt], 0, 0, 0);
            }
        if (kt + 1 < ntile) { bf16_t* kn = (bf16_t*)(c.smem + ((kt + 1) & 1) * MLA_BUF); bf16_t* vn = (bf16_t*)(c.smem + ((kt + 1) & 1) * MLA_BUF + MLA_KBYTES);
            *(U4*)(kn + kr0 * MLA_KS + kc0) = rk0; if (tid < 256) *(U4*)(kn + kr1 * MLA_KS + kc1) = rk1; *(U4*)(vn + vr * MLA_VS + vc) = rv; }
        __syncthreads();
    }
    const float inv = 1.0f / (lsum + __shfl_xor(lsum, 32));
    bf16_t* out = (bf16_t*)(c.ws() + WS_OCAT) + ((size_t)b * NTOK + q0 + wv * 32 + lr) * 1024 + 256 + hh * 64;
#pragma unroll
    for (int dt = 0; dt < 2; ++dt)
#pragma unroll
        for (int rg = 0; rg < 4; ++rg) { U2 w; w.x = pack2(o[dt][rg * 4 + 0] * inv, o[dt][rg * 4 + 1] * inv); w.y = pack2(o[dt][rg * 4 + 2] * inv, o[dt][rg * 4 + 3] * inv);
            *(U2*)(out + dt * 32 + rg * 8 + lh * 4) = w; }
}

constexpr int BCS = 65, BCD = 64 * BCS;
constexpr int GL_B = 0;
constexpr int GL_X0 = 33280;
static_assert(2 * BCD * 4 <= GL_X0 && GL_X0 % 16 == 0, "bc");
struct GateLd { U4 bh, bl, a0, a1, a2, a3; float bias; };
DEV GateLd gla_gates_load(const Ctx& c, int b, int hh, int ch) {
    const int tid = ltid(), lane = tid & 63, wv = tid >> 6, l = c.layer, lr = lane & 15, q4 = lane >> 4;
    const int dir = wv >> 2, dblk = (wv & 3) * 16;
    const bf16_t* Z = (const bf16_t*)(c.ws() + WS_Z) + ((size_t)b * NTOK + ch * 64) * ZS + (dir == 0 ? ZAF : ZAB);
    const bf16_t* wt = (const bf16_t*)(c.ws() + WS_WGT) + ((size_t)(l * 2 + dir) * 2 * 256 + hh * 64 + dblk + lr) * 16;
    const int qc = q4 & 1;
    GateLd g;
    g.bh = *(const U4*)(wt + qc * 8); g.bl = *(const U4*)(wt + 256 * 16 + qc * 8);
    g.a0 = *(const U4*)(Z + (size_t)(0 * 16 + lr) * ZS + qc * 8); g.a1 = *(const U4*)(Z + (size_t)(1 * 16 + lr) * ZS + qc * 8);
    g.a2 = *(const U4*)(Z + (size_t)(2 * 16 + lr) * ZS + qc * 8); g.a3 = *(const U4*)(Z + (size_t)(3 * 16 + lr) * ZS + qc * 8);
    const float* pf = c.in(I_BAF); const float* pb = c.in(I_BAB);
    g.bias = (dir == 0 ? pf : pb)[l * 256 + hh * 64 + dblk + lr];
    return g;
}
DEV void gla_gates_compute(const Ctx& c, const GateLd& g) {
    const int tid = ltid(), lane = tid & 63, wv = tid >> 6, lr = lane & 15, q4 = lane >> 4;
    const int dir = wv >> 2, dblk = (wv & 3) * 16;
    float* bc = (float*)(c.smem + GL_B);
    const uint32_t kmask = q4 < 2 ? 0xFFFFFFFFu : 0u;
    const float bias = g.bias;
    U4 ar[4]; ar[0] = g.a0; ar[1] = g.a1; ar[2] = g.a2; ar[3] = g.a3;
    const U4 bhr = g.bh & kmask, blr = g.bl & kmask;
    const bf16x8 bh = __builtin_bit_cast(bf16x8, bhr), bl = __builtin_bit_cast(bf16x8, blr);
    f32x4 z[4];
#pragma unroll
    for (int mt = 0; mt < 4; ++mt) { const bf16x8 a = __builtin_bit_cast(bf16x8, ar[mt] & kmask);
        z[mt] = f32x4{bias, bias, bias, bias};
        z[mt] = __builtin_amdgcn_mfma_f32_16x16x32_bf16(a, bh, z[mt], 0, 0, 0); z[mt] = __builtin_amdgcn_mfma_f32_16x16x32_bf16(a, bl, z[mt], 0, 0, 0); }
    float S[4];
#pragma unroll
    for (int mt = 0; mt < 4; ++mt) { S[mt] = 0.f;
#pragma unroll
        for (int j = 0; j < 4; ++j) { const float x = z[mt][j]; const float g = (fminf(x, 0.0f) - __logf(1.0f + __expf(-fabsf(x)))) * (1.0f / 16.0f); z[mt][j] = g; S[mt] += g; } }
    float off[4];
    { float x1[4], x2[4], x3[4], T[4];
#pragma unroll
      for (int mt = 0; mt < 4; ++mt) { x1[mt] = __shfl_xor(S[mt], 16); x2[mt] = __shfl_xor(S[mt], 32); x3[mt] = __shfl_xor(S[mt], 48); T[mt] = S[mt] + x1[mt] + x2[mt] + x3[mt]; }
#pragma unroll
      for (int mt = 0; mt < 4; ++mt) {
          float o;
          if (dir == 0) { o = ((q4 & 1) ? x1[mt] : 0.f) + ((q4 & 2) ? x2[mt] + x3[mt] : 0.f);
#pragma unroll
              for (int m2 = 0; m2 < 4; ++m2) if (m2 < mt) o += T[m2]; }
          else { o = ((q4 & 1) ? 0.f : x1[mt]) + ((q4 & 2) ? 0.f : x2[mt] + x3[mt]);
#pragma unroll
              for (int m2 = 0; m2 < 4; ++m2) if (m2 > mt) o += T[m2]; }
          off[mt] = o; } }
    __syncthreads();
#pragma unroll
    for (int mt = 0; mt < 4; ++mt) {
        float run = off[mt];
        if (dir == 0) {
#pragma unroll
            for (int j = 0; j < 4; ++j) { run += z[mt][j]; bc[(mt * 16 + q4 * 4 + j) * BCS + dblk + lr] = run; }
        } else {
#pragma unroll
            for (int j = 3; j >= 0; --j) { run += z[mt][j]; bc[BCD + (mt * 16 + q4 * 4 + j) * BCS + dblk + lr] = run; }
        }
    }
    __syncthreads();
}
constexpr int G1_ITEMS = BATCH * 4 * NCH;
struct G1Pre { GateLd gl; U4 kraw; };
DEV G1Pre g1_prefetch(const Ctx& c, int item) {
    const int ch = item % NCH, hh = (item / NCH) & 3, b = item / NCH / 4; const int tid = ltid();
    G1Pre p; p.gl = gla_gates_load(c, b, hh, ch);
    p.kraw = *(const U4*)((const bf16_t*)(c.ws() + WS_Z) + ((size_t)b * NTOK + ch * 64 + (tid & 63)) * ZS + ZGK + hh * 64 + (tid >> 6) * 8);
    return p;
}
DEV void p3_gla_g1_body(const Ctx& c, int item, const G1Pre& cur, int nitem, G1Pre& nxt) {
    const int ch = item % NCH, hh = (item / NCH) & 3, b = item / NCH / 4;
    const int tid = ltid(), lane = tid & 63, wave = tid >> 6, lr = lane & 15, lq = lane >> 4;
    const bf16_t* Vt = (const bf16_t*)(c.ws() + WS_GVT) + ((size_t)b * 4 + hh) * 128 * NTOK + ch * 64;
    U4 vfr[2][8];
#pragma unroll
    for (int ks = 0; ks < 2; ++ks)
#pragma unroll
        for (int nt = 0; nt < 8; ++nt) vfr[ks][nt] = *(const U4*)(Vt + (size_t)(nt * 16 + lr) * NTOK + ks * 32 + lq * 8);
    nxt = g1_prefetch(c, nitem);
    const GateLd gl = cur.gl; const U4 kraw = cur.kraw;
    SCHED_FENCE();
    gla_gates_compute(c, gl);
    const float* bc = (const float*)(c.smem + GL_B);
    bf16_t* kte = (bf16_t*)(c.smem + GL_X0);
    { const int sI = tid & 63, d0 = (tid >> 6) * 8;
#pragma unroll
      for (int dir = 0; dir < 2; ++dir) {
          const float* bl = bc + dir * BCD + (dir == 0 ? 63 * BCS : 0) + d0; const float* bs = bc + dir * BCD + sI * BCS + d0;
#pragma unroll
          for (int i = 0; i < 8; ++i) { const float kv = bf2f((bf16_t)((i & 1) ? (kraw[i >> 1] >> 16) : (kraw[i >> 1] & 0xFFFF)));
              kte[(dir * 64 + d0 + i) * GS + sI] = f2bf(kv * __expf(bl[i] - bs[i])); } } }
    __syncthreads();
    const int dir = wave >> 2, mt = wave & 3;
    f32x4 acc[8];
#pragma unroll
    for (int nt = 0; nt < 8; ++nt) acc[nt] = f32x4{0.f, 0.f, 0.f, 0.f};
#pragma unroll
    for (int ks = 0; ks < 2; ++ks) {
        const bf16x8 a = *(const bf16x8*)(kte + (dir * 64 + mt * 16 + lr) * GS + ks * 32 + lq * 8);
#pragma unroll
        for (int nt = 0; nt < 8; ++nt) acc[nt] = __builtin_amdgcn_mfma_f32_16x16x32_bf16(a, __builtin_bit_cast(bf16x8, vfr[ks][nt]), acc[nt], 0, 0, 0);
    }
    bf16_t* KV = (bf16_t*)(c.ws() + WS_EXP + GLA_KV) + ((((size_t)b * 4 + hh) * 2 + dir) * NCH + ch) * 64 * 128;
#pragma unroll
    for (int nt = 0; nt < 8; ++nt) { U2 w; w.x = pack2(acc[nt][0], acc[nt][1]); w.y = pack2(acc[nt][2], acc[nt][3]); *(U2*)(KV + (size_t)(nt * 16 + lr) * 64 + mt * 16 + lq * 4) = w; }
    if (tid < 128) { int dr = tid >> 6, d = tid & 63; ((float*)(c.ws() + WS_EXP + GLA_DEC))[((((size_t)b * 4 + hh) * 2 + dr) * NCH + ch) * 64 + d] = __expf(dr == 0 ? bc[63 * BCS + d] : bc[BCD + d]); }
}
DEV void p3_gla_g1_range(const Ctx& c, int r, int n, int G) {
    G1Pre cur = g1_prefetch(c, r);
    for (;;) {
        const int rn = r + G; const bool more = rn < n;
        G1Pre nxt; p3_gla_g1_body(c, r, cur, more ? rn : r, nxt);
        if (!more) break;
        SCHED_FENCE();
        cur = nxt; r = rn;
    }
}
constexpr int G2_ITEMS = BATCH * 4 * 2 * 4;
DEV int gla_order_chunk(int dir, int i) { if (dir == 0) return i; return (i < NCC) ? (NCC - 1 - i) : (NCH - 1 - (i - NCC)); }
DEV void p4_gla_g2_item(const Ctx& c, int item) {
    const int vq = item & 3, seq = item >> 2, dir = seq & 1;
    const int tid = ltid(), v = vq * 32 + (tid >> 4), d0 = (tid & 15) * 4;
    const bf16_t* KV = (const bf16_t*)(c.ws() + WS_EXP + GLA_KV) + (size_t)seq * NCH * 64 * 128;
    const float* DEC = (const float*)(c.ws() + WS_EXP + GLA_DEC) + (size_t)seq * NCH * 64;
    bf16_t* SP = (bf16_t*)(c.ws() + WS_EXP + GLA_SP) + (size_t)seq * NCH * 64 * 128;
    f32x4 s = f32x4{0.f, 0.f, 0.f, 0.f};
    constexpr int HB = NCH / 2; static_assert(NCH % 2 == 0, "g2 batches");
#pragma unroll 1
    for (int half = 0; half < 2; ++half) {
        U2 kvr[HB]; f32x4 dec[HB];
#pragma unroll
        for (int i = 0; i < HB; ++i) { const int n = gla_order_chunk(dir, half * HB + i); kvr[i] = *(const U2*)(KV + ((size_t)n * 128 + v) * 64 + d0); dec[i] = *(const f32x4*)(DEC + n * 64 + d0); }
#pragma unroll
        for (int i = 0; i < HB; ++i) { const int n = gla_order_chunk(dir, half * HB + i);
            U2 pk; pk.x = pack2(s[0], s[1]); pk.y = pack2(s[2], s[3]);
            *(U2*)(SP + ((size_t)n * 128 + v) * 64 + d0) = pk;
            const f32x4 kv = f32x4{bf2f((bf16_t)(kvr[i].x & 0xFFFF)), bf2f((bf16_t)(kvr[i].x >> 16)), bf2f((bf16_t)(kvr[i].y & 0xFFFF)), bf2f((bf16_t)(kvr[i].y >> 16))};
            s = dec[i] * s + kv; }
    }
}
constexpr int G3_QD = GL_X0;
constexpr int G3_KD = G3_QD + 2 * 64 * GS * 2;
constexpr int G3_AM = G3_KD + 2 * 64 * GS * 2;
constexpr int G3_SS = G3_AM + 2 * 64 * GS * 2;
static_assert(G3_SS + 64 * 2 * 4 <= LDS_MISC, "lds");
struct G3Pre { GateLd gl; U4 qraw, kraw; };
DEV G3Pre g3_prefetch(const Ctx& c, int b, int hh, int ch) {
    const int tid = ltid();
    G3Pre p; p.gl = gla_gates_load(c, b, hh, ch);
    const bf16_t* Z = (const bf16_t*)(c.ws() + WS_Z) + ((size_t)b * NTOK + ch * 64) * ZS;
    p.qraw = *(const U4*)(Z + (size_t)(tid >> 3) * ZS + ZGQ + hh * 64 + (tid & 7) * 8); p.kraw = *(const U4*)(Z + (size_t)(tid >> 3) * ZS + ZGK + hh * 64 + (tid & 7) * 8);
    return p;
}
DEV void p5_gla_g3_body(const Ctx& c, int b, int hh, int ch, const G3Pre& cur, int bn, int hn, int cn, G3Pre& nxt) {
    const int tid = ltid(), lane = tid & 63, wave = tid >> 6, lr = lane & 15, lq = lane >> 4, l = c.layer;
    const size_t row0 = (size_t)b * NTOK + ch * 64;
    const bf16_t* Z = (const bf16_t*)(c.ws() + WS_Z) + row0 * ZS;
    const int tt = wave & 3, vb = (wave >> 2) * 4;
    U4 avr[2][4], asr[2][2][4];
    { const bf16_t* Vt = (const bf16_t*)(c.ws() + WS_GVT) + ((size_t)b * 4 + hh) * 128 * NTOK + ch * 64;
      const bf16_t* SP = (const bf16_t*)(c.ws() + WS_EXP + GLA_SP);
#pragma unroll
      for (int ks = 0; ks < 2; ++ks)
#pragma unroll
          for (int nt = 0; nt < 4; ++nt) avr[ks][nt] = *(const U4*)(Vt + (size_t)((vb + nt) * 16 + lr) * NTOK + ks * 32 + lq * 8);
#pragma unroll
      for (int dir = 0; dir < 2; ++dir) { const bf16_t* spd = SP + ((((size_t)b * 4 + hh) * 2 + dir) * NCH + ch) * 128 * 64;
#pragma unroll
          for (int ks = 0; ks < 2; ++ks)
#pragma unroll
              for (int nt = 0; nt < 4; ++nt) asr[dir][ks][nt] = *(const U4*)(spd + (size_t)((vb + nt) * 16 + lr) * 64 + ks * 32 + lq * 8); } }
    nxt = g3_prefetch(c, bn, hn, cn);
    const GateLd gl = cur.gl; const U4 qraw = cur.qraw, kraw = cur.kraw;
    SCHED_FENCE();
    gla_gates_compute(c, gl);
    const float* bc = (const float*)(c.smem + GL_B);
    bf16_t* qd = (bf16_t*)(c.smem + G3_QD); bf16_t* kd = (bf16_t*)(c.smem + G3_KD); bf16_t* am = (bf16_t*)(c.smem + G3_AM);
    float* ssq = (float*)(c.smem + G3_SS);
    { const int t = tid >> 3, d0 = (tid & 7) * 8;
#pragma unroll
      for (int dir = 0; dir < 2; ++dir) { const float* bp = bc + dir * BCD + t * BCS + d0; U4 qo, ko;
#pragma unroll
          for (int i = 0; i < 4; ++i) { const float e0 = __expf(bp[2 * i]), e1 = __expf(bp[2 * i + 1]);
              qo[i] = pack2(bf2f((bf16_t)(qraw[i] & 0xFFFF)) * 0.125f * e0, bf2f((bf16_t)(qraw[i] >> 16)) * 0.125f * e1);
              ko[i] = pack2(bf2f((bf16_t)(kraw[i] & 0xFFFF)) * fast_rcp(e0), bf2f((bf16_t)(kraw[i] >> 16)) * fast_rcp(e1)); }
          *(U4*)(qd + (dir * 64 + t) * GS + d0) = qo; *(U4*)(kd + (dir * 64 + t) * GS + d0) = ko; } }
    __syncthreads();
    { const int dir = wave >> 2, stl = wave & 3;
      f32x4 a4[4];
#pragma unroll
      for (int nt = 0; nt < 4; ++nt) a4[nt] = f32x4{0.f, 0.f, 0.f, 0.f};
#pragma unroll
      for (int ks = 0; ks < 2; ++ks) { const bf16x8 a = *(const bf16x8*)(kd + (dir * 64 + stl * 16 + lr) * GS + ks * 32 + lq * 8);
#pragma unroll
          for (int nt = 0; nt < 4; ++nt) { bf16x8 qf = *(const bf16x8*)(qd + (dir * 64 + nt * 16 + lr) * GS + ks * 32 + lq * 8); a4[nt] = __builtin_amdgcn_mfma_f32_16x16x32_bf16(a, qf, a4[nt], 0, 0, 0); } }
#pragma unroll
      for (int nt = 0; nt < 4; ++nt) { const int t = nt * 16 + lr, s0 = stl * 16 + lq * 4; float o[4];
#pragma unroll
          for (int j = 0; j < 4; ++j) { const int sI = s0 + j; const bool keep = (dir == 0) ? (sI <= t) : (sI >= t); o[j] = keep ? a4[nt][j] : 0.f; }
          U2 w; w.x = pack2(o[0], o[1]); w.y = pack2(o[2], o[3]); *(U2*)(am + (dir * 64 + t) * GS + s0) = w; } }
    __syncthreads();
    const float* on = c.in(I_ONORM) + l * 128;
    const bf16_t* ogp = Z + (size_t)(tt * 16 + lr) * ZS + ZOG + hh * 128;
    U2 ogr[4]; f32x4 g4r[4];
#pragma unroll
    for (int nt = 0; nt < 4; ++nt) { const int v0 = (vb + nt) * 16 + lq * 4; ogr[nt] = *(const U2*)(ogp + v0); g4r[nt] = *(const f32x4*)(on + v0); }
    f32x4 o[4];
#pragma unroll
    for (int nt = 0; nt < 4; ++nt) o[nt] = f32x4{0.f, 0.f, 0.f, 0.f};
#pragma unroll
    for (int dir = 0; dir < 2; ++dir) {
#pragma unroll
        for (int ks = 0; ks < 2; ++ks) {
            const bf16x8 ba = *(const bf16x8*)(am + (dir * 64 + tt * 16 + lr) * GS + ks * 32 + lq * 8);
            const bf16x8 bq = *(const bf16x8*)(qd + (dir * 64 + tt * 16 + lr) * GS + ks * 32 + lq * 8);
#pragma unroll
            for (int nt = 0; nt < 4; ++nt) {
                o[nt] = __builtin_amdgcn_mfma_f32_16x16x32_bf16(__builtin_bit_cast(bf16x8, avr[ks][nt]), ba, o[nt], 0, 0, 0);
                o[nt] = __builtin_amdgcn_mfma_f32_16x16x32_bf16(__builtin_bit_cast(bf16x8, asr[dir][ks][nt]), bq, o[nt], 0, 0, 0);
            }
        }
    }
    { float ss = 0.f;
#pragma unroll
      for (int nt = 0; nt < 4; ++nt) ss += o[nt][0] * o[nt][0] + o[nt][1] * o[nt][1] + o[nt][2] * o[nt][2] + o[nt][3] * o[nt][3];
      ss += __shfl_xor(ss, 16); ss += __shfl_xor(ss, 32);
      if (lq == 0) ssq[(tt * 16 + lr) * 2 + (wave >> 2)] = ss; }
    __syncthreads();
    const int t = tt * 16 + lr;
    const float r = rsqrtf((ssq[t * 2] + ssq[t * 2 + 1]) * (1.0f / 128.0f) + EPS);
    bf16_t* oc = (bf16_t*)(c.ws() + WS_OCAT) + (row0 + t) * 1024 + 512 + hh * 128;
#pragma unroll
    for (int nt = 0; nt < 4; ++nt) { const int v0 = (vb + nt) * 16 + lq * 4; const U2 og = ogr[nt]; const f32x4 g4 = g4r[nt];
        const float g0 = bf2f((bf16_t)(og.x & 0xFFFF)), g1 = bf2f((bf16_t)(og.x >> 16)), g2 = bf2f((bf16_t)(og.y & 0xFFFF)), g3 = bf2f((bf16_t)(og.y >> 16));
        U2 w; w.x = pack2(o[nt][0] * r * g4[0] * siluf_(g0), o[nt][1] * r * g4[1] * siluf_(g1)); w.y = pack2(o[nt][2] * r * g4[2] * siluf_(g2), o[nt][3] * r * g4[3] * siluf_(g3));
        *(U2*)(oc + v0) = w; }
}

struct ProbMerge {
    static constexpr bool PERM = true, GATHER = false;
    const char* A; const char* Bt; const bf16_t* Z; bf16_t* Y; int G, c, lat_only;
    DEV int row0(const g8::Unit& u) const { return lat_only ? lat_unit_row0(u.pm) : u.pm * 256; }
    DEV bool next(int i, g8::Unit& u) const { const int it = i >> 2, L = it * G + c; const int nM = lat_only ? BATCH * (SEQ / 256) : MTOT / 256;
        if (L >= nM * (D / 256)) return false; g8::order_map(L, nM, D / 256, u.pm, u.pn); u.aux = i & 3; u.idx = i; return true; }
    DEV int koff(const g8::Unit& u) const { return u.aux * 256; }
    DEV const char* a_base(const g8::Unit& u) const { return A + ((size_t)row0(u) * 1024 + koff(u)) * 2; }
    DEV const char* b_base(const g8::Unit& u) const { return Bt + ((size_t)u.pn * 256 * 1024 + koff(u)) * 2; }
    DEV int nt(const g8::Unit&) const { return 4; }
    DEV void prologue(LDSP unsigned char*) const {}
    DEV unsigned a_voff(LDSP unsigned char*, const g8::Unit&, int h, int R, int C) const { return (unsigned)((h * 128 + R) * 1024 + C) * 2u; }
    DEV unsigned ldb() const { return 1024 * 2; }
    DEV bool keep_acc(const g8::Unit& u) const { return u.aux < 3; }
    DEV void epi(g8::Acc& acc, const g8::Unit& u, int wr, int wc, int fr, int fq) const {
        if (u.aux == 2) return;
        const int r0 = row0(u) + wr * 64 + fr, c0 = u.pn * 256 + wc * 32 + fq * 8;
        const bf16_t* zb = Z + (size_t)r0 * ZS + ZMA + c0;
        if (u.aux < 2) {
            const bf16_t* zs = zb + u.aux * D;
#pragma unroll
            for (int ai = 0; ai < 2; ++ai) {
                U4 g0[4][2], g1[4][2];
#pragma unroll
                for (int m = 0; m < 4; ++m)
#pragma unroll
                    for (int bj = 0; bj < 2; ++bj) { const bf16_t* zp = zs + (size_t)(ai * 128 + m * 16) * ZS + bj * 128; g0[m][bj] = *(const U4*)zp; g1[m][bj] = *(const U4*)(zp + D); }
                G8_SCHED;
#pragma unroll
                for (int m = 0; m < 4; ++m)
#pragma unroll
                    for (int bj = 0; bj < 2; ++bj)
#pragma unroll
                        for (int q = 0; q < 4; ++q) { const float a0 = bf2f((bf16_t)(g0[m][bj][q] & 0xFFFF)), a1 = bf2f((bf16_t)(g0[m][bj][q] >> 16)), b0 = bf2f((bf16_t)(g1[m][bj][q] & 0xFFFF)), b1 = bf2f((bf16_t)(g1[m][bj][q] >> 16));
                            acc[ai][bj][m][q >> 1][(q & 1) * 2] *= (1.f + b0) * fast_rcp(1.f + a0); acc[ai][bj][m][q >> 1][(q & 1) * 2 + 1] *= (1.f + b1) * fast_rcp(1.f + a1); }
            }
        } else {
            const bf16_t* zs = zb + 2 * D;
#pragma unroll
            for (int ai = 0; ai < 2; ++ai) {
                U4 g0[4][2];
#pragma unroll
                for (int m = 0; m < 4; ++m)
#pragma unroll
                    for (int bj = 0; bj < 2; ++bj) g0[m][bj] = *(const U4*)(zs + (size_t)(ai * 128 + m * 16) * ZS + bj * 128);
                G8_SCHED;
#pragma unroll
                for (int m = 0; m < 4; ++m)
#pragma unroll
                    for (int bj = 0; bj < 2; ++bj) { float o[8];
#pragma unroll
                        for (int q = 0; q < 4; ++q) { o[2 * q] = acc[ai][bj][m][q >> 1][(q & 1) * 2] * fast_rcp(1.f + bf2f((bf16_t)(g0[m][bj][q] & 0xFFFF))); o[2 * q + 1] = acc[ai][bj][m][q >> 1][(q & 1) * 2 + 1] * fast_rcp(1.f + bf2f((bf16_t)(g0[m][bj][q] >> 16))); }
                        U4 w; w.x = cvt_pk_bf16(o[0], o[1]); w.y = cvt_pk_bf16(o[2], o[3]); w.z = cvt_pk_bf16(o[4], o[5]); w.w = cvt_pk_bf16(o[6], o[7]);
                        *(U4*)(Y + (size_t)(r0 + ai * 128 + m * 16) * D + c0 + bj * 128) = w; }
            }
        }
    }
};
struct ProbWout {
    static constexpr bool PERM = false, GATHER = false;
    const char* A; const char* Bt; Ctx cx; int G, c, lat_only;
    DEV int row0(const g8::Unit& u) const { return lat_only ? lat_unit_row0(u.pm) : u.pm * 256; }
    DEV bool next(int i, g8::Unit& u) const { const int L = i * G + c; const int nM = lat_only ? BATCH * (SEQ / 256) : MTOT / 256;
        if (L >= nM * (D / 256)) return false; g8::order_map(L, nM, D / 256, u.pm, u.pn); u.aux = 0; u.idx = i; return true; }
    DEV const char* a_base(const g8::Unit& u) const { return A + (size_t)row0(u) * D * 2; }
    DEV const char* b_base(const g8::Unit& u) const { return Bt + (size_t)u.pn * 256 * D * 2; }
    DEV int nt(const g8::Unit&) const { return D / 64; }
    DEV void prologue(LDSP unsigned char*) const {}
    DEV unsigned a_voff(LDSP unsigned char*, const g8::Unit&, int h, int R, int C) const { return (unsigned)((h * 128 + R) * D + C) * 2u; }
    DEV unsigned ldb() const { return D * 2; }
    DEV bool keep_acc(const g8::Unit&) const { return false; }
    DEV void epi(g8::Acc& acc, const g8::Unit& u, int wr, int wc, int fr, int fq) const {
        const int rbase = row0(u), b = rbase / NTOK, pb = rbase % NTOK;
        const float* gate = cx.mod(cx.layer, pb < CTX_LEN ? BATCH : b) + 2 * D + u.pn * 256 + wc * 32 + fq * 4;
        f32x4 gv[2][2];
#pragma unroll
        for (int bj = 0; bj < 2; ++bj)
#pragma unroll
            for (int n = 0; n < 2; ++n) gv[bj][n] = *(const f32x4*)(gate + bj * 128 + n * 16);
#pragma unroll
        for (int ai = 0; ai < 2; ++ai) {
            f32x4 xv[4][2][2]; const int cof = u.pn * 256 + wc * 32 + fq * 4;
#pragma unroll
            for (int m = 0; m < 4; ++m) { const float* xs = xrow_src(cx, rbase + ai * 128 + wr * 64 + m * 16 + fr) + cof;
#pragma unroll
                for (int bj = 0; bj < 2; ++bj)
#pragma unroll
                    for (int n = 0; n < 2; ++n) xv[m][bj][n] = *(const f32x4*)(xs + bj * 128 + n * 16); }
            G8_SCHED;
#pragma unroll
            for (int m = 0; m < 4; ++m) { float* xd = xrow_dst(cx, rbase + ai * 128 + wr * 64 + m * 16 + fr) + cof;
#pragma unroll
                for (int bj = 0; bj < 2; ++bj)
#pragma unroll
                    for (int n = 0; n < 2; ++n) *(f32x4*)(xd + bj * 128 + n * 16) = xv[m][bj][n] + gv[bj][n] * acc[ai][bj][m][n]; }
        }
    }
};
DEV void p8_load_router(const Ctx& c) {
    float* w = (float*)c.smem; const float* src = c.in(I_ROUTER) + (size_t)c.layer * D * NE;
    __syncthreads();
    for (int i = ltid() * 4; i < D * NE; i += NTHR * 4) { const int k = i / NE, e4 = (i % NE) >> 2; *(f32x4*)(w + ((size_t)(e4 * 4 + (k & 3)) * (D / 4) + (k >> 2)) * 4) = *(const f32x4*)(src + i); }
    __syncthreads();
}
struct P8Pre { f32x4 xv[NV], scv[NV], shv[NV]; };
DEV P8Pre p8_prefetch(const Ctx& c, int grow) {
    const int lane = ltid() & 63, l = c.layer;
    const int b = grow / NTOK, p = grow % NTOK;
    const float* x = xrow_dst(c, grow);
    const float* md = c.mod(l, p < CTX_LEN ? BATCH : b);
    P8Pre r;
#pragma unroll
    for (int i = 0; i < NV; ++i) r.xv[i] = *(const f32x4*)(x + lane * 4 + i * 256);
#pragma unroll
    for (int i = 0; i < NV; ++i) { const int cc = lane * 4 + i * 256; r.scv[i] = *(const f32x4*)(md + 4 * D + cc); r.shv[i] = *(const f32x4*)(md + 3 * D + cc); }
    return r;
}
DEV void p8_norm2_row(const Ctx& c, int grow, const P8Pre& pre, const f32x4 (&gv)[NV]) {
    const int lane = ltid() & 63;
    const float* wr = (const float*)c.smem;
    static_assert(NE == 16 || NE == 4, "router butterfly");
    f32x4 xv[NV], scv[NV], shv[NV]; float ss = 0.f;
#pragma unroll
    for (int i = 0; i < NV; ++i) { xv[i] = pre.xv[i]; scv[i] = pre.scv[i]; shv[i] = pre.shv[i]; }
#pragma unroll
    for (int i = 0; i < NV; ++i) { ss += xv[i][0] * xv[i][0] + xv[i][1] * xv[i][1] + xv[i][2] * xv[i][2] + xv[i][3] * xv[i][3]; }
    ss = wave_sum(ss);
    const float r = rsqrtf(ss / D + EPS);
    bf16_t* h = (bf16_t*)(c.ws() + WS_OCAT) + (size_t)grow * D;
    float lg[NE];
#pragma unroll
    for (int e = 0; e < NE; ++e) lg[e] = 0.f;
#pragma unroll
    for (int i = 0; i < NV; ++i) { const int cc = lane * 4 + i * 256; float o[4];
        const f32x4 gg = gv[i], sc = scv[i], sh = shv[i];
#pragma unroll
        for (int k = 0; k < 4; ++k) { o[k] = xv[i][k] * r * gg[k] * (1.f + sc[k]) + sh[k];
#pragma unroll
            for (int e4 = 0; e4 < NE / 4; ++e4) { const f32x4 w4 = *(const f32x4*)(wr + ((size_t)(e4 * 4 + k) * (D / 4) + (cc >> 2)) * 4);
#pragma unroll
                for (int q = 0; q < 4; ++q) lg[e4 * 4 + q] += o[k] * w4[q]; } }
        U2 pk; pk.x = pack2(o[0], o[1]); pk.y = pack2(o[2], o[3]); *(U2*)(h + cc) = pk; }
    float v8[8], v4[4], v2[2], v1;
    if (NE == 16) {
#pragma unroll
        for (int q = 0; q < 8; ++q) { const bool hi = (lane & 32) != 0; const float keep = hi ? lg[q + 8] : lg[q], give = hi ? lg[q] : lg[q + 8]; v8[q] = keep + __shfl_xor(give, 32); }
#pragma unroll
        for (int q = 0; q < 4; ++q) { const bool hi = (lane & 16) != 0; const float keep = hi ? v8[q + 4] : v8[q], give = hi ? v8[q] : v8[q + 4]; v4[q] = keep + __shfl_xor(give, 16); }
    } else {
#pragma unroll
        for (int q = 0; q < 4; ++q) { float t = lg[q % NE]; t += __shfl_xor(t, 32); t += __shfl_xor(t, 16); v4[q] = t; }
    }
#pragma unroll
    for (int q = 0; q < 2; ++q) { const bool hi = (lane & 8) != 0; const float keep = hi ? v4[q + 2] : v4[q], give = hi ? v4[q] : v4[q + 2]; v2[q] = keep + __shfl_xor(give, 8); }
    { const bool hi = (lane & 4) != 0; const float keep = hi ? v2[1] : v2[0], give = hi ? v2[0] : v2[1]; v1 = keep + __shfl_xor(give, 4); }
    v1 += __shfl_xor(v1, 2); v1 += __shfl_xor(v1, 1);
    const int eh = (NE == 16) ? (((lane >> 5) & 1) * 8 + ((lane >> 4) & 1) * 4 + ((lane >> 3) & 1) * 2 + ((lane >> 2) & 1)) : (((lane >> 3) & 1) * 2 + ((lane >> 2) & 1));
    float mx = v1;
    mx = fmaxf(mx, __shfl_xor(mx, 4)); mx = fmaxf(mx, __shfl_xor(mx, 8));
    if (NE == 16) { mx = fmaxf(mx, __shfl_xor(mx, 16)); mx = fmaxf(mx, __shfl_xor(mx, 32)); }
    const float ex = expf(v1 - mx);
    float sum = ex; sum += __shfl_xor(sum, 4); sum += __shfl_xor(sum, 8);
    if (NE == 16) { sum += __shfl_xor(sum, 16); sum += __shfl_xor(sum, 32); }
    const bool writer = (lane & 3) == 0 && (NE == 16 || lane < 16);
    if (writer) { ((float*)(c.ws() + WS_AFF))[(size_t)grow * NE + eh] = ex / sum; ((int*)(c.ws() + WS_INV))[(size_t)grow * NE + eh] = -1; }
}
DEV int p8_grow(int it, int wave, bool all) { if (all) return it * 8 + wave; const int lr = it * 8 + wave; return (lr / SEQ) * NTOK + CTX_LEN + lr % SEQ; }
DEV void p8_rows(const Ctx& c, int it, int n, int G, int wave, bool all) {
    if (it >= n) return;
    const int lane = ltid() & 63;
    const float* g = c.in(I_NORM2) + c.layer * D;
    f32x4 gv[NV];
#pragma unroll
    for (int i = 0; i < NV; ++i) gv[i] = *(const f32x4*)(g + lane * 4 + i * 256);
    P8Pre cur = p8_prefetch(c, p8_grow(it, wave, all));
    for (;;) {
        const int itn = it + G; const bool more = itn < n;
        const P8Pre nxt = p8_prefetch(c, p8_grow(more ? itn : it, wave, all));
        SCHED_FENCE();
        p8_norm2_row(c, p8_grow(it, wave, all), cur, gv);
        if (!more) break;
        SCHED_FENCE();
        cur = nxt; it = itn;
    }
}
DEV void p9_topk_item(const Ctx& c, int set, int b, int e) {
    unsigned* key = (unsigned*)c.smem;
    unsigned* hist = key + 2048;
    unsigned* misc = hist + 256;
    const int tid = ltid(), lane = tid & 63, wv = tid >> 6;
    const int n = set == 0 ? SEQ : CTX_LEN, cap = set == 0 ? CAPL : CAPC, p0 = set == 0 ? CTX_LEN : 0;
    static_assert(SEQ <= 2048 && CTX_LEN <= 2048, "topk buffer");
    const float* aff = (const float*)(c.ws() + WS_AFF) + ((size_t)b * NTOK + p0) * NE + e;
    __syncthreads();
    for (int i = tid; i < 2048; i += NTHR) key[i] = (i < n) ? __builtin_bit_cast(unsigned, aff[(size_t)i * NE]) : 0u;
    if (tid == 0) { misc[0] = 0u; misc[1] = (unsigned)cap; }
    __syncthreads();
    unsigned kk[4];
#pragma unroll
    for (int q = 0; q < 4; ++q) kk[q] = key[tid * 4 + q];
#pragma unroll 1
    for (int pass = 0; pass < 4; ++pass) {
        const int shift = 24 - 8 * pass; const unsigned mask = pass == 0 ? 0u : (0xFFFFFFFFu << (shift + 8));
        if (tid < 256) hist[tid] = 0u;
        __syncthreads();
        const unsigned prefix = misc[0];
#pragma unroll
        for (int q = 0; q < 4; ++q) if (tid * 4 + q < n && (kk[q] & mask) == prefix) atomicAdd(&hist[(kk[q] >> shift) & 255u], 1u);
        __syncthreads();
        if (tid < 64) {
            const unsigned rem = misc[1];
            const unsigned h0 = hist[tid * 4], h1 = hist[tid * 4 + 1], h2 = hist[tid * 4 + 2], h3 = hist[tid * 4 + 3];
            const unsigned own = h0 + h1 + h2 + h3; unsigned suf = own;
#pragma unroll
            for (int dd = 1; dd < 64; dd <<= 1) { const unsigned o2 = __shfl_down(suf, dd); if (lane + dd < 64) suf += o2; }
            const unsigned ab3 = suf - own, ab2 = ab3 + h3, ab1 = ab2 + h2, ab0 = ab1 + h1;
            int bsel = -1; unsigned above = 0u;
            if (ab3 < rem && ab3 + h3 >= rem) { bsel = tid * 4 + 3; above = ab3; }
            else if (ab2 < rem && ab2 + h2 >= rem) { bsel = tid * 4 + 2; above = ab2; }
            else if (ab1 < rem && ab1 + h1 >= rem) { bsel = tid * 4 + 1; above = ab1; }
            else if (ab0 < rem && ab0 + h0 >= rem) { bsel = tid * 4; above = ab0; }
            if (bsel >= 0) { misc[0] = prefix | ((unsigned)bsel << shift); misc[1] = rem - above; }
        }
        __syncthreads();
    }
    const unsigned T = misc[0], need_eq = misc[1];
    unsigned cg = 0, ce = 0;
#pragma unroll
    for (int q = 0; q < 4; ++q) { const bool v = tid * 4 + q < n; cg += (v && kk[q] > T) ? 1u : 0u; ce += (v && kk[q] == T) ? 1u : 0u; }
    unsigned sg = cg, se = ce;
#pragma unroll
    for (int d = 1; d < 64; d <<= 1) { const unsigned a = __shfl_up(sg, d), bq = __shfl_up(se, d); if (lane >= d) { sg += a; se += bq; } }
    if (lane == 63) { misc[8 + wv] = sg; misc[16 + wv] = se; }
    __syncthreads();
    unsigned og = 0, oe = 0;
    for (int w = 0; w < wv; ++w) { og += misc[8 + w]; oe += misc[16 + w]; }
    unsigned pg = og + sg - cg, pe = oe + se - ce;
    int* rmap = (int*)(c.ws() + WS_RMAP) + (size_t)e * RPE + (set == 0 ? b * CAPL : RPE_L + b * CAPC);
    float* slw = (float*)(c.ws() + WS_SLW) + (size_t)e * RPE + (set == 0 ? b * CAPL : RPE_L + b * CAPC);
    int* inv = (int*)(c.ws() + WS_INV);
#pragma unroll
    for (int q = 0; q < 4; ++q) { const int i = tid * 4 + q; if (i < n) {
        const bool gt = kk[q] > T, eq = kk[q] == T; const bool sel = gt || (eq && pe < need_eq);
        if (sel) { const int slot = (int)(pg + (pe < need_eq ? pe : need_eq)); const int tok = b * NTOK + p0 + i;
            rmap[slot] = tok; slw[slot] = __builtin_bit_cast(float, kk[q]); inv[(size_t)tok * NE + e] = e * RPE + (set == 0 ? b * CAPL : RPE_L + b * CAPC) + slot; }
        pg += gt ? 1u : 0u; pe += eq ? 1u : 0u; } }
}
struct ProbMoe1 {
    static constexpr bool PERM = true, GATHER = true;
    static constexpr int MAXU = 12;
    const char* A; const char* Bt; const int* rmap; bf16_t* hid; int G, c, nMe;
    DEV bool next(int i, g8::Unit& u) const { const int L = i * G + c; if (L >= NE * nMe * (2 * FF / 256)) return false; int pmt; g8::order_map(L, NE * nMe, 2 * FF / 256, pmt, u.pn); u.aux = pmt / nMe; u.pm = pmt % nMe; u.idx = i; return true; }
    DEV const char* a_base(const g8::Unit&) const { return A; }
    DEV const char* b_base(const g8::Unit& u) const { return Bt + ((size_t)u.aux * 2 * FF + u.pn * 256) * D * 2; }
    DEV int nt(const g8::Unit&) const { return D / 64; }
    DEV void prologue(LDSP unsigned char* lds) const {
        LDSP unsigned* tab = (LDSP unsigned*)(lds + g8::STAGE_BYTES); g8::Unit u;
        for (int i = 0; i < MAXU && next(i, u); ++i) for (int t = ltid(); t < 256; t += NTHR) tab[i * 256 + t] = (unsigned)rmap[(size_t)u.aux * RPE + u.pm * 256 + t] * (unsigned)(D * 2);
        __syncthreads();
    }
    DEV unsigned a_voff(LDSP unsigned char* lds, const g8::Unit& u, int h, int R, int C) const { return ((const LDSP unsigned*)(lds + g8::STAGE_BYTES))[u.idx * 256 + h * 128 + R] + (unsigned)C * 2u; }
    DEV unsigned ldb() const { return D * 2; }
    DEV bool keep_acc(const g8::Unit&) const { return false; }
    DEV void epi(g8::Acc& acc, const g8::Unit& u, int wr, int wc, int fr, int fq) const {
        bf16_t* base = hid + ((size_t)u.aux * RPE + u.pm * 256 + wr * 64 + fr) * FF + (u.pn * 256 + wc * 32 + fq * 8) / 2;
#pragma unroll
        for (int ai = 0; ai < 2; ++ai)
#pragma unroll
            for (int m = 0; m < 4; ++m)
#pragma unroll
                for (int bj = 0; bj < 2; ++bj) { const f32x4 g = acc[ai][bj][m][0], uu = acc[ai][bj][m][1]; U2 w;
                    w.x = cvt_pk_bf16(siluf_(g[0]) * uu[0], siluf_(g[1]) * uu[1]); w.y = cvt_pk_bf16(siluf_(g[2]) * uu[2], siluf_(g[3]) * uu[3]);
                    *(U2*)(base + (size_t)(ai * 128 + m * 16) * FF + bj * 64) = w; }
    }
};
struct ProbMoe2 {
    static constexpr bool PERM = true, GATHER = false;
    const char* A; const char* Bt; const float* slw; bf16_t* ye; int G, c, nMe;
    DEV bool next(int i, g8::Unit& u) const { const int L = i * G + c; if (L >= NE * nMe * (D / 256)) return false; int pmt; g8::order_map(L, NE * nMe, D / 256, pmt, u.pn); u.aux = pmt / nMe; u.pm = pmt % nMe; u.idx = i; return true; }
    DEV const char* a_base(const g8::Unit& u) const { return A + ((size_t)u.aux * RPE + u.pm * 256) * FF * 2; }
    DEV const char* b_base(const g8::Unit& u) const { return Bt + ((size_t)u.aux * D + u.pn * 256) * FF * 2; }
    DEV int nt(const g8::Unit&) const { return FF / 64; }
    DEV void prologue(LDSP unsigned char*) const {}
    DEV unsigned a_voff(LDSP unsigned char*, const g8::Unit&, int h, int R, int C) const { return (unsigned)((h * 128 + R) * FF + C) * 2u; }
    DEV unsigned ldb() const { return FF * 2; }
    DEV bool keep_acc(const g8::Unit&) const { return false; }
    DEV void epi(g8::Acc& acc, const g8::Unit& u, int wr, int wc, int fr, int fq) const {
        const size_t r0 = (size_t)u.aux * RPE + u.pm * 256 + wr * 64 + fr;
        bf16_t* base = ye + r0 * D + u.pn * 256 + wc * 32 + fq * 8;
        float wv[2][4];
#pragma unroll
        for (int ai = 0; ai < 2; ++ai)
#pragma unroll
            for (int m = 0; m < 4; ++m) wv[ai][m] = slw[r0 + ai * 128 + m * 16];
        G8_SCHED;
#pragma unroll
        for (int ai = 0; ai < 2; ++ai)
#pragma unroll
            for (int m = 0; m < 4; ++m) { const float w8 = wv[ai][m];
#pragma unroll
                for (int bj = 0; bj < 2; ++bj) { U4 w; w.x = cvt_pk_bf16(acc[ai][bj][m][0][0] * w8, acc[ai][bj][m][0][1] * w8); w.y = cvt_pk_bf16(acc[ai][bj][m][0][2] * w8, acc[ai][bj][m][0][3] * w8);
                    w.z = cvt_pk_bf16(acc[ai][bj][m][1][0] * w8, acc[ai][bj][m][1][1] * w8); w.w = cvt_pk_bf16(acc[ai][bj][m][1][2] * w8, acc[ai][bj][m][1][3] * w8);
                    *(U4*)(base + (size_t)(ai * 128 + m * 16) * D + bj * 128) = w; } }
    }
};
struct PfPre { f32x4 xv[NV]; MoePre mp; };
DEV PfPre pf_prefetch(const Ctx& c, int lrow) {
    const int lane = ltid() & 63;
    const float* x = c.out() + (size_t)lrow * D;
    const int grow = (lrow / SEQ) * NTOK + CTX_LEN + lrow % SEQ;
    PfPre r;
#pragma unroll
    for (int i = 0; i < NV; ++i) r.xv[i] = *(const f32x4*)(x + lane * 4 + i * 256);
    r.mp = moe_prefetch(c, grow, DEPTH - 1);
    return r;
}
DEV void pf_final_row(const Ctx& c, int lrow, const PfPre& pre, const f32x4 (&gv)[NV]) {
    const int lane = ltid() & 63;
    float* x = c.out() + (size_t)lrow * D;
    f32x4 xv[NV];
#pragma unroll
    for (int i = 0; i < NV; ++i) xv[i] = pre.xv[i];
    moe_combine_regs(c, pre.mp, xv);
    float ss = 0.f;
#pragma unroll
    for (int i = 0; i < NV; ++i) ss += xv[i][0] * xv[i][0] + xv[i][1] * xv[i][1] + xv[i][2] * xv[i][2] + xv[i][3] * xv[i][3];
    ss = wave_sum(ss);
    const float r = rsqrtf(ss / D + EPS);
#pragma unroll
    for (int i = 0; i < NV; ++i) NT_STORE4(x + lane * 4 + i * 256, xv[i] * r * gv[i]);
}
DEV void pf_rows(const Ctx& c, int it, int n, int G, int wave) {
    if (it >= n) return;
    const int lane = ltid() & 63;
    const float* g = c.in(I_FNORM);
    f32x4 gv[NV];
#pragma unroll
    for (int i = 0; i < NV; ++i) gv[i] = *(const f32x4*)(g + lane * 4 + i * 256);
    PfPre cur = pf_prefetch(c, it * 8 + wave);
    for (;;) {
        const int itn = it + G; const bool more = itn < n;
        const PfPre nxt = pf_prefetch(c, (more ? itn : it) * 8 + wave);
        SCHED_FENCE();
        pf_final_row(c, it * 8 + wave, cur, gv);
        if (!more) break;
        SCHED_FENCE();
        cur = nxt; it = itn;
    }
}

constexpr int PH_PER_LAYER = 11, N_PHASES = 1 + DEPTH * PH_PER_LAYER + 1;
__global__ void __launch_bounds__(NTHR) mk_forward(Params prm) {
#ifdef EMU
    char* smem = emu_lds();
#else
    extern __shared__ __attribute__((aligned(16))) char smem[];
#endif
    Ctx c; c.smem = smem; c.layer = 0;
    const int bid = blockIdx.x, G = gridDim.x, tid = threadIdx.x;
#define wave (ltid() >> 6)
    const int lo = prm.ph_lo, hi = prm.ph_hi;
#ifdef EMU
    emu_params = prm;
#endif
#ifdef EMU
#define GRID_BAR() emu_grid_sync()
#else
    XcdBarrier bar; bar.bar = (unsigned*)(prm.ws + WS_BAR); bar.x = 0; bar.st = nullptr;
    if (hi - lo > 1) {
        if (tid < 4) ((volatile LAS unsigned*)(smem + LDS_MISC))[tid] = 0u;
        __syncthreads();
        bar = xcd_barrier_post((unsigned*)(prm.ws + WS_BAR), (volatile LAS unsigned*)(smem + LDS_MISC));
    }
#define GRID_BAR() xcd_barrier(bar)
#endif
#ifdef PH_ONLY
#define PHSEL(j) ((j) == PH_ONLY)
#elif defined(PH_SKIP)
#define PHSEL(j) ((j) != PH_SKIP)
#else
#define PHSEL(j) true
#endif
#ifndef PROBE_PHASE
#define PROBE_PHASE -1
#endif
#ifndef PROBE_REPS
#define PROBE_REPS 1
#endif
#ifndef PROBE_L0
#define PROBE_L0 0
#endif
#define REPS(j) for (int rep_ = 0; rep_ < (((j) == PROBE_PHASE && (!PROBE_L0 || c.layer == 0)) ? PROBE_REPS : 1); ++rep_)
#ifndef PROBE_SUB
#define PROBE_SUB -1
#endif
#define SUBREP(id) for (int srep_ = 0; srep_ < (((id) == PROBE_SUB && (!PROBE_L0 || c.layer == 0)) ? PROBE_REPS : 1); ++srep_)
#define IN(k) (lo <= (k) && (k) < hi)
#ifndef PROBE_BAR
#define PROBE_BAR 0
#endif
#define SEAM(k) do { if (IN(k) && IN((k) + 1)) { GRID_BAR(); for (int pb_ = 0; pb_ < PROBE_BAR; ++pb_) GRID_BAR(); } } while (0)
#define pl ((bf16_t*)(smem + wave * (16 * GS * 2)))

    if (PHSEL(100) && IN(0)) REPS(100) {
        const int n_mod = DEPTH * (D6 / 64), n_cw = DEPTH * CW_PER_LAYER;
        for (int it = bid; it < n_mod + n_cw + DEPTH; it += G) { if (it < n_mod) p0_mod_item(c, it); else if (it < n_mod + n_cw) p0_convw_item(c, it - n_mod); else p0_gatew_item(c, it - n_mod - n_cw); }
        { PrepJobFn f; f.c = &c; const int nmodb = n_mod < G ? n_mod : 0;
          conv_range(c, f, 0, DEPTH * PJ_PER_L, bid >= nmodb ? bid - nmodb : G - nmodb + bid, G); }
    }
    SEAM(0);
    for (int l = 0; l < DEPTH; ++l) {
        c.layer = l;
        const int P = 1 + l * PH_PER_LAYER;
        const bool ctxo = (l < DEPTH - 1);
        const int mt_n = ctxo ? MT_ALL : MT_LAT;
        if (PHSEL(0) && IN(P + 0)) REPS(0) { p1_rows(c, bid, MTOT / 8, G, wave); }
        SEAM(P + 0);
        if (PHSEL(1) && IN(P + 1)) REPS(1) { ProbInproj pr; pr.A = c.ws() + WS_H; pr.Bt = c.ws() + WS_WIN + (size_t)l * NIN * D * 2; pr.Z = (bf16_t*)(c.ws() + WS_Z); pr.navt = (bf16_t*)(c.ws() + WS_NAVT); pr.gvt = (bf16_t*)(c.ws() + WS_GVT); pr.G = G; pr.c = bid; pr.lastl = ctxo ? 0 : 1;
            g8::gemm_phase((LDSP unsigned char*)smem, pr); }
        SEAM(P + 1);
        if (PHSEL(2) && IN(P + 2)) REPS(2) {
            const int n_q = mt_n * 3, n_kv = MT_ALL * 4, n_g1 = G1_ITEMS, n_na = NA_LAT_ITEMS + (ctxo ? NA_CTX_ITEMS : 0), n_kr = MTOT / 16;
            const int tot = n_g1 + n_q + n_kv + n_na + n_kr;
            int it = bid;
            for (; it < n_na; it += G) { SUBREP(23) p3_na_item(c, it); }
            if (it < n_na + n_g1) { SUBREP(20) p3_gla_g1_range(c, it - n_na, n_g1, G); it += ((n_na + n_g1 - 1 - it) / G + 1) * G; }
            { const int e = n_na + n_g1 + n_q; if (it < e) { SUBREP(21) p3_up_range<true>(c, it - (e - n_q), n_q, G, ctxo); it += ((e - 1 - it) / G + 1) * G; } }
            { const int e = n_na + n_g1 + n_q + n_kv; if (it < e) { SUBREP(22) p3_up_range<false>(c, it - (e - n_kv), n_kv, G, ctxo); it += ((e - 1 - it) / G + 1) * G; } }
            for (; it < tot; it += G) p3_krope_item(c, it - (n_na + n_g1 + n_q + n_kv));
        }
        SEAM(P + 2);
        if (PHSEL(3) && IN(P + 3)) REPS(3) {
            const int n_g2 = G2_ITEMS, n_att = MLA_LAT_ITEMS + (ctxo ? MLA_CTX_ITEMS : 0);
            for (int it = bid; it < n_g2 + n_att; it += G) {
                if (it < n_g2) { SUBREP(30) p4_gla_g2_item(c, it); continue; }
                SUBREP(31) p4_mla_item(c, it - n_g2);
            }
        }
        SEAM(P + 3);
        if (PHSEL(4) && IN(P + 4)) REPS(4) {
            const int chs = ctxo ? NCH : (NCH - NCC);
            const int n3 = BATCH * 4 * chs, ch0 = ctxo ? 0 : NCC;
            if (bid < n3) {
                int it = bid;
                G3Pre cur = g3_prefetch(c, it / chs / 4, (it / chs) & 3, (it % chs) + ch0);
                for (;;) {
                    const int itn = it + G; const bool more = itn < n3; const int ix = more ? itn : it;
                    G3Pre nxt; p5_gla_g3_body(c, it / chs / 4, (it / chs) & 3, (it % chs) + ch0, cur, ix / chs / 4, (ix / chs) & 3, (ix % chs) + ch0, nxt);
                    if (!more) break;
                    SCHED_FENCE();
                    cur = nxt; it = itn;
                }
            }
        }
        SEAM(P + 4);
        if (PHSEL(5) && IN(P + 5)) REPS(5) {
            { ProbMerge pr; pr.A = c.ws() + WS_OCAT; pr.Bt = c.ws() + WS_WBR + (size_t)l * D * 1024 * 2; pr.Z = (const bf16_t*)(c.ws() + WS_Z); pr.Y = (bf16_t*)(c.ws() + WS_H); pr.G = G; pr.c = bid; pr.lat_only = ctxo ? 0 : 1;
              SUBREP(50) g8::gemm_phase((LDSP unsigned char*)smem, pr); }
            { const int nu = (ctxo ? MTOT / 256 : BATCH * (SEQ / 256)) * (D / 256), dbl = nu % G;
              if (bid >= dbl) SUBREP(51) convexp_range(c, l, 0, CE_ITEMS / 2, bid - dbl, G - dbl); }
        }
        SEAM(P + 5);
        if (PHSEL(6) && IN(P + 6)) REPS(6) { ProbWout pr; pr.A = c.ws() + WS_H; pr.Bt = c.ws() + WS_WOUT + (size_t)l * D * D * 2; pr.cx = c; pr.G = G; pr.c = bid; pr.lat_only = ctxo ? 0 : 1;
            SUBREP(52) g8::gemm_phase((LDSP unsigned char*)smem, pr);
            { const int nu = (ctxo ? MTOT / 256 : BATCH * (SEQ / 256)) * (D / 256), dbl = nu % G;
              if (bid >= dbl) SUBREP(53) convexp_range(c, l, CE_ITEMS / 2, CE_ITEMS, bid - dbl, G - dbl); } }
        SEAM(P + 6);
        if (PHSEL(7) && IN(P + 7)) REPS(7) {
            p8_load_router(c);
            p8_rows(c, bid, ctxo ? MTOT / 8 : BATCH * SEQ / 8, G, wave, ctxo);
        }
        SEAM(P + 7);
        if (PHSEL(8) && IN(P + 8)) REPS(8) { const int tot = BATCH * NE * (ctxo ? 2 : 1); for (int it = bid; it < tot; it += G) { const int set = it / (BATCH * NE), r = it % (BATCH * NE); p9_topk_item(c, set, r / NE, r % NE); } }
        SEAM(P + 8);
        const int mt_e = (ctxo ? RPE : RPE_L) / 256;
        if (PHSEL(9) && IN(P + 9)) REPS(9) { ProbMoe1 pr; pr.A = c.ws() + WS_OCAT; pr.Bt = c.ws() + WS_EXP + EXP_WGU; pr.rmap = (const int*)(c.ws() + WS_RMAP); pr.hid = (bf16_t*)(c.ws() + WS_Z); pr.G = G; pr.c = bid; pr.nMe = mt_e;
            g8::gemm_phase((LDSP unsigned char*)smem, pr); }
        SEAM(P + 9);
        if (PHSEL(10) && IN(P + 10)) REPS(10) { ProbMoe2 pr; pr.A = c.ws() + WS_Z; pr.Bt = c.ws() + WS_EXP + EXP_WD; pr.slw = (const float*)(c.ws() + WS_SLW); pr.ye = (bf16_t*)(c.ws() + WS_YE); pr.G = G; pr.c = bid; pr.nMe = mt_e;
            g8::gemm_phase((LDSP unsigned char*)smem, pr); }
        SEAM(P + 10);
    }
    if (PHSEL(101) && IN(N_PHASES - 1)) { pf_rows(c, bid, BATCH * SEQ / 8, G, wave); }
#undef wave
#undef pl
}

#ifdef EMU
static void emu_dump_map(FILE* f) {
    fprintf(f, "MOD %zu\nCCUR %zu\nH %zu\nZ %zu\nWIN %zu\nWUQ %zu\nWUKV %zu\nWBR %zu\nWOUT %zu\nEXP %zu\nMQ %zu\nMK %zu\nMVT %zu\nNAVT %zu\nGVT %zu\nOCAT %zu\nAFF %zu\nRMAP %zu\nSLW %zu\nTOTAL %zu\n",
            WS_MOD, WS_CCUR, WS_H, WS_Z, WS_WIN, WS_WUQ, WS_WUKV, WS_WBR, WS_WOUT, WS_EXP, WS_MQ, WS_MK, WS_MVT, WS_NAVT, WS_GVT, WS_OCAT, WS_AFF, WS_RMAP, WS_SLW, WS_TOTAL_BYTES);
    fprintf(f, "D_IN_PAD %d\nNTOK %d\nMTOT %d\nRPE %d\n", D_IN_PAD, NTOK, MTOT, RPE);
}
#endif

extern "C" void kernel_launch(void* const* d_in, const int* in_sizes, int n_in, void* d_out, int out_size, void* d_ws, size_t ws_size, hipStream_t stream) {
    Params p{};
    for (int i = 0; i < 28; ++i) p.in[i] = (const float*)d_in[i];
    p.out = (float*)d_out; p.ws = (char*)d_ws;
#ifdef EMU
    int emu_stop = N_PHASES; if (getenv("EMU_STOP")) emu_stop = atoi(getenv("EMU_STOP"));
    hipMemsetAsync((char*)d_ws + WS_BAR, 0, WS_BAR_BYTES, stream);
    if (getenv("EMU_ONE")) { p.ph_lo = 0; p.ph_hi = emu_stop; emu_launch(mk_forward, 3, NTHR, LDS_BYTES, p, true); }
    else for (int k = 0; k < emu_stop; ++k) { p.ph_lo = k; p.ph_hi = k + 1; emu_launch(mk_forward, 5, NTHR, LDS_BYTES, p, false); }
#else
    static int grid = 0;
    if (grid == 0) {
        if (n_in != 28 || out_size != BATCH * SEQ * D || ws_size < WS_TOTAL_BYTES) { fprintf(stderr, "kernel_launch: unexpected shapes (n_in %d out %d ws %zu need %zu)\n", n_in, out_size, ws_size, (size_t)WS_TOTAL_BYTES); grid = -1; return; }
        int dev = 0, cus = 0, per_cu = 0;
        hipGetDevice(&dev); hipDeviceGetAttribute(&cus, hipDeviceAttributeMultiprocessorCount, dev);
        hipFuncSetAttribute((const void*)mk_forward, hipFuncAttributeMaxDynamicSharedMemorySize, LDS_BYTES);
        hipOccupancyMaxActiveBlocksPerMultiprocessor(&per_cu, (const void*)mk_forward, NTHR, LDS_BYTES);
        if (per_cu < 1) { fprintf(stderr, "kernel_launch: occupancy query says %d blocks/CU\n", per_cu); grid = -1; return; }
        grid = cus;
    }
    if (grid < 0) return;
    hipMemsetAsync((char*)d_ws + WS_BAR, 0, WS_BAR_BYTES, stream);
#if MK_ONE_LAUNCH
    p.ph_lo = 0; p.ph_hi = N_PHASES;
    void* args[] = {&p};
    hipError_t e = hipLaunchCooperativeKernel((const void*)mk_forward, dim3(grid), dim3(NTHR), args, LDS_BYTES, stream);
    if (e != hipSuccess) fprintf(stderr, "cooperative launch failed: %s (grid %d)\n", hipGetErrorString(e), grid);
#else
    for (int k = 0; k < N_PHASES; ++k) { p.ph_lo = k; p.ph_hi = k + 1; hipLaunchKernelGGL(mk_forward, dim3(grid), dim3(NTHR), LDS_BYTES, stream, p); }
#endif
#endif
}
```

```cpp
#ifndef EMU
#include <hip/hip_runtime.h>
#include <hip/hip_cooperative_groups.h>
#include <cstdio>
#endif
#include <stdint.h>

#ifndef MK_ONE_LAUNCH
#define MK_ONE_LAUNCH 1
#endif

#ifdef EMU_SMALL
constexpr int D_MODEL = 256, BATCH = 2, SEQ = 1024, CTX_LEN = 256, N_EXPERTS = 4, EXPERT_FF = 256;
#else
constexpr int D_MODEL = 1024, BATCH = 8, SEQ = 2048, CTX_LEN = 256, N_EXPERTS = 16, EXPERT_FF = 1024;
#endif
constexpr int DEPTH = 2, GRID_W = 64, ROWS = SEQ / GRID_W;
constexpr int D = D_MODEL, D6 = 6 * D, FF = EXPERT_FF, NE = N_EXPERTS;
constexpr int NTOK = CTX_LEN + SEQ;
constexpr int MTOT = BATCH * NTOK;
constexpr int NCH = NTOK / 64, NCC = CTX_LEN / 64;
constexpr int ZKA = 0, ZGK = 256, ZDKV = 512, ZKR = 640, ZAF = 672, ZAB = 688, ZQA = 768, ZDQ = 1024, ZGQ = 1280, ZOG = 1536, ZMA = 2048;
constexpr int D_IN = 2752 + 3 * D;
constexpr int ZROW = ZMA + 3 * D;
constexpr int ZS = (ZROW + 255) / 256 * 256;
constexpr int NIN = ZS + 768;
constexpr int D_IN_PAD = ZS;
constexpr int CAPL = 2 * SEQ / NE, CAPC = 2 * CTX_LEN / NE;
constexpr int RPE_L = BATCH * CAPL, RPE_C = BATCH * CAPC, RPE = RPE_L + RPE_C;
constexpr float EPS = 1e-6f;
constexpr int NTHR = 512;
static_assert(ROWS >= 8 && NTOK % 256 == 0 && CTX_LEN % 256 == 0 && SEQ % 256 == 0 && RPE_L % 256 == 0 && RPE_C % 256 == 0 && D % 256 == 0 && FF % 256 == 0, "shape");

constexpr size_t al256(size_t x) { return (x + 255) / 256 * 256; }
constexpr size_t WS_BAR = 0;
constexpr size_t WS_BAR_BYTES = 16384;
constexpr size_t WS_MOD = WS_BAR + WS_BAR_BYTES;
constexpr size_t WS_CCUR = WS_MOD + al256((size_t)DEPTH * (BATCH + 1) * D6 * 4);
constexpr size_t WS_H = WS_CCUR + al256((size_t)BATCH * CTX_LEN * D * 4);
constexpr size_t WS_Z = WS_H + al256((size_t)MTOT * D * 2);
constexpr size_t WS_Z_BYTES = al256((size_t)MTOT * D_IN_PAD * 2);
static_assert((size_t)NE * RPE * FF * 2 <= WS_Z_BYTES, "hid alias");
constexpr size_t WS_WIN = WS_Z + WS_Z_BYTES;
constexpr size_t WS_WUQ = WS_WIN + al256((size_t)DEPTH * NIN * D * 2);
constexpr size_t WS_WUKV = WS_WUQ + al256((size_t)DEPTH * 384 * 256 * 2);
constexpr size_t WS_WGT = WS_WUKV + al256((size_t)DEPTH * 512 * 128 * 2);
constexpr size_t WS_WBR = WS_WGT + al256((size_t)DEPTH * 2 * 2 * 256 * 16 * 2);
constexpr size_t WS_WOUT = WS_WBR + al256((size_t)DEPTH * D * 1024 * 2);
constexpr size_t WS_EXP = WS_WOUT + al256((size_t)DEPTH * D * D * 2);
constexpr size_t EXP_WGU = 0;
constexpr size_t EXP_WD = al256((size_t)NE * 2 * FF * D * 2);
constexpr size_t EXP_BYTES = EXP_WD + al256((size_t)NE * D * FF * 2);
constexpr size_t GLA_KV = 0;
constexpr size_t GLA_DEC = al256((size_t)BATCH * 4 * 2 * NCH * 64 * 128 * 4);
constexpr size_t GLA_SP = GLA_DEC + al256((size_t)BATCH * 4 * 2 * NCH * 64 * 4);
constexpr size_t GLA_BYTES = GLA_SP + al256((size_t)BATCH * 4 * 2 * NCH * 64 * 128 * 2);
constexpr size_t WS_EXP_BYTES = EXP_BYTES > GLA_BYTES ? EXP_BYTES : GLA_BYTES;
constexpr size_t WS_MQ = WS_EXP + WS_EXP_BYTES;
constexpr size_t WS_MK = WS_MQ + al256((size_t)BATCH * 4 * NTOK * 96 * 2);
constexpr size_t WS_MVT = WS_MK + al256((size_t)BATCH * 4 * NTOK * 96 * 2);
constexpr size_t WS_NAVT = WS_MVT + al256((size_t)BATCH * 4 * 64 * NTOK * 2);
constexpr size_t WS_GVT = WS_NAVT + al256((size_t)BATCH * 4 * 64 * NTOK * 2);
constexpr size_t WS_OCAT = WS_GVT + al256((size_t)BATCH * 4 * 128 * NTOK * 2);
constexpr size_t WS_AFF = WS_OCAT + al256((size_t)MTOT * 1024 * 2);
constexpr size_t WS_RMAP = WS_AFF + al256((size_t)MTOT * NE * 4);
constexpr size_t WS_SLW = WS_RMAP + al256((size_t)NE * RPE * 4);
constexpr size_t WS_INV = WS_SLW + al256((size_t)NE * RPE * 4);
constexpr size_t WS_TOTAL_BYTES = WS_INV + al256((size_t)MTOT * NE * 4);
constexpr size_t WS_YE = WS_MQ;
static_assert((size_t)NE * RPE * D * 2 <= WS_AFF - WS_MQ, "ye alias");

typedef unsigned short bf16_t;
typedef short bf16x8 __attribute__((ext_vector_type(8)));
typedef float f32x4 __attribute__((ext_vector_type(4)));
typedef uint32_t U4 __attribute__((ext_vector_type(4)));
typedef uint32_t U2 __attribute__((ext_vector_type(2)));
#define DEV __device__ __forceinline__
#ifdef EMU
DEV int ltid() { return (int)threadIdx.x; }
#else
DEV int ltid() { int t = (int)threadIdx.x; asm volatile("" : "+v"(t)); return t; }
#endif

#ifdef EMU
#define NT_LOAD4(p) (*(const f32x4*)(p))
#define NT_LOAD1(p) (*(const float*)(p))
#define NT_STORE4(p, v) (*(f32x4*)(p) = (v))
#else
#define NT_LOAD4(p) __builtin_nontemporal_load((const f32x4*)(p))
#define NT_LOAD1(p) __builtin_nontemporal_load((const float*)(p))
#define NT_STORE4(p, v) __builtin_nontemporal_store((v), (f32x4*)(p))
#endif
DEV float bf2f(bf16_t h) { return __builtin_bit_cast(float, (uint32_t)h << 16); }
DEV bf16_t f2bf(float f) { uint32_t u = __builtin_bit_cast(uint32_t, f); u += 0x7FFFu + ((u >> 16) & 1u); return (bf16_t)(u >> 16); }
DEV uint32_t pack2(float a, float b) { return (uint32_t)f2bf(a) | ((uint32_t)f2bf(b) << 16); }
#ifdef EMU
DEV float fast_exp2(float x) { return exp2f(x); }
#else
DEV float fast_exp2(float x) { return __builtin_amdgcn_exp2f(x); }
#endif
#ifdef EMU
DEV float fast_rcp(float x) { return 1.0f / x; }
#else
DEV float fast_rcp(float x) { return __builtin_amdgcn_rcpf(x); }
#endif
#ifdef EMU
#define SCHED_FENCE()
#else
#define SCHED_FENCE() __builtin_amdgcn_sched_barrier(0)
#endif
DEV float sigmoidf_(float x) { return fast_rcp(1.0f + __expf(-x)); }
DEV float siluf_(float x) { return x * sigmoidf_(x); }

#ifdef EMU
#define WAVE_SYNC() emu_wave_sync()
#else
#define WAVE_SYNC() do { asm volatile("s_waitcnt lgkmcnt(0)" ::: "memory"); __builtin_amdgcn_wave_barrier(); } while (0)
#endif

struct Params { const float* in[28]; float* out; char* ws; int ph_lo, ph_hi; };
enum { I_X = 0, I_C, I_CTX, I_CCTX, I_ADAW, I_ADAB, I_NORM1, I_NORM2, I_WIN, I_RPB, I_QNORM, I_WUQ, I_KVNORM, I_WUKV, I_WAF, I_BAF, I_WAB, I_BAB, I_ONORM,
       I_WBRA, I_WBRB, I_WBRC, I_WOUT, I_ROUTER, I_WGATE, I_WUP, I_WDOWN, I_FNORM };

#ifndef EMU
#define XB_TMO      128
#define XB_XCNT(j)  (256  + 64 * (j))
#define XB_XSUB(j)  (1280 + 64 * (j))
#define XB_XGEN(j)  (2304 + 64 * (j))
#define XB_TOP      3328
#define XB_TOPGEN   3392
#define XCD_BAR_WORDS 3456
#define XB_SPIN_CAP (1u << 22)
#define LAS __attribute__((address_space(3)))
DEV unsigned xb_ld(unsigned* p)              { return __hip_atomic_load(p, __ATOMIC_RELAXED, __HIP_MEMORY_SCOPE_AGENT); }
DEV unsigned xb_add(unsigned* p, unsigned v) { return __hip_atomic_fetch_add(p, v, __ATOMIC_RELAXED, __HIP_MEMORY_SCOPE_AGENT); }
DEV unsigned xb_xcc_id() { return (unsigned)__builtin_amdgcn_s_getreg((3 << 11) | 20) & 0xFu; }
#define XB_SPIN(cond, bar) do { unsigned _sp = 0; while (cond) { __builtin_amdgcn_s_sleep(1); \
    if ((++_sp & 255u) == 0u) { if (xb_ld(&(bar)[XB_TMO])) break; if (_sp > XB_SPIN_CAP) { atomicAdd(&(bar)[XB_TMO], 1u); break; } } } } while (0)
struct XcdBarrier { unsigned* bar; unsigned x; volatile LAS unsigned* st; };
DEV XcdBarrier xcd_barrier_post(unsigned* bar, volatile LAS unsigned* st) {
    XcdBarrier b; b.bar = bar; b.x = xb_xcc_id(); b.st = st;
    if (ltid() == 0) (void)xb_add(&bar[XB_XCNT(b.x)], 1u);
    return b;
}
DEV void xcd_barrier_complete(unsigned* bar, unsigned x, unsigned& nloc, unsigned& nx) {
    const unsigned G = gridDim.x * gridDim.y * gridDim.z;
    unsigned sum, cnt, mine, sp = 0u;
    for (;;) {
        sum = 0u; cnt = 0u; mine = 0u;
#pragma unroll
        for (unsigned j = 0; j < 16; ++j) { const unsigned c = xb_ld(&bar[XB_XCNT(j)]); sum += c; cnt += (c > 0u) ? 1u : 0u; mine = (j == x) ? c : mine; }
        if (sum == G) break;
        __builtin_amdgcn_s_sleep(1);
        if ((++sp & 255u) == 0u) { if (xb_ld(&bar[XB_TMO])) break; if (sp > XB_SPIN_CAP) { atomicAdd(&bar[XB_TMO], 1u); break; } }
    }
    nloc = mine > 0u ? mine : 1u; nx = cnt > 0u ? cnt : 1u;
}
DEV void xcd_barrier(const XcdBarrier& b) {
    asm volatile("s_waitcnt vmcnt(0)" ::: "memory");
    __syncthreads();
    if (ltid() == 0) {
        unsigned* bar = b.bar;
        __builtin_amdgcn_s_waitcnt(0);
        unsigned nloc = b.st[0], nx = b.st[1];
        if (nloc == 0u) { xcd_barrier_complete(bar, b.x, nloc, nx); b.st[0] = nloc; b.st[1] = nx; }
        const unsigned old = xb_add(&bar[XB_XSUB(b.x)], 1u);
        const unsigned gen = old / nloc;
        if (old + 1u == (gen + 1u) * nloc) {
            __builtin_amdgcn_fence(__ATOMIC_RELEASE, "agent");
            asm volatile("s_waitcnt vmcnt(0)" ::: "memory");
            const unsigned og = xb_add(&bar[XB_TOP], 1u);
            const unsigned tg = og / nx;
            if (og + 1u == (tg + 1u) * nx) xb_add(&bar[XB_TOPGEN], 1u);
            else XB_SPIN(xb_ld(&bar[XB_TOPGEN]) == tg, bar);
            __builtin_amdgcn_fence(__ATOMIC_ACQUIRE, "agent");
            xb_add(&bar[XB_XGEN(b.x)], 1u);
            asm volatile("s_waitcnt vmcnt(0)" ::: "memory");
        } else {
            XB_SPIN(xb_ld(&bar[XB_XGEN(b.x)]) == gen, bar);
            __builtin_amdgcn_fence(__ATOMIC_ACQUIRE, "agent");
            asm volatile("s_waitcnt vmcnt(0)" ::: "memory");
        }
    }
    __syncthreads();
}
#endif

constexpr int LDS_BYTES = 147456;
constexpr int LDS_MISC = LDS_BYTES - 64;
constexpr int GS = 72;

DEV void acc_zero(f32x4 (&acc)[4][2]) {
#pragma unroll
    for (int mi = 0; mi < 4; ++mi)
#pragma unroll
        for (int ni = 0; ni < 2; ++ni) acc[mi][ni] = f32x4{0.f, 0.f, 0.f, 0.f};
}

#ifdef EMU
static Params emu_params;
DEV const Params* KP() { return &emu_params; }
#else
typedef const Params __attribute__((address_space(4))) CParams;
DEV CParams* KP() { CParams* p = (CParams*)__builtin_amdgcn_kernarg_segment_ptr(); asm volatile("" : "+s"(p)); return p; }
#endif
struct Ctx {
    char* smem; int layer;
    DEV const float* in(int i) const { return KP()->in[i]; }
    DEV float* out() const { return KP()->out; }
    DEV char* ws() const { return KP()->ws; }
    DEV float* mod(int l, int brow) const { return (float*)(ws() + WS_MOD) + ((size_t)l * (BATCH + 1) + brow) * D6; }
};

DEV void p0_mod_item(const Ctx& c, int item) {
    const int l = item / (D6 / 64), cc = item % (D6 / 64);
    float* sc = (float*)c.smem;
    float* red = sc + (BATCH + 1) * D;
    const int tid = ltid();
    __syncthreads();
    { constexpr int NC4 = BATCH * D / 4, NL = (NC4 + NTHR - 1) / NTHR;
      const f32x4* c4 = (const f32x4*)c.in(I_C); f32x4 cv[NL];
#pragma unroll
      for (int i = 0; i < NL; ++i) { const int ix = tid + i * NTHR; cv[i] = c4[ix < NC4 ? ix : NC4 - 1]; }
      const f32x4 cx = ((const f32x4*)c.in(I_CCTX))[tid & (D / 4 - 1)];
#pragma unroll
      for (int i = 0; i < NL; ++i) { const int ix = tid + i * NTHR; if (ix < NC4) { f32x4 o; o[0] = siluf_(cv[i][0]); o[1] = siluf_(cv[i][1]); o[2] = siluf_(cv[i][2]); o[3] = siluf_(cv[i][3]); *(f32x4*)(sc + ix * 4) = o; } }
      if (tid < D / 4) { f32x4 o; o[0] = siluf_(cx[0]); o[1] = siluf_(cx[1]); o[2] = siluf_(cx[2]); o[3] = siluf_(cx[3]); *(f32x4*)(sc + BATCH * D + tid * 4) = o; } }
    __syncthreads();
    const int col = tid & 63, kg = tid >> 6;
    const float* W = c.in(I_ADAW) + (size_t)l * D * D6 + cc * 64 + col;
    typedef float f32x16 __attribute__((ext_vector_type(16)));
    static_assert(BATCH + 1 <= 16, "mod rows");
    float a[BATCH + 1];
#pragma unroll
    for (int r = 0; r <= BATCH; ++r) a[r] = 0.f;
    {
        constexpr int UB = 16, NB = D / 8 / UB;
        static_assert(NB % 2 == 0, "mod batches");
        float w[UB], wn[UB];
#ifdef EMU
#define MOD_FMAC(acc, x, y) acc += (x) * (y)
#else
#define MOD_FMAC(acc, x, y) asm("v_fmac_f32 %0, %1, %2" : "+v"(acc) : "v"(x), "v"(y))
#endif
#define MOD_LD(dst, kbase) _Pragma("unroll") for (int u = 0; u < UB; ++u) dst[u] = NT_LOAD1(W + (size_t)((kbase) + 8 * u) * D6);
#define MOD_FMA(src, kbase) _Pragma("unroll") for (int u = 0; u < UB; ++u) { _Pragma("unroll") for (int r = 0; r <= BATCH; ++r) MOD_FMAC(a[r], sc[r * D + (kbase) + 8 * u], src[u]); }
        MOD_LD(w, kg)
        for (int bt = 0; bt < NB - 2; bt += 2) {
            const int kb = kg + bt * 8 * UB;
            MOD_LD(wn, kb + 8 * UB) SCHED_FENCE(); MOD_FMA(w, kb) SCHED_FENCE();
            MOD_LD(w, kb + 16 * UB) SCHED_FENCE(); MOD_FMA(wn, kb + 8 * UB) SCHED_FENCE();
        }
        { const int kb = kg + (NB - 2) * 8 * UB;
          MOD_LD(wn, kb + 8 * UB) SCHED_FENCE(); MOD_FMA(w, kb) SCHED_FENCE(); MOD_FMA(wn, kb + 8 * UB) }
#undef MOD_LD
#undef MOD_FMA
#undef MOD_FMAC
    }
#pragma unroll
    for (int r = 0; r <= BATCH; ++r) red[(kg * (BATCH + 1) + r) * 64 + col] = a[r];
    __syncthreads();
    for (int i = tid; i < (BATCH + 1) * 64; i += NTHR) { int r = i / 64, cl = i % 64; float s = 0.f;
        for (int g = 0; g < 8; ++g) s += red[(g * (BATCH + 1) + r) * 64 + cl];
        c.mod(l, r)[cc * 64 + cl] = s + c.in(I_ADAB)[(size_t)l * D6 + cc * 64 + cl]; }
}

template <class Map> DEV void convT_tile(char* smem, const float* src, int sstride, const float* gain, bf16_t* dst, int dstride, int n0, int k0, Map map) {
    float* t = (float*)smem;
    const int tid = ltid();
    __syncthreads();
    for (int i = tid; i < 4096; i += NTHR) { int k = i >> 6, n = i & 63; int sc = map(n0 + n); float v = 0.f; if (sc >= 0) { v = src[(size_t)(k0 + k) * sstride + sc]; if (gain) v *= gain[k0 + k]; } t[k * 65 + n] = v; }
    __syncthreads();
    { int n = tid >> 3, kc = (tid & 7) * 8; U4 o;
      o.x = pack2(t[(kc + 0) * 65 + n], t[(kc + 1) * 65 + n]); o.y = pack2(t[(kc + 2) * 65 + n], t[(kc + 3) * 65 + n]);
      o.z = pack2(t[(kc + 4) * 65 + n], t[(kc + 5) * 65 + n]); o.w = pack2(t[(kc + 6) * 65 + n], t[(kc + 7) * 65 + n]);
      *(U4*)(dst + (size_t)(n0 + n) * dstride + k0 + kc) = o; }
}
DEV int rope_perm32(int j) { int blk = j >> 3; blk = (blk == 1) ? 2 : (blk == 2) ? 1 : blk; return blk * 8 + (j & 7); }
struct MapWin { DEV int operator()(int n) const {
    if (n < 256) return 256 + n;
    if (n < 512) return 1440 + (n - 256);
    if (n < 640) return 1024 + (n - 512);
    if (n < 672) return 1152 + rope_perm32(n - 640);
    if (n < 688) return 2208 + (n - 672);
    if (n < 704) return 2224 + (n - 688);
    if (n < 768) return -1;
    if (n < 1024) return n - 768;
    if (n < 1280) return 768 + (n - 1024);
    if (n < 1536) return 1184 + (n - 1280);
    if (n < 2048) return 2240 + (n - 1536);
    if (n < ZROW) return 2752 + (n - ZMA);
    if (n < ZS) return -1;
    if (n < ZS + 256) return 512 + (n - ZS);
    return 1696 + (n - ZS - 256); } };
struct MapUq { DEV int operator()(int n) const { int h = n / 96, w = n % 96; return (w < 64) ? n : h * 96 + 64 + rope_perm32(w - 64); } };
struct MapId { DEV int operator()(int n) const { return n; } };
struct MapGU { int which; DEV int operator()(int r) const { int q = r >> 5, w = r & 31; if (which == 0) return (w < 16) ? 16 * q + w : -2; return (w >= 16) ? 16 * q + w - 16 : -2; } };

constexpr int CW_UQ = 6 * 4, CW_UKV = 8 * 2, CW_PER_LAYER = CW_UQ + CW_UKV;
DEV void p0_gatew_item(const Ctx& c, int l) {
    bf16_t* o = (bf16_t*)(c.ws() + WS_WGT) + (size_t)l * 2 * 2 * 256 * 16;
    for (int i = ltid(); i < 2 * 256 * 16; i += NTHR) { const int dir = i >> 12, d = (i >> 4) & 255, r = i & 15;
        const float w = (dir == 0 ? c.in(I_WAF) : c.in(I_WAB))[((size_t)l * 16 + r) * 256 + d]; const bf16_t hi = f2bf(w); const bf16_t lo = f2bf(w - bf2f(hi));
        o[((dir * 2 + 0) * 256 + d) * 16 + r] = hi; o[((dir * 2 + 1) * 256 + d) * 16 + r] = lo; }
}
DEV void p0_convw_item(const Ctx& c, int item) {
    const int l = item / CW_PER_LAYER; int r = item % CW_PER_LAYER;
    if (r < CW_UQ) { int tn = r / 4, tk = r % 4;
        convT_tile(c.smem, c.in(I_WUQ) + (size_t)l * 256 * 384, 384, c.in(I_QNORM) + l * 256, (bf16_t*)(c.ws() + WS_WUQ) + (size_t)l * 384 * 256, 256, tn * 64, tk * 64, MapUq()); return; }
    r -= CW_UQ;
    { int tn = r / 2, tk = r % 2;
      convT_tile(c.smem, c.in(I_WUKV) + (size_t)l * 128 * 512, 512, c.in(I_KVNORM) + l * 128, (bf16_t*)(c.ws() + WS_WUKV) + (size_t)l * 512 * 128, 128, tn * 64, tk * 64, MapId()); }
}
struct ConvJob { const float* src; bf16_t* dst; int sstride, dstride, k0, n0, mode; };
DEV int conv_row(int mode, int n) { return mode >= 2 ? n : 8 * (n >> 2) + (mode == 1 ? 4 : 0) + (n & 3); }
constexpr int CE_G = (D / 64) * (FF / 256), CE_D = (FF / 64) * (D / 256), CE_PER_E = 2 * CE_G + CE_D, CE_ITEMS = NE * CE_PER_E;
DEV ConvJob convexp_job(const Ctx& c, int l, int item) {
    ConvJob j; const int e = item / CE_PER_E; int r = item % CE_PER_E;
    bf16_t* wgu = (bf16_t*)(c.ws() + WS_EXP + EXP_WGU) + (size_t)e * 2 * FF * D;
    if (r < 2 * CE_G) { const int up = r >= CE_G; r -= up * CE_G; j.src = (up ? c.in(I_WUP) : c.in(I_WGATE)) + ((size_t)l * NE + e) * D * FF; j.sstride = FF; j.k0 = (r / (FF / 256)) * 64; j.n0 = (r % (FF / 256)) * 256; j.dst = wgu; j.dstride = D; j.mode = up; return j; }
    r -= 2 * CE_G;
    j.src = c.in(I_WDOWN) + ((size_t)l * NE + e) * FF * D; j.sstride = D; j.k0 = (r / (D / 256)) * 64; j.n0 = (r % (D / 256)) * 256; j.dst = (bf16_t*)(c.ws() + WS_EXP + EXP_WD) + (size_t)e * D * FF; j.dstride = FF; j.mode = 2; return j;
}
DEV void conv_load(const ConvJob& j, f32x4 (&v)[2][4]) {
    const int tid = ltid(), lane = tid & 63, wv = tid >> 6;
#pragma unroll
    for (int i = 0; i < 2; ++i)
#pragma unroll
        for (int r = 0; r < 4; ++r) { int col = j.n0 + lane * 4; if (j.mode == 3) col = MapWin()(col);
            v[i][r] = col >= 0 ? NT_LOAD4(j.src + (size_t)(j.k0 + (wv + 8 * i) * 4 + r) * j.sstride + col) : f32x4{0.f, 0.f, 0.f, 0.f}; }
}
DEV void conv_finish(char* smem, const ConvJob& j, const f32x4 (&v)[2][4]) {
    constexpr int RS = 68;
    bf16_t* t = (bf16_t*)smem;
    const int tid = ltid(), lane = tid & 63, wv = tid >> 6;
    __syncthreads();
#pragma unroll
    for (int i = 0; i < 2; ++i)
#pragma unroll
        for (int q = 0; q < 4; ++q) { U2 w; w.x = pack2(v[i][0][q], v[i][1][q]); w.y = pack2(v[i][2][q], v[i][3][q]); *(U2*)(t + (q * 64 + lane) * RS + (wv + 8 * i) * 4) = w; }
    __syncthreads();
#pragma unroll
    for (int i = 0; i < 4; ++i) { const int ch = tid + i * NTHR, n = ch >> 3, kc = (ch & 7) * 8; const bf16_t* rp = t + ((n & 3) * 64 + (n >> 2)) * RS + kc;
        const U2 a = *(const U2*)rp, bq = *(const U2*)(rp + 4); U4 o; o.x = a.x; o.y = a.y; o.z = bq.x; o.w = bq.y;
        *(U4*)(j.dst + (size_t)conv_row(j.mode, j.n0 + n) * j.dstride + j.k0 + kc) = o; }
}
template <class JobFn> DEV void conv_range(const Ctx& c, JobFn jobfn, int lo, int hi, int rank, int nb) {
    int it = lo + rank; if (it >= hi) return;
    ConvJob j = jobfn(it); f32x4 v[2][4]; conv_load(j, v);
    for (;;) {
        const int nx = it + nb; const bool more = nx < hi;
        ConvJob jn = j; f32x4 vn[2][4];
        if (more) { jn = jobfn(nx); conv_load(jn, vn); }
        conv_finish(c.smem, j, v);
        if (!more) break;
#pragma unroll
        for (int i = 0; i < 2; ++i)
#pragma unroll
            for (int r = 0; r < 4; ++r) v[i][r] = vn[i][r];
        j = jn; it = nx;
    }
}
struct ExpJobFn { const Ctx* c; int l; DEV ConvJob operator()(int item) const { return convexp_job(*c, l, item); } };
DEV void convexp_range(const Ctx& c, int l, int lo, int hi, int rank, int nb) { ExpJobFn f; f.c = &c; f.l = l; conv_range(c, f, lo, hi, rank, nb); }
constexpr int PJ_WIN = (NIN / 256) * (D / 64), PJ_BRA = (D / 256) * 4, PJ_BRC = (D / 256) * 8, PJ_OUT = (D / 256) * (D / 64), PJ_PER_L = PJ_WIN + 2 * PJ_BRA + PJ_BRC + PJ_OUT;
struct PrepJobFn { const Ctx* c; DEV ConvJob operator()(int item) const {
    ConvJob j; const int l = item / PJ_PER_L; int r = item % PJ_PER_L; const Ctx& cc = *c;
    if (r < PJ_WIN) { j.src = cc.in(I_WIN) + (size_t)l * D * D_IN; j.sstride = D_IN; j.k0 = (r % (D / 64)) * 64; j.n0 = (r / (D / 64)) * 256; j.dst = (bf16_t*)(cc.ws() + WS_WIN) + (size_t)l * NIN * D; j.dstride = D; j.mode = 3; return j; }
    r -= PJ_WIN; bf16_t* wbr = (bf16_t*)(cc.ws() + WS_WBR) + (size_t)l * D * 1024; j.mode = 2; j.sstride = D;
    if (r < PJ_BRA) { j.src = cc.in(I_WBRA) + (size_t)l * 256 * D; j.k0 = (r % 4) * 64; j.n0 = (r / 4) * 256; j.dst = wbr; j.dstride = 1024; return j; }
    r -= PJ_BRA;
    if (r < PJ_BRA) { j.src = cc.in(I_WBRB) + (size_t)l * 256 * D; j.k0 = (r % 4) * 64; j.n0 = (r / 4) * 256; j.dst = wbr + 256; j.dstride = 1024; return j; }
    r -= PJ_BRA;
    if (r < PJ_BRC) { j.src = cc.in(I_WBRC) + (size_t)l * 512 * D; j.k0 = (r % 8) * 64; j.n0 = (r / 8) * 256; j.dst = wbr + 512; j.dstride = 1024; return j; }
    r -= PJ_BRC;
    j.src = cc.in(I_WOUT) + (size_t)l * D * D; j.k0 = (r % (D / 64)) * 64; j.n0 = (r / (D / 64)) * 256; j.dst = (bf16_t*)(cc.ws() + WS_WOUT) + (size_t)l * D * D; j.dstride = D; return j; } };

DEV const float* xrow_src(const Ctx& c, int grow) {
    const int b = grow / NTOK, p = grow % NTOK;
    if (p < CTX_LEN) return (c.layer == 0 ? c.in(I_CTX) : (const float*)(c.ws() + WS_CCUR)) + ((size_t)b * CTX_LEN + p) * D;
    return (c.layer == 0 ? c.in(I_X) : (const float*)c.out()) + ((size_t)b * SEQ + (p - CTX_LEN)) * D;
}
DEV float* xrow_dst(const Ctx& c, int grow) {
    const int b = grow / NTOK, p = grow % NTOK;
    if (p < CTX_LEN) return (float*)(c.ws() + WS_CCUR) + ((size_t)b * CTX_LEN + p) * D;
    return c.out() + ((size_t)b * SEQ + (p - CTX_LEN)) * D;
}
DEV float wave_sum(float v) { for (int m = 1; m < 64; m <<= 1) v += __shfl_xor(v, m); return v; }

constexpr int NV = D / 256;
DEV void moe_combine_regs(const Ctx& c, int grow, int lprev, f32x4 (&xv)[NV]) {
    const int lane = ltid() & 63;
    const int b = grow / NTOK, p = grow % NTOK;
    const float* gate = c.mod(lprev, p < CTX_LEN ? BATCH : b) + 5 * D;
    const int* inv = (const int*)(c.ws() + WS_INV) + (size_t)grow * NE;
    const bf16_t* ye = (const bf16_t*)(c.ws() + WS_YE);
    f32x4 a[NV], gt[NV];
    const int mine = (lane < NE) ? inv[lane] : -1;
#pragma unroll
    for (int i = 0; i < NV; ++i) { a[i] = f32x4{0.f, 0.f, 0.f, 0.f}; gt[i] = *(const f32x4*)(gate + lane * 4 + i * 256); }
    const int mine_unused = 0; (void)mine_unused;
    unsigned long long msk = __ballot(mine >= 0);
    while (msk) {
        const int e0 = __builtin_ctzll(msk); msk &= msk - 1;
        int e1 = -1; if (msk) { e1 = __builtin_ctzll(msk); msk &= msk - 1; }
        const int i0 = __shfl(mine, e0), i1 = __shfl(mine, e1 < 0 ? e0 : e1);
        U2 p0[NV], p1[NV];
#pragma unroll
        for (int i = 0; i < NV; ++i) { p0[i] = *(const U2*)(ye + (size_t)i0 * D + lane * 4 + i * 256); p1[i] = *(const U2*)(ye + (size_t)i1 * D + lane * 4 + i * 256); }
#pragma unroll
        for (int i = 0; i < NV; ++i) {
            a[i][0] += bf2f((bf16_t)(p0[i].x & 0xFFFF)); a[i][1] += bf2f((bf16_t)(p0[i].x >> 16)); a[i][2] += bf2f((bf16_t)(p0[i].y & 0xFFFF)); a[i][3] += bf2f((bf16_t)(p0[i].y >> 16));
            if (e1 >= 0) { a[i][0] += bf2f((bf16_t)(p1[i].x & 0xFFFF)); a[i][1] += bf2f((bf16_t)(p1[i].x >> 16)); a[i][2] += bf2f((bf16_t)(p1[i].y & 0xFFFF)); a[i][3] += bf2f((bf16_t)(p1[i].y >> 16)); } }
    }
#pragma unroll
    for (int i = 0; i < NV; ++i) xv[i] += gt[i] * a[i];
}
DEV void p1_norm_row(const Ctx& c, int grow) {
    const int lane = ltid() & 63, l = c.layer;
    const int b = grow / NTOK, p = grow % NTOK;
    const float* x = xrow_src(c, grow);
    const float* md = c.mod(l, p < CTX_LEN ? BATCH : b);
    const float* g = c.in(I_NORM1) + l * D;
    f32x4 xv[NV], gv[NV], scv[NV], shv[NV];
#pragma unroll
    for (int i = 0; i < NV; ++i) xv[i] = *(const f32x4*)(x + lane * 4 + i * 256);
#pragma unroll
    for (int i = 0; i < NV; ++i) { const int cc = lane * 4 + i * 256; gv[i] = *(const f32x4*)(g + cc); scv[i] = *(const f32x4*)(md + D + cc); shv[i] = *(const f32x4*)(md + cc); }
    if (l > 0) { moe_combine_regs(c, grow, l - 1, xv); float* xw = xrow_dst(c, grow);
#pragma unroll
        for (int i = 0; i < NV; ++i) *(f32x4*)(xw + lane * 4 + i * 256) = xv[i]; }
    float ss = 0.f;
#pragma unroll
    for (int i = 0; i < NV; ++i) ss += xv[i][0] * xv[i][0] + xv[i][1] * xv[i][1] + xv[i][2] * xv[i][2] + xv[i][3] * xv[i][3];
    ss = wave_sum(ss);
    const float r = rsqrtf(ss / D + EPS);
    bf16_t* h = (bf16_t*)(c.ws() + WS_H) + (size_t)grow * D;
#pragma unroll
    for (int i = 0; i < NV; ++i) { const int cc = lane * 4 + i * 256; float o[4];
#pragma unroll
        for (int k = 0; k < 4; ++k) o[k] = xv[i][k] * r * gv[i][k] * (1.f + scv[i][k]) + shv[i][k];
        U2 pk; pk.x = pack2(o[0], o[1]); pk.y = pack2(o[2], o[3]); *(U2*)(h + cc) = pk; }
}

#ifdef EMU
#define LDSP
#define G8_GLDS(gptr, ldsptr) memcpy((char*)(ldsptr) + (ltid() & 63) * 16, (const void*)(gptr), 16)
#define G8_WAIT_V(n)
#define G8_WAIT_L(n)
#define G8_BAR __syncthreads()
#define G8_SCHED
#define G8_PRIO(x)
#define G8_LAUNDER(v)
DEV unsigned cvt_pk_bf16(float lo, float hi) { return pack2(lo, hi); }
#else
#define LDSP __attribute__((address_space(3)))
#define G8_GLDS(gptr, ldsptr) __builtin_amdgcn_global_load_lds((const unsigned*)(gptr), (LDSP unsigned*)(ldsptr), 16, 0, 0)
#define G8_WAIT_V(n) asm volatile("s_waitcnt vmcnt(" #n ")" ::: "memory")
#define G8_WAIT_L(n) asm volatile("s_waitcnt lgkmcnt(" #n ")" ::: "memory")
#define G8_BAR __builtin_amdgcn_s_barrier()
#define G8_SCHED __builtin_amdgcn_sched_barrier(0)
#define G8_PRIO(x) __builtin_amdgcn_s_setprio(x)
#define G8_LAUNDER(v) asm volatile("" : "+v"(v))
DEV unsigned cvt_pk_bf16(float lo, float hi) { unsigned r; asm("v_cvt_pk_bf16_f32 %0, %1, %2" : "=v"(r) : "v"(lo), "v"(hi)); return r; }
#endif
namespace g8 {
constexpr int BM = 256, BK = 64, HALF = 128, HTB = HALF * BK * 2, STAGE_BYTES = 8 * HTB, NXCD = 8, WGM = 8;
DEV int lds_byte(int r, int c) { const int st = (r >> 4) * 2 + (c >> 5), rr = r & 15, cc = c & 31, ob = rr * 64 + cc * 2; return st * 1024 + (ob ^ (((ob >> 9) & 1) << 5)); }
DEV void stage_rc(int b, int& R, int& C) { const int st = b / 1024, sb = b % 1024, swz = sb ^ (((sb >> 9) & 1) << 5); R = (st >> 1) * 16 + swz / 64; C = (st & 1) * 32 + (swz % 64) / 2; }
DEV int perm32(int rho) { const int n = rho >> 4, i = rho & 15; return 8 * (i >> 2) + 4 * n + (i & 3); }
struct Unit { int pm, pn, aux, idx; };
DEV void order_map(int L, int nM, int nN, int& pm, int& pn) {
    const int nwg = nM * nN; int wgid = L;
    { const int q = nwg / NXCD, r = nwg % NXCD, xcd = wgid % NXCD, off = wgid / NXCD; wgid = (xcd < r ? xcd * (q + 1) : r * (q + 1) + (xcd - r) * q) + off; }
    const int nig = WGM * nN, gid = wgid / nig, fm = gid * WGM, gsz = (nM - fm) < WGM ? (nM - fm) : WGM;
    pm = fm + ((wgid % nig) % gsz); pn = (wgid % nig) / gsz;
}
typedef f32x4 Acc[2][2][4][2];
template <class P> DEV void gemm_phase(LDSP unsigned char* lds, const P& prob) {
    const int tid = ltid(), wid = __builtin_amdgcn_readfirstlane(tid >> 6), lane = tid & 63, wr = wid >> 2, wc = wid & 3, fr = lane & 15, fq = lane >> 4;
    unsigned voffB[2][2];
    prob.prologue(lds);
#define G8_RC(i, R, C) int R, C; stage_rc(ltid() * 16 + (i) * 8192, R, C)
#pragma unroll
    for (int i = 0; i < 2; ++i) { int R, C; stage_rc(tid * 16 + i * 8192, R, C); const int Rb = P::PERM ? ((R & ~31) + perm32(R & 31)) : R;
        voffB[0][i] = (unsigned)Rb * prob.ldb() + (unsigned)C * 2u; voffB[1][i] = voffB[0][i] + 128u * prob.ldb(); }
    const size_t kstep = (size_t)(BK * 2);
    const unsigned ldsw = (unsigned)wid * 1024u;
    const int aoff = lds_byte(wr * 64 + fr, fq * 8), boff = lds_byte(wc * 32 + fr, fq * 8);
#define G8_SA(b, h) (((b) * 2 + (h)) * HTB)
#define G8_SB(b, h) ((4 + (b) * 2 + (h)) * HTB)
#define G8_STAGE(bufoff, gbase, v0, v1) do { unsigned _v0 = (v0), _v1 = (v1); G8_LAUNDER(_v0); G8_LAUNDER(_v1); G8_GLDS((const char*)(gbase) + _v0, lds + (bufoff) + ldsw); G8_GLDS((const char*)(gbase) + _v1, lds + (bufoff) + ldsw + 8192); } while (0)
#define G8_LDA(dst, b, h) do { _Pragma("unroll") for (int m = 0; m < 4; ++m) _Pragma("unroll") for (int k = 0; k < 2; ++k) dst[m][k] = *(const LDSP bf16x8*)(lds + G8_SA(b, h) + aoff + m * 2048 + k * 1024); } while (0)
#define G8_LDB(dst, b, h) do { _Pragma("unroll") for (int n = 0; n < 2; ++n) _Pragma("unroll") for (int k = 0; k < 2; ++k) dst[n][k] = *(const LDSP bf16x8*)(lds + G8_SB(b, h) + boff + n * 2048 + k * 1024); } while (0)
#define G8_MMA(ai, bj, At, Bt) do { G8_PRIO(1); _Pragma("unroll") for (int m = 0; m < 4; ++m) _Pragma("unroll") for (int n = 0; n < 2; ++n) _Pragma("unroll") for (int k = 0; k < 2; ++k) \
        acc[ai][bj][m][n] = __builtin_amdgcn_mfma_f32_16x16x32_bf16(Bt[n][k], At[m][k], acc[ai][bj][m][n], 0, 0, 0); G8_PRIO(0); } while (0)
#define G8_ZERO() do { _Pragma("unroll") for (int a = 0; a < 2; ++a) _Pragma("unroll") for (int b = 0; b < 2; ++b) _Pragma("unroll") for (int m = 0; m < 4; ++m) _Pragma("unroll") for (int n = 0; n < 2; ++n) acc[a][b][m][n] = f32x4{0.f, 0.f, 0.f, 0.f}; } while (0)
    Unit cur, nxt; int ui = 0;
    if (!prob.next(0, cur)) return;
    Acc acc; G8_ZERO();
    bf16x8 At[4][2], B0[2][2], B1[2][2];
    const char* cA = prob.a_base(cur); const char* cB = prob.b_base(cur); int ntc = prob.nt(cur);
    unsigned vc00, vc01, vc10, vc11;
    { G8_RC(0, R0, C0); G8_RC(1, R1, C1); vc00 = prob.a_voff(lds, cur, 0, R0, C0); vc01 = prob.a_voff(lds, cur, 0, R1, C1); vc10 = prob.a_voff(lds, cur, 1, R0, C0); vc11 = prob.a_voff(lds, cur, 1, R1, C1); }
    G8_STAGE(G8_SB(0, 0), cB, voffB[0][0], voffB[0][1]); G8_STAGE(G8_SA(0, 0), cA, vc00, vc01); G8_STAGE(G8_SB(0, 1), cB, voffB[1][0], voffB[1][1]); G8_STAGE(G8_SA(0, 1), cA, vc10, vc11);
    if (wr == 1) G8_BAR;
    G8_WAIT_V(4); G8_BAR;
    G8_STAGE(G8_SB(1, 0), cB + kstep, voffB[0][0], voffB[0][1]); G8_STAGE(G8_SA(1, 0), cA + kstep, vc00, vc01); G8_STAGE(G8_SB(1, 1), cB + kstep, voffB[1][0], voffB[1][1]);
    G8_WAIT_V(6); G8_BAR;
    for (;;) {
        const bool has_next = prob.next(ui + 1, nxt);
        const char* nA = has_next ? prob.a_base(nxt) : cA; const char* nB = has_next ? prob.b_base(nxt) : cB;
        unsigned vn00 = vc00, vn01 = vc01, vn10 = vc10, vn11 = vc11;
        for (int t = 0; t < ntc; t += 2) {
            const bool last = (t == ntc - 2);
            if (P::GATHER && last && has_next) { G8_RC(0, R0, C0); G8_RC(1, R1, C1); vn00 = prob.a_voff(lds, nxt, 0, R0, C0); vn01 = prob.a_voff(lds, nxt, 0, R1, C1); vn10 = prob.a_voff(lds, nxt, 1, R0, C0); vn11 = prob.a_voff(lds, nxt, 1, R1, C1); }
            const char* a1 = cA + (size_t)(t + 1) * kstep;
            const char* a2 = last ? nA : cA + (size_t)(t + 2) * kstep; const char* b2 = last ? nB : cB + (size_t)(t + 2) * kstep;
            const char* a3 = a2 + kstep; const char* b3 = b2 + kstep;
            const unsigned w00 = last ? vn00 : vc00, w01 = last ? vn01 : vc01, w10 = last ? vn10 : vc10, w11 = last ? vn11 : vc11;
            G8_LDB(B0, 0, 0); G8_SCHED; G8_LDA(At, 0, 0); G8_STAGE(G8_SA(1, 1), a1, vc10, vc11);
            G8_WAIT_L(8); G8_BAR; G8_WAIT_L(0); G8_MMA(0, 0, At, B0); G8_BAR; G8_SCHED;
            G8_LDB(B1, 0, 1); G8_STAGE(G8_SB(0, 0), b2, voffB[0][0], voffB[0][1]);
            G8_BAR; G8_WAIT_L(0); G8_MMA(0, 1, At, B1); G8_BAR;
            G8_LDA(At, 0, 1); G8_STAGE(G8_SA(0, 0), a2, w00, w01);
            G8_BAR; G8_WAIT_L(0); G8_MMA(1, 0, At, B0); G8_BAR; G8_SCHED;
            G8_STAGE(G8_SB(0, 1), b2, voffB[1][0], voffB[1][1]);
            G8_WAIT_V(6); G8_BAR; G8_MMA(1, 1, At, B1); G8_BAR;
            G8_LDB(B0, 1, 0); G8_SCHED; G8_LDA(At, 1, 0); G8_STAGE(G8_SA(0, 1), a2, w10, w11);
            G8_WAIT_L(8); G8_BAR; G8_WAIT_L(0); G8_MMA(0, 0, At, B0); G8_BAR; G8_SCHED;
            G8_LDB(B1, 1, 1); G8_STAGE(G8_SB(1, 0), b3, voffB[0][0], voffB[0][1]);
            G8_BAR; G8_WAIT_L(0); G8_MMA(0, 1, At, B1); G8_BAR;
            G8_LDA(At, 1, 1); G8_STAGE(G8_SA(1, 0), a3, w00, w01);
            G8_BAR; G8_WAIT_L(0); G8_MMA(1, 0, At, B0); G8_BAR; G8_SCHED;
            G8_STAGE(G8_SB(1, 1), b3, voffB[1][0], voffB[1][1]);
            G8_WAIT_V(6); G8_BAR; G8_MMA(1, 1, At, B1); G8_BAR;
        }
        if (wr == 0) G8_BAR;
        prob.epi(acc, cur, wr, wc, fr, fq);
        if (!has_next) break;
        if (!prob.keep_acc(cur)) G8_ZERO();
        cur = nxt; cA = nA; cB = nB; vc00 = vn00; vc01 = vn01; vc10 = vn10; vc11 = vn11; ntc = prob.nt(cur); ++ui;
        if (wr == 1) G8_BAR;
    }
    G8_WAIT_V(0);
    G8_BAR;
#undef G8_RC
#undef G8_SA
#undef G8_SB
#undef G8_STAGE
#undef G8_LDA
#undef G8_LDB
#undef G8_MMA
#undef G8_ZERO
}
}

DEV int lat_unit_row0(int pm) { const int b = pm / (SEQ / 256), w = pm % (SEQ / 256); return b * NTOK + CTX_LEN + w * 256; }
struct ProbInproj {
    static constexpr bool PERM = true, GATHER = false;
    const char* A; const char* Bt; bf16_t* Z; bf16_t* navt; bf16_t* gvt; int G, c, lastl;
    DEV bool next(int i, g8::Unit& u) const { const int L = i * G + c; u.aux = 0; u.idx = i;
        if (!lastl) { if (L >= (MTOT / 256) * (NIN / 256)) return false; g8::order_map(L, MTOT / 256, NIN / 256, u.pm, u.pn); return true; }
        constexpr int NL = BATCH * (SEQ / 256) * (NIN / 256), NC = BATCH * (CTX_LEN / 256) * 6;
        if (L >= NL + NC) return false;
        if (L < NL) { int pml; g8::order_map(L, BATCH * (SEQ / 256), NIN / 256, pml, u.pn); u.pm = lat_unit_row0(pml) / 256; return true; }
        const int Lc = L - NL, bc = Lc / 6, j = Lc % 6; u.pm = ((bc / (CTX_LEN / 256)) * NTOK + (bc % (CTX_LEN / 256)) * 256) / 256; u.pn = j < 3 ? j : ZS / 256 + (j - 3); return true; }
    DEV const char* a_base(const g8::Unit& u) const { return A + (size_t)u.pm * 256 * D * 2; }
    DEV const char* b_base(const g8::Unit& u) const { return Bt + (size_t)u.pn * 256 * D * 2; }
    DEV int nt(const g8::Unit&) const { return D / 64; }
    DEV void prologue(LDSP unsigned char*) const {}
    DEV unsigned a_voff(LDSP unsigned char*, const g8::Unit&, int h, int R, int C) const { return (unsigned)((h * 128 + R) * D + C) * 2u; }
    DEV unsigned ldb() const { return D * 2; }
    DEV bool keep_acc(const g8::Unit&) const { return false; }
    DEV void epi(g8::Acc& acc, const g8::Unit& u, int wr, int wc, int fr, int fq) const {
        if (u.pn * 256 < ZS) {
            bf16_t* base = Z + (size_t)(u.pm * 256 + wr * 64 + fr) * ZS + u.pn * 256 + wc * 32 + fq * 8;
            if (u.pn * 256 >= ZMA) {
#pragma unroll
                for (int ai = 0; ai < 2; ++ai)
#pragma unroll
                    for (int bj = 0; bj < 2; ++bj)
#pragma unroll
                        for (int m = 0; m < 4; ++m)
#pragma unroll
                            for (int n = 0; n < 2; ++n)
#pragma unroll
                                for (int j = 0; j < 4; ++j) acc[ai][bj][m][n][j] = fast_exp2(acc[ai][bj][m][n][j] * -1.4426950408889634f);
            }
#pragma unroll
            for (int ai = 0; ai < 2; ++ai)
#pragma unroll
                for (int m = 0; m < 4; ++m)
#pragma unroll
                    for (int bj = 0; bj < 2; ++bj) { U4 w; w.x = cvt_pk_bf16(acc[ai][bj][m][0][0], acc[ai][bj][m][0][1]); w.y = cvt_pk_bf16(acc[ai][bj][m][0][2], acc[ai][bj][m][0][3]);
                        w.z = cvt_pk_bf16(acc[ai][bj][m][1][0], acc[ai][bj][m][1][1]); w.w = cvt_pk_bf16(acc[ai][bj][m][1][2], acc[ai][bj][m][1][3]);
                        *(U4*)(base + (size_t)(ai * 128 + m * 16) * ZS + bj * 128) = w; }
        } else {
            const int b = (u.pm * 256) / NTOK, p0 = (u.pm * 256) % NTOK + wr * 64 + fr;
            const int cc0 = u.pn * 256 - ZS + wc * 32 + fq * 8;
            bf16_t* base = (cc0 < 256) ? navt + (size_t)(b * 256 + cc0) * NTOK : gvt + (size_t)(b * 512 + cc0 - 256) * NTOK;
#pragma unroll
            for (int ai = 0; ai < 2; ++ai)
#pragma unroll
                for (int m = 0; m < 4; ++m)
#pragma unroll
                    for (int bj = 0; bj < 2; ++bj)
#pragma unroll
                        for (int n = 0; n < 2; ++n)
#pragma unroll
                            for (int j = 0; j < 4; ++j) base[(size_t)(bj * 128 + n * 4 + j) * NTOK + p0 + ai * 128 + m * 16] = f2bf(acc[ai][bj][m][n][j]);
        }
    }
};

constexpr int MT_ALL = MTOT / 128;
constexpr int MT_LAT = BATCH * (SEQ / 128);
DEV int lat_tile_m0(int t) { int b = t / (SEQ / 128), w = t % (SEQ / 128); return b * NTOK + CTX_LEN + w * 128; }

constexpr int UP_RS_OFF = 2 * 128 * (256 + 8) * 2;
static_assert(UP_RS_OFF + 128 * 4 <= LDS_MISC, "lds");
template <int K> struct UpLd { U4 a[K / 32], b[K / 32]; };
template <int K> DEV UpLd<K> up_load(const bf16_t* A, const bf16_t* Bt) {
    const int tid = ltid(), row = tid >> 2, pc = tid & 3; UpLd<K> r;
#pragma unroll
    for (int i = 0; i < K / 32; ++i) { r.a[i] = *(const U4*)(A + (size_t)row * D_IN_PAD + (pc + 4 * i) * 8); r.b[i] = *(const U4*)(Bt + (size_t)row * K + (pc + 4 * i) * 8); }
    return r;
}
template <int K> DEV void up_stage(char* smem, const UpLd<K>& ld) {
    constexpr int RS_ = K + 8;
    bf16_t* As = (bf16_t*)smem; bf16_t* Bs = As + 128 * RS_; float* rs = (float*)(smem + UP_RS_OFF);
    const int tid = ltid(), row = tid >> 2, pc = tid & 3;
    float ss = 0.f;
#pragma unroll
    for (int i = 0; i < K / 32; ++i) { *(U4*)(As + row * RS_ + (pc + 4 * i) * 8) = ld.a[i]; *(U4*)(Bs + row * RS_ + (pc + 4 * i) * 8) = ld.b[i];
#pragma unroll
        for (int q = 0; q < 4; ++q) { const float lo = bf2f((bf16_t)(ld.a[i][q] & 0xFFFF)), hi = bf2f((bf16_t)(ld.a[i][q] >> 16)); ss += lo * lo + hi * hi; } }
    ss += __shfl_xor(ss, 1); ss += __shfl_xor(ss, 2);
    if (pc == 0) rs[row] = rsqrtf(ss / K + EPS);
}
template <int K> DEV void up_mma(f32x4 (&acc)[4][2], const char* smem, bool tr) {
    constexpr int RS_ = K + 8;
    const bf16_t* As = (const bf16_t*)smem; const bf16_t* Bs = As + 128 * RS_;
    const int tid = ltid(), lane = tid & 63, wave = tid >> 6, wr = wave >> 2, wc = wave & 3;
    acc_zero(acc);
    if (tr) {
#pragma unroll
        for (int kk = 0; kk < K / 32; ++kk) { bf16x8 a[4], b[2];
#pragma unroll
            for (int mi = 0; mi < 4; ++mi) a[mi] = *(const bf16x8*)(As + (wr * 64 + mi * 16 + (lane & 15)) * RS_ + kk * 32 + (lane >> 4) * 8);
#pragma unroll
            for (int ni = 0; ni < 2; ++ni) b[ni] = *(const bf16x8*)(Bs + (wc * 32 + ni * 16 + (lane & 15)) * RS_ + kk * 32 + (lane >> 4) * 8);
#pragma unroll
            for (int mi = 0; mi < 4; ++mi)
#pragma unroll
                for (int ni = 0; ni < 2; ++ni) acc[mi][ni] = __builtin_amdgcn_mfma_f32_16x16x32_bf16(b[ni], a[mi], acc[mi][ni], 0, 0, 0); }
    } else {
#pragma unroll
        for (int kk = 0; kk < K / 32; ++kk) { bf16x8 a[4], b[2];
#pragma unroll
            for (int mi = 0; mi < 4; ++mi) a[mi] = *(const bf16x8*)(As + (wr * 64 + mi * 16 + (lane & 15)) * RS_ + kk * 32 + (lane >> 4) * 8);
#pragma unroll
            for (int ni = 0; ni < 2; ++ni) b[ni] = *(const bf16x8*)(Bs + (wc * 32 + ni * 16 + (lane & 15)) * RS_ + kk * 32 + (lane >> 4) * 8);
#pragma unroll
            for (int mi = 0; mi < 4; ++mi)
#pragma unroll
                for (int ni = 0; ni < 2; ++ni) acc[mi][ni] = __builtin_amdgcn_mfma_f32_16x16x32_bf16(a[mi], b[ni], acc[mi][ni], 0, 0, 0); }
    }
}
DEV void p3_qup_epilogue(const Ctx& c, const f32x4 (&acc)[4][2], int m0, int tn) {
    const int n0 = tn * 128;
    const int tid = ltid(), lane = tid & 63, wave = tid >> 6, wr = wave >> 2, wc = wave & 3, q4 = lane >> 4;
    const float* rs = (const float*)(c.smem + UP_RS_OFF);
    const int b = m0 / NTOK, pbase = m0 % NTOK;
    const int cb = n0 + wc * 32;
    const int hh = cb / 96, wofs = cb % 96;
    bf16_t* Q = (bf16_t*)(c.ws() + WS_MQ) + ((size_t)b * 4 + hh) * NTOK * 96;
    const float qscale = 0.10206207261596575f * 1.4426950408889634f;
    float invf[4];
#pragma unroll
    for (int j = 0; j < 4; ++j) invf[j] = __expf(-(float)(((q4 & 1) * 4 + j)) * (9.210340371976184f / 8.0f));
#pragma unroll
    for (int mi = 0; mi < 4; ++mi) {
        const int rl = wr * 64 + mi * 16 + (lane & 15), p = pbase + rl;
        const float r = rs[rl] * qscale;
        float v0[4], v1[4];
#pragma unroll
        for (int j = 0; j < 4; ++j) { v0[j] = acc[mi][0][j] * r; v1[j] = acc[mi][1][j] * r; }
        if (wofs == 64 && p >= CTX_LEN) {
            const int t = p - CTX_LEN; const float pos = (float)((q4 < 2) ? (t / GRID_W) : (t % GRID_W));
#pragma unroll
            for (int j = 0; j < 4; ++j) { const float ang = pos * invf[j], cs = __cosf(ang), sn = __sinf(ang);
                const float o0 = v0[j] * cs - v1[j] * sn, o1 = v0[j] * sn + v1[j] * cs; v0[j] = o0; v1[j] = o1; }
        }
        U2 w0, w1; w0.x = pack2(v0[0], v0[1]); w0.y = pack2(v0[2], v0[3]); w1.x = pack2(v1[0], v1[1]); w1.y = pack2(v1[2], v1[3]);
        *(U2*)(Q + (size_t)p * 96 + wofs + q4 * 4) = w0; *(U2*)(Q + (size_t)p * 96 + wofs + 16 + q4 * 4) = w1;
    }
}
DEV void p3_kvup_epilogue(const Ctx& c, const f32x4 (&acc)[4][2], int m0, int tn) {
    const int tid = ltid(), lane = tid & 63, wave = tid >> 6, wr = wave >> 2, wc = wave & 3, q4 = lane >> 4;
    const float* rs = (const float*)(c.smem + UP_RS_OFF);
    const int b = m0 / NTOK, pbase = m0 % NTOK, hh = tn;
    bf16_t* Kp = (bf16_t*)(c.ws() + WS_MK) + ((size_t)b * 4 + hh) * NTOK * 96;
    bf16_t* Vt = (bf16_t*)(c.ws() + WS_MVT) + ((size_t)b * 4 + hh) * 64 * NTOK;
    if (wc < 2) {
#pragma unroll
        for (int mi = 0; mi < 4; ++mi) { const int rl = wr * 64 + mi * 16 + (lane & 15); const float r = rs[rl];
#pragma unroll
            for (int ni = 0; ni < 2; ++ni) { U2 pk; pk.x = pack2(acc[mi][ni][0] * r, acc[mi][ni][1] * r); pk.y = pack2(acc[mi][ni][2] * r, acc[mi][ni][3] * r);
                *(U2*)(Kp + (size_t)(pbase + rl) * 96 + wc * 32 + ni * 16 + q4 * 4) = pk; } }
    } else {
#pragma unroll
        for (int ni = 0; ni < 2; ++ni) { const int cl = wc * 32 + ni * 16 + (lane & 15);
#pragma unroll
            for (int mi = 0; mi < 4; ++mi) { const int rl0 = wr * 64 + mi * 16 + q4 * 4;
                U2 pk; pk.x = pack2(acc[mi][ni][0] * rs[rl0], acc[mi][ni][1] * rs[rl0 + 1]); pk.y = pack2(acc[mi][ni][2] * rs[rl0 + 2], acc[mi][ni][3] * rs[rl0 + 3]);
                *(U2*)(Vt + (size_t)(cl - 64) * NTOK + pbase + rl0) = pk; } }
    }
}
template <bool Q> DEV void p3_up_range(const Ctx& c, int r, int n, int G, bool ctxo) {
    constexpr int K = Q ? 256 : 128, NT = Q ? 3 : 4;
    const int l = c.layer;
    const bf16_t* A = (const bf16_t*)(c.ws() + WS_Z) + (Q ? ZDQ : ZDKV);
    const bf16_t* Bt = Q ? (const bf16_t*)(c.ws() + WS_WUQ) + (size_t)l * 384 * 256 : (const bf16_t*)(c.ws() + WS_WUKV) + (size_t)l * 512 * 128;
    int m0 = Q ? (ctxo ? (r / NT) * 128 : lat_tile_m0(r / NT)) : (r / NT) * 128, tn = r % NT;
    UpLd<K> cur = up_load<K>(A + (size_t)m0 * D_IN_PAD, Bt + (size_t)tn * 128 * K);
    for (;;) {
        __syncthreads();
        up_stage<K>(c.smem, cur);
        __syncthreads();
        const int rn = r + G; const bool more = rn < n; const int rx = more ? rn : r;
        const int m0n = Q ? (ctxo ? (rx / NT) * 128 : lat_tile_m0(rx / NT)) : (rx / NT) * 128, tnn = rx % NT;
        const UpLd<K> nxt = up_load<K>(A + (size_t)m0n * D_IN_PAD, Bt + (size_t)tnn * 128 * K);
        SCHED_FENCE();
        f32x4 acc[4][2];
        const bool tr = Q || ((ltid() >> 6) & 3) < 2;
        up_mma<K>(acc, c.smem, tr);
        if (Q) p3_qup_epilogue(c, acc, m0, tn); else p3_kvup_epilogue(c, acc, m0, tn);
        if (!more) break;
        SCHED_FENCE();
        cur = nxt; r = rn; m0 = m0n; tn = tnn;
    }
}
DEV void p3_krope_item(const Ctx& c, int item) {
    const int tid = ltid(), grow = item * 16 + (tid >> 5), j = tid & 31;
    const int b = grow / NTOK, p = grow % NTOK;
    const bf16_t* z = (const bf16_t*)(c.ws() + WS_Z) + (size_t)grow * D_IN_PAD + ZKR;
    float v = bf2f(z[j]);
    if (p >= CTX_LEN) {
        const float other = bf2f(z[j ^ 16]);
        const int t = p - CTX_LEN; const float pos = (float)(((j & 15) < 8) ? (t / GRID_W) : (t % GRID_W));
        const float invf = __expf(-(float)(j & 7) * (9.210340371976184f / 8.0f));
        const float ang = pos * invf, cs = __cosf(ang), sn = __sinf(ang);
        v = (j < 16) ? (v * cs - other * sn) : (other * sn + v * cs);
    }
    const bf16_t o = f2bf(v);
#pragma unroll
    for (int hh = 0; hh < 4; ++hh) ((bf16_t*)(c.ws() + WS_MK))[(((size_t)b * 4 + hh) * NTOK + p) * 96 + 64 + j] = o;
}

DEV int xcd_item(int m, int nbh, int nqb) {
    const int xcd = m & 7, slot = m >> 3, bh = xcd * (nbh >> 3) + slot / nqb, qb = slot % nqb; return bh * nqb + qb;
}
static_assert((BATCH * 4) % 8 == 0, "xcd item map");
typedef float f32x16 __attribute__((ext_vector_type(16)));
typedef short bf16x4 __attribute__((ext_vector_type(4)));
constexpr int NA_LAT_ITEMS = BATCH * 4 * (ROWS / 4), NA_CTX_ITEMS = BATCH * 4 * (CTX_LEN / 256);
constexpr int NA_TB = 64 * GS * 2, NA_BUF = 2 * NA_TB;
static_assert(ROWS % 4 == 0, "na rows");
DEV int na_rs(int r) { int rs = r - 4; return rs < 0 ? 0 : (rs > ROWS - 8 ? ROWS - 8 : rs); }
#ifdef EMU
#define NA_PIN(x)
#else
#define NA_PIN(x) asm volatile("" : "+v"(x))
#endif
template <int H> DEV void na_local_step(const f32x16 (&st)[2], const float* rrow, int cs, int lh, int lr, float& m, float& lsum, f32x16 (&o)[2], const bf16_t* vb) {
    constexpr int TF = H, TP = 1 - H, KP0 = H ? 12 : 0;
    const float SCL = 0.125f * 1.4426950408889634f;
    float sv[16], sp[4]; float mx = -1e30f;
    int base = cs - 4 * lh;
#ifndef EMU
    asm volatile("" : "+v"(base));
#endif
    const float* rb = rrow + 4 * lh;
    float bs[20];
#pragma unroll
    for (int k = 0; k < 16; ++k) bs[k] = rb[TF * 32 + (k & 3) + 8 * (k >> 2)];
#pragma unroll
    for (int q = 0; q < 4; ++q) bs[16 + q] = rb[TP * 32 + ((KP0 + q) & 3) + 8 * ((KP0 + q) >> 2)];
#pragma unroll
    for (int k = 0; k < 20; ++k) NA_PIN(bs[k]);
#pragma unroll
    for (int k = 0; k < 16; ++k) { const int kk = TF * 32 + (k & 3) + 8 * (k >> 2);
        const bool valid = (unsigned)(kk - base) < 16u;
        const float v = valid ? st[TF][k] * SCL + bs[k] : -1e30f; sv[k] = v; mx = fmaxf(mx, v); }
#pragma unroll
    for (int q = 0; q < 4; ++q) { const int k = KP0 + q; const int kk = TP * 32 + (k & 3) + 8 * (k >> 2);
        const bool valid = (unsigned)(kk - base) < 16u;
        const float v = valid ? st[TP][k] * SCL + bs[16 + q] : -1e30f; sp[q] = v; mx = fmaxf(mx, v); }
    mx = fmaxf(mx, __shfl_xor(mx, 32));
    const float mn = fmaxf(m, mx), alpha = fast_exp2(m - mn); m = mn;
    float rsum = 0.f; bf16x8 pfF[2], pfP;
#pragma unroll
    for (int s2 = 0; s2 < 2; ++s2) { U4 pk;
#pragma unroll
        for (int j = 0; j < 4; ++j) { const float p0 = fast_exp2(sv[s2 * 8 + 2 * j] - mn), p1 = fast_exp2(sv[s2 * 8 + 2 * j + 1] - mn); rsum += p0 + p1; pk[j] = cvt_pk_bf16(p0, p1); }
        pfF[s2] = __builtin_bit_cast(bf16x8, pk); }
    { const float e0 = fast_exp2(sp[0] - mn), e1 = fast_exp2(sp[1] - mn), e2 = fast_exp2(sp[2] - mn), e3 = fast_exp2(sp[3] - mn); rsum += (e0 + e1) + (e2 + e3);
      U4 pk; pk.x = 0u; pk.y = 0u; pk.z = 0u; pk.w = 0u;
      if (H == 0) { pk.x = cvt_pk_bf16(e0, e1); pk.y = cvt_pk_bf16(e2, e3); } else { pk.z = cvt_pk_bf16(e0, e1); pk.w = cvt_pk_bf16(e2, e3); }
      pfP = __builtin_bit_cast(bf16x8, pk); }
    lsum = lsum * alpha + rsum;
    if (__ballot(alpha != 1.0f) != 0ull) {
#pragma unroll
        for (int k = 0; k < 16; ++k) { o[0][k] *= alpha; o[1][k] *= alpha; } }
#pragma unroll
    for (int u = 0; u < 3; ++u) { const int ks = (u < 2) ? TF * 2 + u : TP * 2 + (H ? 1 : 0); const bf16x8 pf = (u == 0) ? pfF[0] : (u == 1) ? pfF[1] : pfP;
#pragma unroll
        for (int dt = 0; dt < 2; ++dt) { const bf16_t* vp = vb + (dt * 32 + lr) * GS + ks * 16 + lh * 4;
            const bf16x4 v0 = *(const bf16x4*)vp, v1 = *(const bf16x4*)(vp + 8);
            bf16x8 a; a[0] = v0[0]; a[1] = v0[1]; a[2] = v0[2]; a[3] = v0[3]; a[4] = v1[0]; a[5] = v1[1]; a[6] = v1[2]; a[7] = v1[3];
            o[dt] = __builtin_amdgcn_mfma_f32_32x32x16_bf16(a, pf, o[dt], 0, 0, 0); } }
}
DEV void p3_na_item(const Ctx& c, int item) {
    const int tid = ltid(), lane = tid & 63, wv = tid >> 6, lr = lane & 31, lh = lane >> 5, l = c.layer;
    const bf16_t* Z = (const bf16_t*)(c.ws() + WS_Z);
    int b, hh, q0, r = 0, rs = 0, qcol = 0, wlo = 0, nloc = 0; bool lat;
    if (item < NA_LAT_ITEMS) { lat = true; item = xcd_item(item, BATCH * 4, ROWS / 4); const int rg = item % (ROWS / 4); hh = (item / (ROWS / 4)) & 3; b = item / (ROWS / 4) / 4;
        r = rg * 4 + (wv >> 1); rs = na_rs(r); wlo = na_rs(rg * 4); nloc = na_rs(rg * 4 + 3) + 8 - wlo; q0 = CTX_LEN + r * GRID_W + (wv & 1) * 32; qcol = (wv & 1) * 32 + lr; }
    else { lat = false; const int it = item - NA_LAT_ITEMS; const int qb = it % (CTX_LEN / 256); hh = (it / (CTX_LEN / 256)) & 3; b = it / (CTX_LEN / 256) / 4; q0 = qb * 256 + wv * 32; }
    const size_t tok0 = (size_t)b * NTOK;
    bf16x8 q[4];
#pragma unroll
    for (int ks = 0; ks < 4; ++ks) q[ks] = *(const bf16x8*)(Z + (tok0 + q0 + lr) * ZS + ZQA + hh * 64 + ks * 16 + lh * 8);
    const bf16_t* Kg = Z + tok0 * ZS + ZKA + hh * 64;
    const bf16_t* Vg = (const bf16_t*)(c.ws() + WS_NAVT) + ((size_t)b * 4 + hh) * 64 * NTOK;
    float* rpb = (float*)(c.smem + 2 * NA_BUF);
    const int nstep = nloc + CTX_LEN / 64;
    const int sr = tid >> 3, sc8 = (tid & 7) * 8;
#define NA_TOK(i) ((i) < nloc ? CTX_LEN + (wlo + (i)) * GRID_W : ((i) - nloc) * 64)
    U4 rk, rv;
    { const int t0 = NA_TOK(0); rk = *(const U4*)(Kg + (size_t)(t0 + sr) * ZS + sc8); rv = *(const U4*)(Vg + (size_t)sr * NTOK + t0 + sc8); }
    __syncthreads();
    { bf16_t* kb = (bf16_t*)c.smem; bf16_t* vb = (bf16_t*)(c.smem + NA_TB); *(U4*)(kb + sr * GS + sc8) = rk; *(U4*)(vb + sr * GS + sc8) = rv;
      if (tid < 15 * 31) rpb[tid] = c.in(I_RPB)[((size_t)l * 4 + hh) * 15 * 31 + tid] * 1.4426950408889634f; }
    __syncthreads();
    f32x16 o[2]; float m = -1e30f, lsum = 0.f;
#pragma unroll
    for (int i = 0; i < 16; ++i) { o[0][i] = 0.f; o[1][i] = 0.f; }
    int cs = qcol - 8; cs = cs < 0 ? 0 : (cs > GRID_W - 16 ? GRID_W - 16 : cs);
    for (int i = 0; i < nstep; ++i) {
        const bf16_t* kb = (const bf16_t*)(c.smem + (i & 1) * NA_BUF); const bf16_t* vb = (const bf16_t*)(c.smem + (i & 1) * NA_BUF + NA_TB);
        if (i + 1 < nstep) { const int t1 = NA_TOK(i + 1); rk = *(const U4*)(Kg + (size_t)(t1 + sr) * ZS + sc8); rv = *(const U4*)(Vg + (size_t)sr * NTOK + t1 + sc8); }
        const bool local = i < nloc; const int wrow = wlo + i;
        if (!local || (lat && wrow >= rs && wrow < rs + 8)) {
            f32x16 st[2];
#pragma unroll
            for (int t = 0; t < 2; ++t) {
#pragma unroll
                for (int k = 0; k < 16; ++k) st[t][k] = 0.f;
#pragma unroll
                for (int ks = 0; ks < 4; ++ks) { const bf16x8 a = *(const bf16x8*)(kb + (t * 32 + lr) * GS + ks * 16 + lh * 8); st[t] = __builtin_amdgcn_mfma_f32_32x32x16_bf16(a, q[ks], st[t], 0, 0, 0); }
            }
            if (local) {
                const float* rrow = rpb + (wrow - r + 7) * 31 - qcol + 15;
                if ((__builtin_amdgcn_readfirstlane(wv) & 1) == 0) na_local_step<0>(st, rrow, cs, lh, lr, m, lsum, o, vb); else na_local_step<1>(st, rrow, cs, lh, lr, m, lsum, o, vb);
            } else {
                const float SCL = 0.125f * 1.4426950408889634f;
                float mx = -1e30f;
#pragma unroll
                for (int t = 0; t < 2; ++t)
#pragma unroll
                    for (int k = 0; k < 16; ++k) { const float v = st[t][k] * SCL; st[t][k] = v; mx = fmaxf(mx, v); }
                mx = fmaxf(mx, __shfl_xor(mx, 32));
                const float mn = fmaxf(m, mx), alpha = fast_exp2(m - mn); m = mn;
                float rsum = 0.f; bf16x8 pf[4];
#pragma unroll
                for (int t = 0; t < 2; ++t)
#pragma unroll
                    for (int s2 = 0; s2 < 2; ++s2) { U4 pk;
#pragma unroll
                        for (int j = 0; j < 4; ++j) { const float p0 = fast_exp2(st[t][s2 * 8 + 2 * j] - mn), p1 = fast_exp2(st[t][s2 * 8 + 2 * j + 1] - mn); rsum += p0 + p1; pk[j] = cvt_pk_bf16(p0, p1); }
                        pf[t * 2 + s2] = __builtin_bit_cast(bf16x8, pk); }
                lsum = lsum * alpha + rsum;
                if (__ballot(alpha != 1.0f) != 0ull) {
#pragma unroll
                    for (int k = 0; k < 16; ++k) { o[0][k] *= alpha; o[1][k] *= alpha; } }
#pragma unroll
                for (int ks = 0; ks < 4; ++ks)
#pragma unroll
                    for (int dt = 0; dt < 2; ++dt) { const bf16_t* vp = vb + (dt * 32 + lr) * GS + ks * 16 + lh * 4;
                        const bf16x4 v0 = *(const bf16x4*)vp, v1 = *(const bf16x4*)(vp + 8);
                        bf16x8 a; a[0] = v0[0]; a[1] = v0[1]; a[2] = v0[2]; a[3] = v0[3]; a[4] = v1[0]; a[5] = v1[1]; a[6] = v1[2]; a[7] = v1[3];
                        o[dt] = __builtin_amdgcn_mfma_f32_32x32x16_bf16(a, pf[ks], o[dt], 0, 0, 0); }
            }
        }
        if (i + 1 < nstep) { bf16_t* kn = (bf16_t*)(c.smem + ((i + 1) & 1) * NA_BUF); bf16_t* vn = (bf16_t*)(c.smem + ((i + 1) & 1) * NA_BUF + NA_TB); *(U4*)(kn + sr * GS + sc8) = rk; *(U4*)(vn + sr * GS + sc8) = rv; }
        __syncthreads();
    }
#undef NA_TOK
    const float inv = 1.0f / (lsum + __shfl_xor(lsum, 32));
    bf16_t* out = (bf16_t*)(c.ws() + WS_OCAT) + (tok0 + q0 + lr) * 1024 + hh * 64;
#pragma unroll
    for (int dt = 0; dt < 2; ++dt)
#pragma unroll
        for (int rg = 0; rg < 4; ++rg) { U2 w; w.x = pack2(o[dt][rg * 4 + 0] * inv, o[dt][rg * 4 + 1] * inv); w.y = pack2(o[dt][rg * 4 + 2] * inv, o[dt][rg * 4 + 3] * inv);
            *(U2*)(out + dt * 32 + rg * 8 + lh * 4) = w; }
}
constexpr int MLA_KS = 104, MLA_VS = 72;
constexpr int MLA_KBYTES = 64 * MLA_KS * 2, MLA_VBYTES = 64 * MLA_VS * 2, MLA_BUF = MLA_KBYTES + MLA_VBYTES;
constexpr int MLA_LAT_ITEMS = BATCH * 4 * (SEQ / 256), MLA_CTX_ITEMS = BATCH * 4 * (CTX_LEN / 256);
DEV void p4_mla_item(const Ctx& c, int item) {
    const int tid = ltid(), lane = tid & 63, wv = tid >> 6, lr = lane & 31, lh = lane >> 5;
    int b, hh, q0, nkeys;
    if (item < MLA_LAT_ITEMS) { item = xcd_item(item, BATCH * 4, SEQ / 256); const int qb = item % (SEQ / 256); hh = (item / (SEQ / 256)) & 3; b = item / (SEQ / 256) / 4; q0 = CTX_LEN + qb * 256; nkeys = NTOK; }
    else { const int it = item - MLA_LAT_ITEMS; const int qb = it % (CTX_LEN / 256); hh = (it / (CTX_LEN / 256)) & 3; b = it / (CTX_LEN / 256) / 4; q0 = qb * 256; nkeys = CTX_LEN; }
    const bf16_t* Q = (const bf16_t*)(c.ws() + WS_MQ) + ((size_t)b * 4 + hh) * NTOK * 96;
    const bf16_t* K = (const bf16_t*)(c.ws() + WS_MK) + ((size_t)b * 4 + hh) * NTOK * 96;
    const bf16_t* Vt = (const bf16_t*)(c.ws() + WS_MVT) + ((size_t)b * 4 + hh) * 64 * NTOK;
    bf16x8 q[6];
#pragma unroll
    for (int ks = 0; ks < 6; ++ks) q[ks] = *(const bf16x8*)(Q + (size_t)(q0 + wv * 32 + lr) * 96 + ks * 16 + lh * 8);
    const int kr0 = tid / 12, kc0 = (tid % 12) * 8, kr1 = (512 + tid) / 12, kc1 = ((512 + tid) % 12) * 8, vr = tid >> 3, vc = (tid & 7) * 8;
    U4 rk0, rk1, rv;
    rk0 = *(const U4*)(K + (size_t)kr0 * 96 + kc0); if (tid < 256) rk1 = *(const U4*)(K + (size_t)kr1 * 96 + kc1); rv = *(const U4*)(Vt + (size_t)vr * NTOK + vc);
    __syncthreads();
    { bf16_t* kb = (bf16_t*)c.smem; bf16_t* vb = (bf16_t*)(c.smem + MLA_KBYTES);
      *(U4*)(kb + kr0 * MLA_KS + kc0) = rk0; if (tid < 256) *(U4*)(kb + kr1 * MLA_KS + kc1) = rk1; *(U4*)(vb + vr * MLA_VS + vc) = rv; }
    __syncthreads();
    f32x16 o[2]; float m = -1e30f, lsum = 0.f;
#pragma unroll
    for (int i = 0; i < 16; ++i) { o[0][i] = 0.f; o[1][i] = 0.f; }
    const int ntile = nkeys / 64;
    for (int kt = 0; kt < ntile; ++kt) {
        const bf16_t* kb = (const bf16_t*)(c.smem + (kt & 1) * MLA_BUF); const bf16_t* vb = (const bf16_t*)(c.smem + (kt & 1) * MLA_BUF + MLA_KBYTES);
        if (kt + 1 < ntile) { const int t1 = (kt + 1) * 64;
            rk0 = *(const U4*)(K + (size_t)(t1 + kr0) * 96 + kc0); if (tid < 256) rk1 = *(const U4*)(K + (size_t)(t1 + kr1) * 96 + kc1); rv = *(const U4*)(Vt + (size_t)vr * NTOK + t1 + vc); }
        f32x16 st[2];
#pragma unroll
        for (int t = 0; t < 2; ++t) {
#pragma unroll
            for (int i = 0; i < 16; ++i) st[t][i] = 0.f;
#pragma unroll
            for (int ks = 0; ks < 6; ++ks) { const bf16x8 a = *(const bf16x8*)(kb + (t * 32 + lr) * MLA_KS + ks * 16 + lh * 8); st[t] = __builtin_amdgcn_mfma_f32_32x32x16_bf16(a, q[ks], st[t], 0, 0, 0); }
        }
        float mx = st[0][0];
#pragma unroll
        for (int t = 0; t < 2; ++t)
#pragma unroll
            for (int i = 0; i < 16; ++i) mx = fmaxf(mx, st[t][i]);
        mx = fmaxf(mx, __shfl_xor(mx, 32));
        const float mn = fmaxf(m, mx), alpha = fast_exp2(m - mn); m = mn;
        float rs = 0.f;
        bf16x8 pf[4];
#pragma unroll
        for (int t = 0; t < 2; ++t)
#pragma unroll
            for (int s2 = 0; s2 < 2; ++s2) { U4 pk;
#pragma unroll
                for (int j = 0; j < 4; ++j) { const float p0 = fast_exp2(st[t][s2 * 8 + 2 * j] - mn), p1 = fast_exp2(st[t][s2 * 8 + 2 * j + 1] - mn); rs += p0 + p1; pk[j] = cvt_pk_bf16(p0, p1); }
                pf[t * 2 + s2] = __builtin_bit_cast(bf16x8, pk); }
        lsum = lsum * alpha + rs;
        if (__ballot(alpha != 1.0f) != 0ull) {
#pragma unroll
            for (int i = 0; i < 16; ++i) { o[0][i] *= alpha; o[1][i] *= alpha; } }
#pragma unroll
        for (int ks = 0; ks < 4; ++ks)
#pragma unroll
            for (int dt = 0; dt < 2; ++dt) {
                const bf16_t* vp = vb + (dt * 32 + lr) * MLA_VS + ks * 16 + lh * 4;
                const bf16x4 v0 = *(const bf16x4*)vp, v1 = *(const bf16x4*)(vp + 8);
                bf16x8 a; a[0] = v0[0]; a[1] = v0[1]; a[2] = v0[2]; a[3] = v0[3]; a[4] = v1[0]; a[5] = v1[1]; a[6] = v1[2]; a[7] = v1[3];
                o[dt] = __builtin_amdgcn_mfma_f32_32x32x16_bf16(a, pf[ks], o[dt], 0, 0, 0);
            }
        if (kt + 1 < ntile) { bf16_t* kn = (bf16_t*)(c.smem + ((kt + 1) & 1) * MLA_BUF); bf16_t* vn = (bf16_t*)(c.smem + ((kt + 1) & 1) * MLA_BUF + MLA_KBYTES);
            *(U4*)(kn + kr0 * MLA_KS + kc0) = rk0; if (tid < 256) *(U4*)(kn + kr1 * MLA_KS + kc1) = rk1; *(U4*)(vn + vr * MLA_VS + vc) = rv; }
        __syncthreads();
    }
    const float inv = 1.0f / (lsum + __shfl_xor(lsum, 32));
    bf16_t* out = (bf16_t*)(c.ws() + WS_OCAT) + ((size_t)b * NTOK + q0 + wv * 32 + lr) * 1024 + 256 + hh * 64;
#pragma unroll
    for (int dt = 0; dt < 2; ++dt)
#pragma unroll
        for (int rg = 0; rg < 4; ++rg) { U2 w; w.x = pack2(o[dt][rg * 4 + 0] * inv, o[dt][rg * 4 + 1] * inv); w.y = pack2(o[dt][rg * 4 + 2] * inv, o[dt][rg * 4 + 3] * inv);
            *(U2*)(out + dt * 32 + rg * 8 + lh * 4) = w; }
}

constexpr int BCS = 65, BCD = 64 * BCS;
constexpr int GL_B = 0;
constexpr int GL_X0 = 33280;
static_assert(2 * BCD * 4 <= GL_X0 && GL_X0 % 16 == 0, "bc");
struct GateLd { U4 bh, bl, a0, a1, a2, a3; float bias; };
DEV GateLd gla_gates_load(const Ctx& c, int b, int hh, int ch) {
    const int tid = ltid(), lane = tid & 63, wv = tid >> 6, l = c.layer, lr = lane & 15, q4 = lane >> 4;
    const int dir = wv >> 2, dblk = (wv & 3) * 16;
    const bf16_t* Z = (const bf16_t*)(c.ws() + WS_Z) + ((size_t)b * NTOK + ch * 64) * ZS + (dir == 0 ? ZAF : ZAB);
    const bf16_t* wt = (const bf16_t*)(c.ws() + WS_WGT) + ((size_t)(l * 2 + dir) * 2 * 256 + hh * 64 + dblk + lr) * 16;
    const int qc = q4 & 1;
    GateLd g;
    g.bh = *(const U4*)(wt + qc * 8); g.bl = *(const U4*)(wt + 256 * 16 + qc * 8);
    g.a0 = *(const U4*)(Z + (size_t)(0 * 16 + lr) * ZS + qc * 8); g.a1 = *(const U4*)(Z + (size_t)(1 * 16 + lr) * ZS + qc * 8);
    g.a2 = *(const U4*)(Z + (size_t)(2 * 16 + lr) * ZS + qc * 8); g.a3 = *(const U4*)(Z + (size_t)(3 * 16 + lr) * ZS + qc * 8);
    const float* pf = c.in(I_BAF); const float* pb = c.in(I_BAB);
    g.bias = (dir == 0 ? pf : pb)[l * 256 + hh * 64 + dblk + lr];
    return g;
}
DEV void gla_gates_compute(const Ctx& c, const GateLd& g) {
    const int tid = ltid(), lane = tid & 63, wv = tid >> 6, lr = lane & 15, q4 = lane >> 4;
    const int dir = wv >> 2, dblk = (wv & 3) * 16;
    float* bc = (float*)(c.smem + GL_B);
    const uint32_t kmask = q4 < 2 ? 0xFFFFFFFFu : 0u;
    const float bias = g.bias;
    U4 ar[4]; ar[0] = g.a0; ar[1] = g.a1; ar[2] = g.a2; ar[3] = g.a3;
    const U4 bhr = g.bh & kmask, blr = g.bl & kmask;
    const bf16x8 bh = __builtin_bit_cast(bf16x8, bhr), bl = __builtin_bit_cast(bf16x8, blr);
    f32x4 z[4];
#pragma unroll
    for (int mt = 0; mt < 4; ++mt) { const bf16x8 a = __builtin_bit_cast(bf16x8, ar[mt] & kmask);
        z[mt] = f32x4{bias, bias, bias, bias};
        z[mt] = __builtin_amdgcn_mfma_f32_16x16x32_bf16(a, bh, z[mt], 0, 0, 0); z[mt] = __builtin_amdgcn_mfma_f32_16x16x32_bf16(a, bl, z[mt], 0, 0, 0); }
    float S[4];
#pragma unroll
    for (int mt = 0; mt < 4; ++mt) { S[mt] = 0.f;
#pragma unroll
        for (int j = 0; j < 4; ++j) { const float x = z[mt][j]; const float g = (fminf(x, 0.0f) - __logf(1.0f + __expf(-fabsf(x)))) * (1.0f / 16.0f); z[mt][j] = g; S[mt] += g; } }
    float off[4];
    { float x1[4], x2[4], x3[4], T[4];
#pragma unroll
      for (int mt = 0; mt < 4; ++mt) { x1[mt] = __shfl_xor(S[mt], 16); x2[mt] = __shfl_xor(S[mt], 32); x3[mt] = __shfl_xor(S[mt], 48); T[mt] = S[mt] + x1[mt] + x2[mt] + x3[mt]; }
#pragma unroll
      for (int mt = 0; mt < 4; ++mt) {
          float o;
          if (dir == 0) { o = ((q4 & 1) ? x1[mt] : 0.f) + ((q4 & 2) ? x2[mt] + x3[mt] : 0.f);
#pragma unroll
              for (int m2 = 0; m2 < 4; ++m2) if (m2 < mt) o += T[m2]; }
          else { o = ((q4 & 1) ? 0.f : x1[mt]) + ((q4 & 2) ? 0.f : x2[mt] + x3[mt]);
#pragma unroll
              for (int m2 = 0; m2 < 4; ++m2) if (m2 > mt) o += T[m2]; }
          off[mt] = o; } }
    __syncthreads();
#pragma unroll
    for (int mt = 0; mt < 4; ++mt) {
        float run = off[mt];
        if (dir == 0) {
#pragma unroll
            for (int j = 0; j < 4; ++j) { run += z[mt][j]; bc[(mt * 16 + q4 * 4 + j) * BCS + dblk + lr] = run; }
        } else {
#pragma unroll
            for (int j = 3; j >= 0; --j) { run += z[mt][j]; bc[BCD + (mt * 16 + q4 * 4 + j) * BCS + dblk + lr] = run; }
        }
    }
    __syncthreads();
}
constexpr int G1_ITEMS = BATCH * 4 * NCH;
struct G1Pre { GateLd gl; U4 kraw; };
DEV G1Pre g1_prefetch(const Ctx& c, int item) {
    const int ch = item % NCH, hh = (item / NCH) & 3, b = item / NCH / 4; const int tid = ltid();
    G1Pre p; p.gl = gla_gates_load(c, b, hh, ch);
    p.kraw = *(const U4*)((const bf16_t*)(c.ws() + WS_Z) + ((size_t)b * NTOK + ch * 64 + (tid & 63)) * ZS + ZGK + hh * 64 + (tid >> 6) * 8);
    return p;
}
DEV void p3_gla_g1_body(const Ctx& c, int item, const G1Pre& cur, int nitem, G1Pre& nxt) {
    const int ch = item % NCH, hh = (item / NCH) & 3, b = item / NCH / 4;
    const int tid = ltid(), lane = tid & 63, wave = tid >> 6, lr = lane & 15, lq = lane >> 4;
    const bf16_t* Vt = (const bf16_t*)(c.ws() + WS_GVT) + ((size_t)b * 4 + hh) * 128 * NTOK + ch * 64;
    U4 vfr[2][8];
#pragma unroll
    for (int ks = 0; ks < 2; ++ks)
#pragma unroll
        for (int nt = 0; nt < 8; ++nt) vfr[ks][nt] = *(const U4*)(Vt + (size_t)(nt * 16 + lr) * NTOK + ks * 32 + lq * 8);
    nxt = g1_prefetch(c, nitem);
    const GateLd gl = cur.gl; const U4 kraw = cur.kraw;
    SCHED_FENCE();
    gla_gates_compute(c, gl);
    const float* bc = (const float*)(c.smem + GL_B);
    bf16_t* kte = (bf16_t*)(c.smem + GL_X0);
    { const int sI = tid & 63, d0 = (tid >> 6) * 8;
#pragma unroll
      for (int dir = 0; dir < 2; ++dir) {
          const float* bl = bc + dir * BCD + (dir == 0 ? 63 * BCS : 0) + d0; const float* bs = bc + dir * BCD + sI * BCS + d0;
#pragma unroll
          for (int i = 0; i < 8; ++i) { const float kv = bf2f((bf16_t)((i & 1) ? (kraw[i >> 1] >> 16) : (kraw[i >> 1] & 0xFFFF)));
              kte[(dir * 64 + d0 + i) * GS + sI] = f2bf(kv * __expf(bl[i] - bs[i])); } } }
    __syncthreads();
    const int dir = wave >> 2, mt = wave & 3;
    f32x4 acc[8];
#pragma unroll
    for (int nt = 0; nt < 8; ++nt) acc[nt] = f32x4{0.f, 0.f, 0.f, 0.f};
#pragma unroll
    for (int ks = 0; ks < 2; ++ks) {
        const bf16x8 a = *(const bf16x8*)(kte + (dir * 64 + mt * 16 + lr) * GS + ks * 32 + lq * 8);
#pragma unroll
        for (int nt = 0; nt < 8; ++nt) acc[nt] = __builtin_amdgcn_mfma_f32_16x16x32_bf16(a, __builtin_bit_cast(bf16x8, vfr[ks][nt]), acc[nt], 0, 0, 0);
    }
    bf16_t* KV = (bf16_t*)(c.ws() + WS_EXP + GLA_KV) + ((((size_t)b * 4 + hh) * 2 + dir) * NCH + ch) * 64 * 128;
#pragma unroll
    for (int nt = 0; nt < 8; ++nt) { U2 w; w.x = pack2(acc[nt][0], acc[nt][1]); w.y = pack2(acc[nt][2], acc[nt][3]); *(U2*)(KV + (size_t)(nt * 16 + lr) * 64 + mt * 16 + lq * 4) = w; }
    if (tid < 128) { int dr = tid >> 6, d = tid & 63; ((float*)(c.ws() + WS_EXP + GLA_DEC))[((((size_t)b * 4 + hh) * 2 + dr) * NCH + ch) * 64 + d] = __expf(dr == 0 ? bc[63 * BCS + d] : bc[BCD + d]); }
}
DEV void p3_gla_g1_range(const Ctx& c, int r, int n, int G) {
    G1Pre cur = g1_prefetch(c, r);
    for (;;) {
        const int rn = r + G; const bool more = rn < n;
        G1Pre nxt; p3_gla_g1_body(c, r, cur, more ? rn : r, nxt);
        if (!more) break;
        SCHED_FENCE();
        cur = nxt; r = rn;
    }
}
constexpr int G2_ITEMS = BATCH * 4 * 2 * 4;
DEV int gla_order_chunk(int dir, int i) { if (dir == 0) return i; return (i < NCC) ? (NCC - 1 - i) : (NCH - 1 - (i - NCC)); }
DEV void p4_gla_g2_item(const Ctx& c, int item) {
    const int vq = item & 3, seq = item >> 2, dir = seq & 1;
    const int tid = ltid(), v = vq * 32 + (tid >> 4), d0 = (tid & 15) * 4;
    const bf16_t* KV = (const bf16_t*)(c.ws() + WS_EXP + GLA_KV) + (size_t)seq * NCH * 64 * 128;
    const float* DEC = (const float*)(c.ws() + WS_EXP + GLA_DEC) + (size_t)seq * NCH * 64;
    bf16_t* SP = (bf16_t*)(c.ws() + WS_EXP + GLA_SP) + (size_t)seq * NCH * 64 * 128;
    f32x4 s = f32x4{0.f, 0.f, 0.f, 0.f};
    constexpr int HB = NCH / 2; static_assert(NCH % 2 == 0, "g2 batches");
#pragma unroll 1
    for (int half = 0; half < 2; ++half) {
        U2 kvr[HB]; f32x4 dec[HB];
#pragma unroll
        for (int i = 0; i < HB; ++i) { const int n = gla_order_chunk(dir, half * HB + i); kvr[i] = *(const U2*)(KV + ((size_t)n * 128 + v) * 64 + d0); dec[i] = *(const f32x4*)(DEC + n * 64 + d0); }
#pragma unroll
        for (int i = 0; i < HB; ++i) { const int n = gla_order_chunk(dir, half * HB + i);
            U2 pk; pk.x = pack2(s[0], s[1]); pk.y = pack2(s[2], s[3]);
            *(U2*)(SP + ((size_t)n * 128 + v) * 64 + d0) = pk;
            const f32x4 kv = f32x4{bf2f((bf16_t)(kvr[i].x & 0xFFFF)), bf2f((bf16_t)(kvr[i].x >> 16)), bf2f((bf16_t)(kvr[i].y & 0xFFFF)), bf2f((bf16_t)(kvr[i].y >> 16))};
            s = dec[i] * s + kv; }
    }
}
constexpr int G3_QD = GL_X0;
constexpr int G3_KD = G3_QD + 2 * 64 * GS * 2;
constexpr int G3_AM = G3_KD + 2 * 64 * GS * 2;
constexpr int G3_SS = G3_AM + 2 * 64 * GS * 2;
static_assert(G3_SS + 64 * 2 * 4 <= LDS_MISC, "lds");
struct G3Pre { GateLd gl; U4 qraw, kraw; };
DEV G3Pre g3_prefetch(const Ctx& c, int b, int hh, int ch) {
    const int tid = ltid();
    G3Pre p; p.gl = gla_gates_load(c, b, hh, ch);
    const bf16_t* Z = (const bf16_t*)(c.ws() + WS_Z) + ((size_t)b * NTOK + ch * 64) * ZS;
    p.qraw = *(const U4*)(Z + (size_t)(tid >> 3) * ZS + ZGQ + hh * 64 + (tid & 7) * 8); p.kraw = *(const U4*)(Z + (size_t)(tid >> 3) * ZS + ZGK + hh * 64 + (tid & 7) * 8);
    return p;
}
DEV void p5_gla_g3_body(const Ctx& c, int b, int hh, int ch, const G3Pre& cur, int bn, int hn, int cn, G3Pre& nxt) {
    const int tid = ltid(), lane = tid & 63, wave = tid >> 6, lr = lane & 15, lq = lane >> 4, l = c.layer;
    const size_t row0 = (size_t)b * NTOK + ch * 64;
    const bf16_t* Z = (const bf16_t*)(c.ws() + WS_Z) + row0 * ZS;
    const int tt = wave & 3, vb = (wave >> 2) * 4;
    U4 avr[2][4], asr[2][2][4];
    { const bf16_t* Vt = (const bf16_t*)(c.ws() + WS_GVT) + ((size_t)b * 4 + hh) * 128 * NTOK + ch * 64;
      const bf16_t* SP = (const bf16_t*)(c.ws() + WS_EXP + GLA_SP);
#pragma unroll
      for (int ks = 0; ks < 2; ++ks)
#pragma unroll
          for (int nt = 0; nt < 4; ++nt) avr[ks][nt] = *(const U4*)(Vt + (size_t)((vb + nt) * 16 + lr) * NTOK + ks * 32 + lq * 8);
#pragma unroll
      for (int dir = 0; dir < 2; ++dir) { const bf16_t* spd = SP + ((((size_t)b * 4 + hh) * 2 + dir) * NCH + ch) * 128 * 64;
#pragma unroll
          for (int ks = 0; ks < 2; ++ks)
#pragma unroll
              for (int nt = 0; nt < 4; ++nt) asr[dir][ks][nt] = *(const U4*)(spd + (size_t)((vb + nt) * 16 + lr) * 64 + ks * 32 + lq * 8); } }
    nxt = g3_prefetch(c, bn, hn, cn);
    const GateLd gl = cur.gl; const U4 qraw = cur.qraw, kraw = cur.kraw;
    SCHED_FENCE();
    gla_gates_compute(c, gl);
    const float* bc = (const float*)(c.smem + GL_B);
    bf16_t* qd = (bf16_t*)(c.smem + G3_QD); bf16_t* kd = (bf16_t*)(c.smem + G3_KD); bf16_t* am = (bf16_t*)(c.smem + G3_AM);
    float* ssq = (float*)(c.smem + G3_SS);
    { const int t = tid >> 3, d0 = (tid & 7) * 8;
#pragma unroll
      for (int dir = 0; dir < 2; ++dir) { const float* bp = bc + dir * BCD + t * BCS + d0; U4 qo, ko;
#pragma unroll
          for (int i = 0; i < 4; ++i) { const float e0 = __expf(bp[2 * i]), e1 = __expf(bp[2 * i + 1]);
              qo[i] = pack2(bf2f((bf16_t)(qraw[i] & 0xFFFF)) * 0.125f * e0, bf2f((bf16_t)(qraw[i] >> 16)) * 0.125f * e1);
              ko[i] = pack2(bf2f((bf16_t)(kraw[i] & 0xFFFF)) * fast_rcp(e0), bf2f((bf16_t)(kraw[i] >> 16)) * fast_rcp(e1)); }
          *(U4*)(qd + (dir * 64 + t) * GS + d0) = qo; *(U4*)(kd + (dir * 64 + t) * GS + d0) = ko; } }
    __syncthreads();
    { const int dir = wave >> 2, stl = wave & 3;
      f32x4 a4[4];
#pragma unroll
      for (int nt = 0; nt < 4; ++nt) a4[nt] = f32x4{0.f, 0.f, 0.f, 0.f};
#pragma unroll
      for (int ks = 0; ks < 2; ++ks) { const bf16x8 a = *(const bf16x8*)(kd + (dir * 64 + stl * 16 + lr) * GS + ks * 32 + lq * 8);
#pragma unroll
          for (int nt = 0; nt < 4; ++nt) { bf16x8 qf = *(const bf16x8*)(qd + (dir * 64 + nt * 16 + lr) * GS + ks * 32 + lq * 8); a4[nt] = __builtin_amdgcn_mfma_f32_16x16x32_bf16(a, qf, a4[nt], 0, 0, 0); } }
#pragma unroll
      for (int nt = 0; nt < 4; ++nt) { const int t = nt * 16 + lr, s0 = stl * 16 + lq * 4; float o[4];
#pragma unroll
          for (int j = 0; j < 4; ++j) { const int sI = s0 + j; const bool keep = (dir == 0) ? (sI <= t) : (sI >= t); o[j] = keep ? a4[nt][j] : 0.f; }
          U2 w; w.x = pack2(o[0], o[1]); w.y = pack2(o[2], o[3]); *(U2*)(am + (dir * 64 + t) * GS + s0) = w; } }
    __syncthreads();
    const float* on = c.in(I_ONORM) + l * 128;
    const bf16_t* ogp = Z + (size_t)(tt * 16 + lr) * ZS + ZOG + hh * 128;
    U2 ogr[4]; f32x4 g4r[4];
#pragma unroll
    for (int nt = 0; nt < 4; ++nt) { const int v0 = (vb + nt) * 16 + lq * 4; ogr[nt] = *(const U2*)(ogp + v0); g4r[nt] = *(const f32x4*)(on + v0); }
    f32x4 o[4];
#pragma unroll
    for (int nt = 0; nt < 4; ++nt) o[nt] = f32x4{0.f, 0.f, 0.f, 0.f};
#pragma unroll
    for (int dir = 0; dir < 2; ++dir) {
#pragma unroll
        for (int ks = 0; ks < 2; ++ks) {
            const bf16x8 ba = *(const bf16x8*)(am + (dir * 64 + tt * 16 + lr) * GS + ks * 32 + lq * 8);
            const bf16x8 bq = *(const bf16x8*)(qd + (dir * 64 + tt * 16 + lr) * GS + ks * 32 + lq * 8);
#pragma unroll
            for (int nt = 0; nt < 4; ++nt) {
                o[nt] = __builtin_amdgcn_mfma_f32_16x16x32_bf16(__builtin_bit_cast(bf16x8, avr[ks][nt]), ba, o[nt], 0, 0, 0);
                o[nt] = __builtin_amdgcn_mfma_f32_16x16x32_bf16(__builtin_bit_cast(bf16x8, asr[dir][ks][nt]), bq, o[nt], 0, 0, 0);
            }
        }
    }
    { float ss = 0.f;
#pragma unroll
      for (int nt = 0; nt < 4; ++nt) ss += o[nt][0] * o[nt][0] + o[nt][1] * o[nt][1] + o[nt][2] * o[nt][2] + o[nt][3] * o[nt][3];
      ss += __shfl_xor(ss, 16); ss += __shfl_xor(ss, 32);
      if (lq == 0) ssq[(tt * 16 + lr) * 2 + (wave >> 2)] = ss; }
    __syncthreads();
    const int t = tt * 16 + lr;
    const float r = rsqrtf((ssq[t * 2] + ssq[t * 2 + 1]) * (1.0f / 128.0f) + EPS);
    bf16_t* oc = (bf16_t*)(c.ws() + WS_OCAT) + (row0 + t) * 1024 + 512 + hh * 128;
#pragma unroll
    for (int nt = 0; nt < 4; ++nt) { const int v0 = (vb + nt) * 16 + lq * 4; const U2 og = ogr[nt]; const f32x4 g4 = g4r[nt];
        const float g0 = bf2f((bf16_t)(og.x & 0xFFFF)), g1 = bf2f((bf16_t)(og.x >> 16)), g2 = bf2f((bf16_t)(og.y & 0xFFFF)), g3 = bf2f((bf16_t)(og.y >> 16));
        U2 w; w.x = pack2(o[nt][0] * r * g4[0] * siluf_(g0), o[nt][1] * r * g4[1] * siluf_(g1)); w.y = pack2(o[nt][2] * r * g4[2] * siluf_(g2), o[nt][3] * r * g4[3] * siluf_(g3));
        *(U2*)(oc + v0) = w; }
}

struct ProbMerge {
    static constexpr bool PERM = true, GATHER = false;
    const char* A; const char* Bt; const bf16_t* Z; bf16_t* Y; int G, c, lat_only;
    DEV int row0(const g8::Unit& u) const { return lat_only ? lat_unit_row0(u.pm) : u.pm * 256; }
    DEV bool next(int i, g8::Unit& u) const { const int it = i >> 2, L = it * G + c; const int nM = lat_only ? BATCH * (SEQ / 256) : MTOT / 256;
        if (L >= nM * (D / 256)) return false; g8::order_map(L, nM, D / 256, u.pm, u.pn); u.aux = i & 3; u.idx = i; return true; }
    DEV int koff(const g8::Unit& u) const { return u.aux * 256; }
    DEV const char* a_base(const g8::Unit& u) const { return A + ((size_t)row0(u) * 1024 + koff(u)) * 2; }
    DEV const char* b_base(const g8::Unit& u) const { return Bt + ((size_t)u.pn * 256 * 1024 + koff(u)) * 2; }
    DEV int nt(const g8::Unit&) const { return 4; }
    DEV void prologue(LDSP unsigned char*) const {}
    DEV unsigned a_voff(LDSP unsigned char*, const g8::Unit&, int h, int R, int C) const { return (unsigned)((h * 128 + R) * 1024 + C) * 2u; }
    DEV unsigned ldb() const { return 1024 * 2; }
    DEV bool keep_acc(const g8::Unit& u) const { return u.aux < 3; }
    DEV void epi(g8::Acc& acc, const g8::Unit& u, int wr, int wc, int fr, int fq) const {
        if (u.aux == 2) return;
        const int r0 = row0(u) + wr * 64 + fr, c0 = u.pn * 256 + wc * 32 + fq * 8;
        const bf16_t* zb = Z + (size_t)r0 * ZS + ZMA + c0;
        if (u.aux < 2) {
            const bf16_t* zs = zb + u.aux * D;
#pragma unroll
            for (int ai = 0; ai < 2; ++ai) {
                U4 g0[4][2], g1[4][2];
#pragma unroll
                for (int m = 0; m < 4; ++m)
#pragma unroll
                    for (int bj = 0; bj < 2; ++bj) { const bf16_t* zp = zs + (size_t)(ai * 128 + m * 16) * ZS + bj * 128; g0[m][bj] = *(const U4*)zp; g1[m][bj] = *(const U4*)(zp + D); }
                G8_SCHED;
#pragma unroll
                for (int m = 0; m < 4; ++m)
#pragma unroll
                    for (int bj = 0; bj < 2; ++bj)
#pragma unroll
                        for (int q = 0; q < 4; ++q) { const float a0 = bf2f((bf16_t)(g0[m][bj][q] & 0xFFFF)), a1 = bf2f((bf16_t)(g0[m][bj][q] >> 16)), b0 = bf2f((bf16_t)(g1[m][bj][q] & 0xFFFF)), b1 = bf2f((bf16_t)(g1[m][bj][q] >> 16));
                            acc[ai][bj][m][q >> 1][(q & 1) * 2] *= (1.f + b0) * fast_rcp(1.f + a0); acc[ai][bj][m][q >> 1][(q & 1) * 2 + 1] *= (1.f + b1) * fast_rcp(1.f + a1); }
            }
        } else {
            const bf16_t* zs = zb + 2 * D;
#pragma unroll
            for (int ai = 0; ai < 2; ++ai) {
                U4 g0[4][2];
#pragma unroll
                for (int m = 0; m < 4; ++m)
#pragma unroll
                    for (int bj = 0; bj < 2; ++bj) g0[m][bj] = *(const U4*)(zs + (size_t)(ai * 128 + m * 16) * ZS + bj * 128);
                G8_SCHED;
#pragma unroll
                for (int m = 0; m < 4; ++m)
#pragma unroll
                    for (int bj = 0; bj < 2; ++bj) { float o[8];
#pragma unroll
                        for (int q = 0; q < 4; ++q) { o[2 * q] = acc[ai][bj][m][q >> 1][(q & 1) * 2] * fast_rcp(1.f + bf2f((bf16_t)(g0[m][bj][q] & 0xFFFF))); o[2 * q + 1] = acc[ai][bj][m][q >> 1][(q & 1) * 2 + 1] * fast_rcp(1.f + bf2f((bf16_t)(g0[m][bj][q] >> 16))); }
                        U4 w; w.x = cvt_pk_bf16(o[0], o[1]); w.y = cvt_pk_bf16(o[2], o[3]); w.z = cvt_pk_bf16(o[4], o[5]); w.w = cvt_pk_bf16(o[6], o[7]);
                        *(U4*)(Y + (size_t)(r0 + ai * 128 + m * 16) * D + c0 + bj * 128) = w; }
            }
        }
    }
};
struct ProbWout {
    static constexpr bool PERM = false, GATHER = false;
    const char* A; const char* Bt; Ctx cx; int G, c, lat_only;
    DEV int row0(const g8::Unit& u) const { return lat_only ? lat_unit_row0(u.pm) : u.pm * 256; }
    DEV bool next(int i, g8::Unit& u) const { const int L = i * G + c; const int nM = lat_only ? BATCH * (SEQ / 256) : MTOT / 256;
        if (L >= nM * (D / 256)) return false; g8::order_map(L, nM, D / 256, u.pm, u.pn); u.aux = 0; u.idx = i; return true; }
    DEV const char* a_base(const g8::Unit& u) const { return A + (size_t)row0(u) * D * 2; }
    DEV const char* b_base(const g8::Unit& u) const { return Bt + (size_t)u.pn * 256 * D * 2; }
    DEV int nt(const g8::Unit&) const { return D / 64; }
    DEV void prologue(LDSP unsigned char*) const {}
    DEV unsigned a_voff(LDSP unsigned char*, const g8::Unit&, int h, int R, int C) const { return (unsigned)((h * 128 + R) * D + C) * 2u; }
    DEV unsigned ldb() const { return D * 2; }
    DEV bool keep_acc(const g8::Unit&) const { return false; }
    DEV void epi(g8::Acc& acc, const g8::Unit& u, int wr, int wc, int fr, int fq) const {
        const int rbase = row0(u), b = rbase / NTOK, pb = rbase % NTOK;
        const float* gate = cx.mod(cx.layer, pb < CTX_LEN ? BATCH : b) + 2 * D + u.pn * 256 + wc * 32 + fq * 4;
        f32x4 gv[2][2];
#pragma unroll
        for (int bj = 0; bj < 2; ++bj)
#pragma unroll
            for (int n = 0; n < 2; ++n) gv[bj][n] = *(const f32x4*)(gate + bj * 128 + n * 16);
#pragma unroll
        for (int ai = 0; ai < 2; ++ai) {
            f32x4 xv[4][2][2]; const int cof = u.pn * 256 + wc * 32 + fq * 4;
#pragma unroll
            for (int m = 0; m < 4; ++m) { const float* xs = xrow_src(cx, rbase + ai * 128 + wr * 64 + m * 16 + fr) + cof;
#pragma unroll
                for (int bj = 0; bj < 2; ++bj)
#pragma unroll
                    for (int n = 0; n < 2; ++n) xv[m][bj][n] = *(const f32x4*)(xs + bj * 128 + n * 16); }
            G8_SCHED;
#pragma unroll
            for (int m = 0; m < 4; ++m) { float* xd = xrow_dst(cx, rbase + ai * 128 + wr * 64 + m * 16 + fr) + cof;
#pragma unroll
                for (int bj = 0; bj < 2; ++bj)
#pragma unroll
                    for (int n = 0; n < 2; ++n) *(f32x4*)(xd + bj * 128 + n * 16) = xv[m][bj][n] + gv[bj][n] * acc[ai][bj][m][n]; }
        }
    }
};
DEV void p8_load_router(const Ctx& c) {
    float* w = (float*)c.smem; const float* src = c.in(I_ROUTER) + (size_t)c.layer * D * NE;
    __syncthreads();
    for (int i = ltid() * 4; i < D * NE; i += NTHR * 4) { const int k = i / NE, e4 = (i % NE) >> 2; *(f32x4*)(w + ((size_t)(e4 * 4 + (k & 3)) * (D / 4) + (k >> 2)) * 4) = *(const f32x4*)(src + i); }
    __syncthreads();
}
DEV void p8_norm2_row(const Ctx& c, int grow) {
    const int lane = ltid() & 63, l = c.layer;
    const int b = grow / NTOK, p = grow % NTOK;
    const float* x = xrow_dst(c, grow);
    const float* md = c.mod(l, p < CTX_LEN ? BATCH : b);
    const float* g = c.in(I_NORM2) + l * D;
    const float* wr = (const float*)c.smem;
    static_assert(NE == 16 || NE == 4, "router butterfly");
    f32x4 xv[NV], gv[NV], scv[NV], shv[NV]; float ss = 0.f;
#pragma unroll
    for (int i = 0; i < NV; ++i) xv[i] = *(const f32x4*)(x + lane * 4 + i * 256);
#pragma unroll
    for (int i = 0; i < NV; ++i) { const int cc = lane * 4 + i * 256; gv[i] = *(const f32x4*)(g + cc); scv[i] = *(const f32x4*)(md + 4 * D + cc); shv[i] = *(const f32x4*)(md + 3 * D + cc); }
#pragma unroll
    for (int i = 0; i < NV; ++i) { ss += xv[i][0] * xv[i][0] + xv[i][1] * xv[i][1] + xv[i][2] * xv[i][2] + xv[i][3] * xv[i][3]; }
    ss = wave_sum(ss);
    const float r = rsqrtf(ss / D + EPS);
    bf16_t* h = (bf16_t*)(c.ws() + WS_OCAT) + (size_t)grow * D;
    float lg[NE];
#pragma unroll
    for (int e = 0; e < NE; ++e) lg[e] = 0.f;
#pragma unroll
    for (int i = 0; i < NV; ++i) { const int cc = lane * 4 + i * 256; float o[4];
        const f32x4 gg = gv[i], sc = scv[i], sh = shv[i];
#pragma unroll
        for (int k = 0; k < 4; ++k) { o[k] = xv[i][k] * r * gg[k] * (1.f + sc[k]) + sh[k];
#pragma unroll
            for (int e4 = 0; e4 < NE / 4; ++e4) { const f32x4 w4 = *(const f32x4*)(wr + ((size_t)(e4 * 4 + k) * (D / 4) + (cc >> 2)) * 4);
#pragma unroll
                for (int q = 0; q < 4; ++q) lg[e4 * 4 + q] += o[k] * w4[q]; } }
        U2 pk; pk.x = pack2(o[0], o[1]); pk.y = pack2(o[2], o[3]); *(U2*)(h + cc) = pk; }
    float v8[8], v4[4], v2[2], v1;
    if (NE == 16) {
#pragma unroll
        for (int q = 0; q < 8; ++q) { const bool hi = (lane & 32) != 0; const float keep = hi ? lg[q + 8] : lg[q], give = hi ? lg[q] : lg[q + 8]; v8[q] = keep + __shfl_xor(give, 32); }
#pragma unroll
        for (int q = 0; q < 4; ++q) { const bool hi = (lane & 16) != 0; const float keep = hi ? v8[q + 4] : v8[q], give = hi ? v8[q] : v8[q + 4]; v4[q] = keep + __shfl_xor(give, 16); }
    } else {
#pragma unroll
        for (int q = 0; q < 4; ++q) { float t = lg[q % NE]; t += __shfl_xor(t, 32); t += __shfl_xor(t, 16); v4[q] = t; }
    }
#pragma unroll
    for (int q = 0; q < 2; ++q) { const bool hi = (lane & 8) != 0; const float keep = hi ? v4[q + 2] : v4[q], give = hi ? v4[q] : v4[q + 2]; v2[q] = keep + __shfl_xor(give, 8); }
    { const bool hi = (lane & 4) != 0; const float keep = hi ? v2[1] : v2[0], give = hi ? v2[0] : v2[1]; v1 = keep + __shfl_xor(give, 4); }
    v1 += __shfl_xor(v1, 2); v1 += __shfl_xor(v1, 1);
    const int eh = (NE == 16) ? (((lane >> 5) & 1) * 8 + ((lane >> 4) & 1) * 4 + ((lane >> 3) & 1) * 2 + ((lane >> 2) & 1)) : (((lane >> 3) & 1) * 2 + ((lane >> 2) & 1));
    float mx = v1;
    mx = fmaxf(mx, __shfl_xor(mx, 4)); mx = fmaxf(mx, __shfl_xor(mx, 8));
    if (NE == 16) { mx = fmaxf(mx, __shfl_xor(mx, 16)); mx = fmaxf(mx, __shfl_xor(mx, 32)); }
    const float ex = expf(v1 - mx);
    float sum = ex; sum += __shfl_xor(sum, 4); sum += __shfl_xor(sum, 8);
    if (NE == 16) { sum += __shfl_xor(sum, 16); sum += __shfl_xor(sum, 32); }
    const bool writer = (lane & 3) == 0 && (NE == 16 || lane < 16);
    if (writer) { ((float*)(c.ws() + WS_AFF))[(size_t)grow * NE + eh] = ex / sum; ((int*)(c.ws() + WS_INV))[(size_t)grow * NE + eh] = -1; }
}
DEV void p9_topk_item(const Ctx& c, int set, int b, int e) {
    unsigned* key = (unsigned*)c.smem;
    unsigned* hist = key + 2048;
    unsigned* misc = hist + 256;
    const int tid = ltid(), lane = tid & 63, wv = tid >> 6;
    const int n = set == 0 ? SEQ : CTX_LEN, cap = set == 0 ? CAPL : CAPC, p0 = set == 0 ? CTX_LEN : 0;
    static_assert(SEQ <= 2048 && CTX_LEN <= 2048, "topk buffer");
    const float* aff = (const float*)(c.ws() + WS_AFF) + ((size_t)b * NTOK + p0) * NE + e;
    __syncthreads();
    for (int i = tid; i < 2048; i += NTHR) key[i] = (i < n) ? __builtin_bit_cast(unsigned, aff[(size_t)i * NE]) : 0u;
    if (tid == 0) { misc[0] = 0u; misc[1] = (unsigned)cap; }
    __syncthreads();
    unsigned kk[4];
#pragma unroll
    for (int q = 0; q < 4; ++q) kk[q] = key[tid * 4 + q];
#pragma unroll 1
    for (int pass = 0; pass < 4; ++pass) {
        const int shift = 24 - 8 * pass; const unsigned mask = pass == 0 ? 0u : (0xFFFFFFFFu << (shift + 8));
        if (tid < 256) hist[tid] = 0u;
        __syncthreads();
        const unsigned prefix = misc[0];
#pragma unroll
        for (int q = 0; q < 4; ++q) if (tid * 4 + q < n && (kk[q] & mask) == prefix) atomicAdd(&hist[(kk[q] >> shift) & 255u], 1u);
        __syncthreads();
        if (tid < 64) {
            const unsigned rem = misc[1];
            const unsigned h0 = hist[tid * 4], h1 = hist[tid * 4 + 1], h2 = hist[tid * 4 + 2], h3 = hist[tid * 4 + 3];
            const unsigned own = h0 + h1 + h2 + h3; unsigned suf = own;
#pragma unroll
            for (int dd = 1; dd < 64; dd <<= 1) { const unsigned o2 = __shfl_down(suf, dd); if (lane + dd < 64) suf += o2; }
            const unsigned ab3 = suf - own, ab2 = ab3 + h3, ab1 = ab2 + h2, ab0 = ab1 + h1;
            int bsel = -1; unsigned above = 0u;
            if (ab3 < rem && ab3 + h3 >= rem) { bsel = tid * 4 + 3; above = ab3; }
            else if (ab2 < rem && ab2 + h2 >= rem) { bsel = tid * 4 + 2; above = ab2; }
            else if (ab1 < rem && ab1 + h1 >= rem) { bsel = tid * 4 + 1; above = ab1; }
            else if (ab0 < rem && ab0 + h0 >= rem) { bsel = tid * 4; above = ab0; }
            if (bsel >= 0) { misc[0] = prefix | ((unsigned)bsel << shift); misc[1] = rem - above; }
        }
        __syncthreads();
    }
    const unsigned T = misc[0], need_eq = misc[1];
    unsigned cg = 0, ce = 0;
#pragma unroll
    for (int q = 0; q < 4; ++q) { const bool v = tid * 4 + q < n; cg += (v && kk[q] > T) ? 1u : 0u; ce += (v && kk[q] == T) ? 1u : 0u; }
    unsigned sg = cg, se = ce;
#pragma unroll
    for (int d = 1; d < 64; d <<= 1) { const unsigned a = __shfl_up(sg, d), bq = __shfl_up(se, d); if (lane >= d) { sg += a; se += bq; } }
    if (lane == 63) { misc[8 + wv] = sg; misc[16 + wv] = se; }
    __syncthreads();
    unsigned og = 0, oe = 0;
    for (int w = 0; w < wv; ++w) { og += misc[8 + w]; oe += misc[16 + w]; }
    unsigned pg = og + sg - cg, pe = oe + se - ce;
    int* rmap = (int*)(c.ws() + WS_RMAP) + (size_t)e * RPE + (set == 0 ? b * CAPL : RPE_L + b * CAPC);
    float* slw = (float*)(c.ws() + WS_SLW) + (size_t)e * RPE + (set == 0 ? b * CAPL : RPE_L + b * CAPC);
    int* inv = (int*)(c.ws() + WS_INV);
#pragma unroll
    for (int q = 0; q < 4; ++q) { const int i = tid * 4 + q; if (i < n) {
        const bool gt = kk[q] > T, eq = kk[q] == T; const bool sel = gt || (eq && pe < need_eq);
        if (sel) { const int slot = (int)(pg + (pe < need_eq ? pe : need_eq)); const int tok = b * NTOK + p0 + i;
            rmap[slot] = tok; slw[slot] = __builtin_bit_cast(float, kk[q]); inv[(size_t)tok * NE + e] = e * RPE + (set == 0 ? b * CAPL : RPE_L + b * CAPC) + slot; }
        pg += gt ? 1u : 0u; pe += eq ? 1u : 0u; } }
}
struct ProbMoe1 {
    static constexpr bool PERM = true, GATHER = true;
    static constexpr int MAXU = 12;
    const char* A; const char* Bt; const int* rmap; bf16_t* hid; int G, c, nMe;
    DEV bool next(int i, g8::Unit& u) const { const int L = i * G + c; if (L >= NE * nMe * (2 * FF / 256)) return false; int pmt; g8::order_map(L, NE * nMe, 2 * FF / 256, pmt, u.pn); u.aux = pmt / nMe; u.pm = pmt % nMe; u.idx = i; return true; }
    DEV const char* a_base(const g8::Unit&) const { return A; }
    DEV const char* b_base(const g8::Unit& u) const { return Bt + ((size_t)u.aux * 2 * FF + u.pn * 256) * D * 2; }
    DEV int nt(const g8::Unit&) const { return D / 64; }
    DEV void prologue(LDSP unsigned char* lds) const {
        LDSP unsigned* tab = (LDSP unsigned*)(lds + g8::STAGE_BYTES); g8::Unit u;
        for (int i = 0; i < MAXU && next(i, u); ++i) for (int t = ltid(); t < 256; t += NTHR) tab[i * 256 + t] = (unsigned)rmap[(size_t)u.aux * RPE + u.pm * 256 + t] * (unsigned)(D * 2);
        __syncthreads();
    }
    DEV unsigned a_voff(LDSP unsigned char* lds, const g8::Unit& u, int h, int R, int C) const { return ((const LDSP unsigned*)(lds + g8::STAGE_BYTES))[u.idx * 256 + h * 128 + R] + (unsigned)C * 2u; }
    DEV unsigned ldb() const { return D * 2; }
    DEV bool keep_acc(const g8::Unit&) const { return false; }
    DEV void epi(g8::Acc& acc, const g8::Unit& u, int wr, int wc, int fr, int fq) const {
        bf16_t* base = hid + ((size_t)u.aux * RPE + u.pm * 256 + wr * 64 + fr) * FF + (u.pn * 256 + wc * 32 + fq * 8) / 2;
#pragma unroll
        for (int ai = 0; ai < 2; ++ai)
#pragma unroll
            for (int m = 0; m < 4; ++m)
#pragma unroll
                for (int bj = 0; bj < 2; ++bj) { const f32x4 g = acc[ai][bj][m][0], uu = acc[ai][bj][m][1]; U2 w;
                    w.x = cvt_pk_bf16(siluf_(g[0]) * uu[0], siluf_(g[1]) * uu[1]); w.y = cvt_pk_bf16(siluf_(g[2]) * uu[2], siluf_(g[3]) * uu[3]);
                    *(U2*)(base + (size_t)(ai * 128 + m * 16) * FF + bj * 64) = w; }
    }
};
struct ProbMoe2 {
    static constexpr bool PERM = true, GATHER = false;
    const char* A; const char* Bt; const float* slw; bf16_t* ye; int G, c, nMe;
    DEV bool next(int i, g8::Unit& u) const { const int L = i * G + c; if (L >= NE * nMe * (D / 256)) return false; int pmt; g8::order_map(L, NE * nMe, D / 256, pmt, u.pn); u.aux = pmt / nMe; u.pm = pmt % nMe; u.idx = i; return true; }
    DEV const char* a_base(const g8::Unit& u) const { return A + ((size_t)u.aux * RPE + u.pm * 256) * FF * 2; }
    DEV const char* b_base(const g8::Unit& u) const { return Bt + ((size_t)u.aux * D + u.pn * 256) * FF * 2; }
    DEV int nt(const g8::Unit&) const { return FF / 64; }
    DEV void prologue(LDSP unsigned char*) const {}
    DEV unsigned a_voff(LDSP unsigned char*, const g8::Unit&, int h, int R, int C) const { return (unsigned)((h * 128 + R) * FF + C) * 2u; }
    DEV unsigned ldb() const { return FF * 2; }
    DEV bool keep_acc(const g8::Unit&) const { return false; }
    DEV void epi(g8::Acc& acc, const g8::Unit& u, int wr, int wc, int fr, int fq) const {
        const size_t r0 = (size_t)u.aux * RPE + u.pm * 256 + wr * 64 + fr;
        bf16_t* base = ye + r0 * D + u.pn * 256 + wc * 32 + fq * 8;
        float wv[2][4];
#pragma unroll
        for (int ai = 0; ai < 2; ++ai)
#pragma unroll
            for (int m = 0; m < 4; ++m) wv[ai][m] = slw[r0 + ai * 128 + m * 16];
        G8_SCHED;
#pragma unroll
        for (int ai = 0; ai < 2; ++ai)
#pragma unroll
            for (int m = 0; m < 4; ++m) { const float w8 = wv[ai][m];
#pragma unroll
                for (int bj = 0; bj < 2; ++bj) { U4 w; w.x = cvt_pk_bf16(acc[ai][bj][m][0][0] * w8, acc[ai][bj][m][0][1] * w8); w.y = cvt_pk_bf16(acc[ai][bj][m][0][2] * w8, acc[ai][bj][m][0][3] * w8);
                    w.z = cvt_pk_bf16(acc[ai][bj][m][1][0] * w8, acc[ai][bj][m][1][1] * w8); w.w = cvt_pk_bf16(acc[ai][bj][m][1][2] * w8, acc[ai][bj][m][1][3] * w8);
                    *(U4*)(base + (size_t)(ai * 128 + m * 16) * D + bj * 128) = w; } }
    }
};
DEV void pf_final_row(const Ctx& c, int lrow) {
    const int lane = ltid() & 63;
    float* x = c.out() + (size_t)lrow * D; const float* g = c.in(I_FNORM);
    const int grow = (lrow / SEQ) * NTOK + CTX_LEN + lrow % SEQ;
    f32x4 xv[NV];
#pragma unroll
    for (int i = 0; i < NV; ++i) xv[i] = *(const f32x4*)(x + lane * 4 + i * 256);
    f32x4 gv[NV];
#pragma unroll
    for (int i = 0; i < NV; ++i) gv[i] = *(const f32x4*)(g + lane * 4 + i * 256);
    moe_combine_regs(c, grow, DEPTH - 1, xv);
    float ss = 0.f;
#pragma unroll
    for (int i = 0; i < NV; ++i) ss += xv[i][0] * xv[i][0] + xv[i][1] * xv[i][1] + xv[i][2] * xv[i][2] + xv[i][3] * xv[i][3];
    ss = wave_sum(ss);
    const float r = rsqrtf(ss / D + EPS);
#pragma unroll
    for (int i = 0; i < NV; ++i) NT_STORE4(x + lane * 4 + i * 256, xv[i] * r * gv[i]);
}

constexpr int PH_PER_LAYER = 11, N_PHASES = 1 + DEPTH * PH_PER_LAYER + 1;
__global__ void __launch_bounds__(NTHR) mk_forward(Params prm) {
#ifdef EMU
    char* smem = emu_lds();
#else
    extern __shared__ __attribute__((aligned(16))) char smem[];
#endif
    Ctx c; c.smem = smem; c.layer = 0;
    const int bid = blockIdx.x, G = gridDim.x, tid = threadIdx.x;
#define wave (ltid() >> 6)
    const int lo = prm.ph_lo, hi = prm.ph_hi;
#ifdef EMU
    emu_params = prm;
#endif
#ifdef EMU
#define GRID_BAR() emu_grid_sync()
#else
    XcdBarrier bar; bar.bar = (unsigned*)(prm.ws + WS_BAR); bar.x = 0; bar.st = nullptr;
    if (hi - lo > 1) {
        if (tid < 4) ((volatile LAS unsigned*)(smem + LDS_MISC))[tid] = 0u;
        __syncthreads();
        bar = xcd_barrier_post((unsigned*)(prm.ws + WS_BAR), (volatile LAS unsigned*)(smem + LDS_MISC));
    }
#define GRID_BAR() xcd_barrier(bar)
#endif
#ifdef PH_ONLY
#define PHSEL(j) ((j) == PH_ONLY)
#elif defined(PH_SKIP)
#define PHSEL(j) ((j) != PH_SKIP)
#else
#define PHSEL(j) true
#endif
#ifndef PROBE_PHASE
#define PROBE_PHASE -1
#endif
#ifndef PROBE_REPS
#define PROBE_REPS 1
#endif
#ifndef PROBE_L0
#define PROBE_L0 0
#endif
#define REPS(j) for (int rep_ = 0; rep_ < (((j) == PROBE_PHASE && (!PROBE_L0 || c.layer == 0)) ? PROBE_REPS : 1); ++rep_)
#ifndef PROBE_SUB
#define PROBE_SUB -1
#endif
#define SUBREP(id) for (int srep_ = 0; srep_ < (((id) == PROBE_SUB && (!PROBE_L0 || c.layer == 0)) ? PROBE_REPS : 1); ++srep_)
#define IN(k) (lo <= (k) && (k) < hi)
#ifndef PROBE_BAR
#define PROBE_BAR 0
#endif
#define SEAM(k) do { if (IN(k) && IN((k) + 1)) { GRID_BAR(); for (int pb_ = 0; pb_ < PROBE_BAR; ++pb_) GRID_BAR(); } } while (0)
#define pl ((bf16_t*)(smem + wave * (16 * GS * 2)))

    if (PHSEL(100) && IN(0)) REPS(100) {
        const int n_mod = DEPTH * (D6 / 64), n_cw = DEPTH * CW_PER_LAYER;
        for (int it = bid; it < n_mod + n_cw + DEPTH; it += G) { if (it < n_mod) p0_mod_item(c, it); else if (it < n_mod + n_cw) p0_convw_item(c, it - n_mod); else p0_gatew_item(c, it - n_mod - n_cw); }
        { PrepJobFn f; f.c = &c; const int nmodb = n_mod < G ? n_mod : 0;
          conv_range(c, f, 0, DEPTH * PJ_PER_L, bid >= nmodb ? bid - nmodb : G - nmodb + bid, G); }
    }
    SEAM(0);
    for (int l = 0; l < DEPTH; ++l) {
        c.layer = l;
        const int P = 1 + l * PH_PER_LAYER;
        const bool ctxo = (l < DEPTH - 1);
        const int mt_n = ctxo ? MT_ALL : MT_LAT;
        if (PHSEL(0) && IN(P + 0)) REPS(0) { for (int it = bid; it < MTOT / 8; it += G) p1_norm_row(c, it * 8 + wave); }
        SEAM(P + 0);
        if (PHSEL(1) && IN(P + 1)) REPS(1) { ProbInproj pr; pr.A = c.ws() + WS_H; pr.Bt = c.ws() + WS_WIN + (size_t)l * NIN * D * 2; pr.Z = (bf16_t*)(c.ws() + WS_Z); pr.navt = (bf16_t*)(c.ws() + WS_NAVT); pr.gvt = (bf16_t*)(c.ws() + WS_GVT); pr.G = G; pr.c = bid; pr.lastl = ctxo ? 0 : 1;
            g8::gemm_phase((LDSP unsigned char*)smem, pr); }
        SEAM(P + 1);
        if (PHSEL(2) && IN(P + 2)) REPS(2) {
            const int n_q = mt_n * 3, n_kv = MT_ALL * 4, n_g1 = G1_ITEMS, n_na = NA_LAT_ITEMS + (ctxo ? NA_CTX_ITEMS : 0), n_kr = MTOT / 16;
            const int tot = n_g1 + n_q + n_kv + n_na + n_kr;
            int it = bid;
            for (; it < n_na; it += G) { SUBREP(23) p3_na_item(c, it); }
            if (it < n_na + n_g1) { SUBREP(20) p3_gla_g1_range(c, it - n_na, n_g1, G); it += ((n_na + n_g1 - 1 - it) / G + 1) * G; }
            { const int e = n_na + n_g1 + n_q; if (it < e) { SUBREP(21) p3_up_range<true>(c, it - (e - n_q), n_q, G, ctxo); it += ((e - 1 - it) / G + 1) * G; } }
            { const int e = n_na + n_g1 + n_q + n_kv; if (it < e) { SUBREP(22) p3_up_range<false>(c, it - (e - n_kv), n_kv, G, ctxo); it += ((e - 1 - it) / G + 1) * G; } }
            for (; it < tot; it += G) p3_krope_item(c, it - (n_na + n_g1 + n_q + n_kv));
        }
        SEAM(P + 2);
        if (PHSEL(3) && IN(P + 3)) REPS(3) {
            const int n_g2 = G2_ITEMS, n_att = MLA_LAT_ITEMS + (ctxo ? MLA_CTX_ITEMS : 0);
            for (int it = bid; it < n_g2 + n_att; it += G) {
                if (it < n_g2) { SUBREP(30) p4_gla_g2_item(c, it); continue; }
                SUBREP(31) p4_mla_item(c, it - n_g2);
            }
        }
        SEAM(P + 3);
        if (PHSEL(4) && IN(P + 4)) REPS(4) {
            const int chs = ctxo ? NCH : (NCH - NCC);
            const int n3 = BATCH * 4 * chs, ch0 = ctxo ? 0 : NCC;
            if (bid < n3) {
                int it = bid;
                G3Pre cur = g3_prefetch(c, it / chs / 4, (it / chs) & 3, (it % chs) + ch0);
                for (;;) {
                    const int itn = it + G; const bool more = itn < n3; const int ix = more ? itn : it;
                    G3Pre nxt; p5_gla_g3_body(c, it / chs / 4, (it / chs) & 3, (it % chs) + ch0, cur, ix / chs / 4, (ix / chs) & 3, (ix % chs) + ch0, nxt);
                    if (!more) break;
                    SCHED_FENCE();
                    cur = nxt; it = itn;
                }
            }
        }
        SEAM(P + 4);
        if (PHSEL(5) && IN(P + 5)) REPS(5) {
            { ProbMerge pr; pr.A = c.ws() + WS_OCAT; pr.Bt = c.ws() + WS_WBR + (size_t)l * D * 1024 * 2; pr.Z = (const bf16_t*)(c.ws() + WS_Z); pr.Y = (bf16_t*)(c.ws() + WS_H); pr.G = G; pr.c = bid; pr.lat_only = ctxo ? 0 : 1;
              SUBREP(50) g8::gemm_phase((LDSP unsigned char*)smem, pr); }
            { const int nu = (ctxo ? MTOT / 256 : BATCH * (SEQ / 256)) * (D / 256), dbl = nu % G;
              if (bid >= dbl) SUBREP(51) convexp_range(c, l, 0, CE_ITEMS / 2, bid - dbl, G - dbl); }
        }
        SEAM(P + 5);
        if (PHSEL(6) && IN(P + 6)) REPS(6) { ProbWout pr; pr.A = c.ws() + WS_H; pr.Bt = c.ws() + WS_WOUT + (size_t)l * D * D * 2; pr.cx = c; pr.G = G; pr.c = bid; pr.lat_only = ctxo ? 0 : 1;
            SUBREP(52) g8::gemm_phase((LDSP unsigned char*)smem, pr);
            { const int nu = (ctxo ? MTOT / 256 : BATCH * (SEQ / 256)) * (D / 256), dbl = nu % G;
              if (bid >= dbl) SUBREP(53) convexp_range(c, l, CE_ITEMS / 2, CE_ITEMS, bid - dbl, G - dbl); } }
        SEAM(P + 6);
        if (PHSEL(7) && IN(P + 7)) REPS(7) {
            p8_load_router(c);
            if (ctxo) { for (int it = bid; it < MTOT / 8; it += G) p8_norm2_row(c, it * 8 + wave); }
            else { for (int it = bid; it < BATCH * SEQ / 8; it += G) { const int lr = it * 8 + wave; p8_norm2_row(c, (lr / SEQ) * NTOK + CTX_LEN + lr % SEQ); } }
        }
        SEAM(P + 7);
        if (PHSEL(8) && IN(P + 8)) REPS(8) { const int tot = BATCH * NE * (ctxo ? 2 : 1); for (int it = bid; it < tot; it += G) { const int set = it / (BATCH * NE), r = it % (BATCH * NE); p9_topk_item(c, set, r / NE, r % NE); } }
        SEAM(P + 8);
        const int mt_e = (ctxo ? RPE : RPE_L) / 256;
        if (PHSEL(9) && IN(P + 9)) REPS(9) { ProbMoe1 pr; pr.A = c.ws() + WS_OCAT; pr.Bt = c.ws() + WS_EXP + EXP_WGU; pr.rmap = (const int*)(c.ws() + WS_RMAP); pr.hid = (bf16_t*)(c.ws() + WS_Z); pr.G = G; pr.c = bid; pr.nMe = mt_e;
            g8::gemm_phase((LDSP unsigned char*)smem, pr); }
        SEAM(P + 9);
        if (PHSEL(10) && IN(P + 10)) REPS(10) { ProbMoe2 pr; pr.A = c.ws() + WS_Z; pr.Bt = c.ws() + WS_EXP + EXP_WD; pr.slw = (const float*)(c.ws() + WS_SLW); pr.ye = (bf16_t*)(c.ws() + WS_YE); pr.G = G; pr.c = bid; pr.nMe = mt_e;
            g8::gemm_phase((LDSP unsigned char*)smem, pr); }
        SEAM(P + 10);
    }
    if (PHSEL(101) && IN(N_PHASES - 1)) { for (int it = bid; it < BATCH * SEQ / 8; it += G) pf_final_row(c, it * 8 + wave); }
#undef wave
#undef pl
}

#ifdef EMU
static void emu_dump_map(FILE* f) {
    fprintf(f, "MOD %zu\nCCUR %zu\nH %zu\nZ %zu\nWIN %zu\nWUQ %zu\nWUKV %zu\nWBR %zu\nWOUT %zu\nEXP %zu\nMQ %zu\nMK %zu\nMVT %zu\nNAVT %zu\nGVT %zu\nOCAT %zu\nAFF %zu\nRMAP %zu\nSLW %zu\nTOTAL %zu\n",
            WS_MOD, WS_CCUR, WS_H, WS_Z, WS_WIN, WS_WUQ, WS_WUKV, WS_WBR, WS_WOUT, WS_EXP, WS_MQ, WS_MK, WS_MVT, WS_NAVT, WS_GVT, WS_OCAT, WS_AFF, WS_RMAP, WS_SLW, WS_TOTAL_BYTES);
    fprintf(f, "D_IN_PAD %d\nNTOK %d\nMTOT %d\nRPE %d\n", D_IN_PAD, NTOK, MTOT, RPE);
}
#endif

extern "C" void kernel_launch(void* const* d_in, const int* in_sizes, int n_in, void* d_out, int out_size, void* d_ws, size_t ws_size, hipStream_t stream) {
    Params p{};
    for (int i = 0; i < 28; ++i) p.in[i] = (const float*)d_in[i];
    p.out = (float*)d_out; p.ws = (char*)d_ws;
#ifdef EMU
    int emu_stop = N_PHASES; if (getenv("EMU_STOP")) emu_stop = atoi(getenv("EMU_STOP"));
    hipMemsetAsync((char*)d_ws + WS_BAR, 0, WS_BAR_BYTES, stream);
    if (getenv("EMU_ONE")) { p.ph_lo = 0; p.ph_hi = emu_stop; emu_launch(mk_forward, 3, NTHR, LDS_BYTES, p, true); }
    else for (int k = 0; k < emu_stop; ++k) { p.ph_lo = k; p.ph_hi = k + 1; emu_launch(mk_forward, 5, NTHR, LDS_BYTES, p, false); }
#else
    static int grid = 0;
    if (grid == 0) {
        if (n_in != 28 || out_size != BATCH * SEQ * D || ws_size < WS_TOTAL_BYTES) { fprintf(stderr, "kernel_launch: unexpected shapes (n_in %d out %d ws %zu need %zu)\n", n_in, out_size, ws_size, (size_t)WS_TOTAL_BYTES); grid = -1; return; }
        int dev = 0, cus = 0, per_cu = 0;
        hipGetDevice(&dev); hipDeviceGetAttribute(&cus, hipDeviceAttributeMultiprocessorCount, dev);
        hipFuncSetAttribute((const void*)mk_forward, hipFuncAttributeMaxDynamicSharedMemorySize, LDS_BYTES);
        hipOccupancyMaxActiveBlocksPerMultiprocessor(&per_cu, (const void*)mk_forward, NTHR, LDS_BYTES);
        if (per_cu < 1) { fprintf(stderr, "kernel_launch: occupancy query says %d blocks/CU\n", per_cu); grid = -1; return; }
        grid = cus;
    }
    if (grid < 0) return;
    hipMemsetAsync((char*)d_ws + WS_BAR, 0, WS_BAR_BYTES, stream);
#if MK_ONE_LAUNCH
    p.ph_lo = 0; p.ph_hi = N_PHASES;
    void* args[] = {&p};
    hipError_t e = hipLaunchCooperativeKernel((const void*)mk_forward, dim3(grid), dim3(NTHR), args, LDS_BYTES, stream);
    if (e != hipSuccess) fprintf(stderr, "cooperative launch failed: %s (grid %d)\n", hipGetErrorString(e), grid);
#else
    for (int k = 0; k < N_PHASES; ++k) { p.ph_lo = k; p.ph_hi = k + 1; hipLaunchKernelGGL(mk_forward, dim3(grid), dim3(NTHR), LDS_BYTES, stream, p); }
#endif
#endif
}
```

```cpp
#ifndef EMU
#include <hip/hip_runtime.h>
#include <hip/hip_cooperative_groups.h>
#include <cstdio>
#endif
#include <stdint.h>

#ifndef MK_ONE_LAUNCH
#define MK_ONE_LAUNCH 1
#endif

#ifdef EMU_SMALL
constexpr int D_MODEL = 256, BATCH = 2, SEQ = 1024, CTX_LEN = 256, N_EXPERTS = 4, EXPERT_FF = 256;
#else
constexpr int D_MODEL = 1024, BATCH = 8, SEQ = 2048, CTX_LEN = 256, N_EXPERTS = 16, EXPERT_FF = 1024;
#endif
constexpr int DEPTH = 2, GRID_W = 64, ROWS = SEQ / GRID_W;
constexpr int D = D_MODEL, D6 = 6 * D, FF = EXPERT_FF, NE = N_EXPERTS;
constexpr int NTOK = CTX_LEN + SEQ;
constexpr int MTOT = BATCH * NTOK;
constexpr int NCH = NTOK / 64, NCC = CTX_LEN / 64;
constexpr int ZKA = 0, ZGK = 256, ZDKV = 512, ZKR = 640, ZAF = 672, ZAB = 688, ZQA = 768, ZDQ = 1024, ZGQ = 1280, ZOG = 1536, ZMA = 2048;
constexpr int D_IN = 2752 + 3 * D;
constexpr int ZROW = ZMA + 3 * D;
constexpr int ZW = (ZROW + 255) / 256 * 256;
constexpr int ZS = (ZMA + (3 * D + 1) / 2 + 255) / 256 * 256;
constexpr int NIN = ZW + 768;
constexpr int D_IN_PAD = ZS;
constexpr int CAPL = 2 * SEQ / NE, CAPC = 2 * CTX_LEN / NE;
constexpr int RPE_L = BATCH * CAPL, RPE_C = BATCH * CAPC, RPE = RPE_L + RPE_C;
constexpr float EPS = 1e-6f;
constexpr int NTHR = 512;
static_assert(ROWS >= 8 && NTOK % 256 == 0 && CTX_LEN % 256 == 0 && SEQ % 256 == 0 && RPE_L % 256 == 0 && RPE_C % 256 == 0 && D % 256 == 0 && FF % 256 == 0, "shape");

constexpr size_t al256(size_t x) { return (x + 255) / 256 * 256; }
constexpr size_t WS_BAR = 0;
constexpr size_t WS_BAR_BYTES = 16384;
constexpr size_t WS_MOD = WS_BAR + WS_BAR_BYTES;
constexpr size_t WS_XB = WS_MOD + al256((size_t)DEPTH * (BATCH + 1) * D6 * 4);
constexpr size_t WS_H = WS_XB + al256((size_t)MTOT * D * 2);
constexpr size_t WS_Z = WS_H + al256((size_t)MTOT * D * 2);
constexpr size_t WS_Z_BYTES = al256((size_t)MTOT * D_IN_PAD * 2);
static_assert((size_t)NE * RPE * FF * 2 <= WS_Z_BYTES, "hid alias");
constexpr size_t WS_WIN = WS_Z + WS_Z_BYTES;
constexpr size_t WS_WUQ = WS_WIN + al256((size_t)DEPTH * NIN * D * 2);
constexpr size_t WS_WUKV = WS_WUQ + al256((size_t)DEPTH * 384 * 256 * 2);
constexpr size_t WS_WGT = WS_WUKV + al256((size_t)DEPTH * 512 * 128 * 2);
constexpr size_t WS_WBR = WS_WGT + al256((size_t)DEPTH * 2 * 2 * 256 * 16 * 2);
constexpr size_t WS_WOUT = WS_WBR + al256((size_t)DEPTH * D * 1024 * 2);
constexpr size_t WS_EXP = WS_WOUT + al256((size_t)DEPTH * D * D * 2);
constexpr size_t EXP_WGU = 0;
constexpr size_t EXP_WD = al256((size_t)NE * 2 * FF * D * 2);
constexpr size_t EXP_BYTES = EXP_WD + al256((size_t)NE * D * FF * 2);
constexpr size_t GLA_KV = 0;
constexpr size_t GLA_DEC = al256((size_t)BATCH * 4 * 2 * NCH * 64 * 128 * 4);
constexpr size_t GLA_SP = GLA_DEC + al256((size_t)BATCH * 4 * 2 * NCH * 64 * 4);
constexpr size_t GLA_BYTES = GLA_SP + al256((size_t)BATCH * 4 * 2 * NCH * 64 * 128 * 2);
constexpr size_t WS_EXP_BYTES = EXP_BYTES > GLA_BYTES ? EXP_BYTES : GLA_BYTES;
constexpr size_t WS_MQ = WS_EXP + WS_EXP_BYTES;
constexpr size_t WS_MK = WS_MQ + al256((size_t)BATCH * 4 * NTOK * 96 * 2);
constexpr size_t WS_MVT = WS_MK + al256((size_t)BATCH * 4 * NTOK * 96 * 2);
constexpr size_t WS_NAVT = WS_MVT + al256((size_t)BATCH * 4 * 64 * NTOK * 2);
constexpr size_t WS_GVT = WS_NAVT + al256((size_t)BATCH * 4 * 64 * NTOK * 2);
constexpr size_t WS_OCAT = WS_GVT + al256((size_t)BATCH * 4 * 128 * NTOK * 2);
constexpr size_t WS_AFF = WS_OCAT + al256((size_t)MTOT * 1024 * 2);
constexpr size_t WS_RMAP = WS_AFF + al256((size_t)MTOT * NE * 4);
constexpr size_t WS_SLW = WS_RMAP + al256((size_t)NE * RPE * 4);
constexpr size_t WS_INV = WS_SLW + al256((size_t)NE * RPE * 4);
constexpr size_t WS_TOTAL_BYTES = WS_INV + al256((size_t)MTOT * NE * 4);
constexpr size_t WS_YE = WS_MQ;
static_assert((size_t)NE * RPE * D * 2 <= WS_AFF - WS_MQ, "ye alias");

typedef unsigned short bf16_t;
typedef short bf16x8 __attribute__((ext_vector_type(8)));
typedef float f32x4 __attribute__((ext_vector_type(4)));
typedef uint32_t U4 __attribute__((ext_vector_type(4)));
typedef uint32_t U2 __attribute__((ext_vector_type(2)));
#define DEV __device__ __forceinline__
#ifdef EMU
DEV int ltid() { return (int)threadIdx.x; }
#else
DEV int ltid() { int t = (int)threadIdx.x; asm volatile("" : "+v"(t)); return t; }
#endif

#ifdef EMU
#define NT_LOAD4(p) (*(const f32x4*)(p))
#define NT_LOAD1(p) (*(const float*)(p))
#define NT_STORE4(p, v) (*(f32x4*)(p) = (v))
#else
#define NT_LOAD4(p) __builtin_nontemporal_load((const f32x4*)(p))
#define NT_LOAD1(p) __builtin_nontemporal_load((const float*)(p))
#define NT_STORE4(p, v) __builtin_nontemporal_store((v), (f32x4*)(p))
#endif
#ifdef EMU
DEV uint32_t pk_u8(uint32_t old, float v, int byte) { float r = nearbyintf(v); r = r < 0.f ? 0.f : (r > 255.f ? 255.f : r); return (old & ~(0xFFu << (8 * byte))) | ((uint32_t)r << (8 * byte)); }
DEV float u8f(uint32_t w, int byte) { return (float)((w >> (8 * byte)) & 0xFFu); }
#else
DEV uint32_t pk_u8(uint32_t old, float v, int byte) { return __builtin_amdgcn_cvt_pk_u8_f32(v, (uint32_t)byte, old); }
DEV float u8f(uint32_t w, int byte) { return (float)((w >> (8 * byte)) & 0xFFu); }
#endif
DEV float bf2f(bf16_t h) { return __builtin_bit_cast(float, (uint32_t)h << 16); }
#ifdef EMU
DEV bf16_t f2bf(float f) { uint32_t u = __builtin_bit_cast(uint32_t, f); u += 0x7FFFu + ((u >> 16) & 1u); return (bf16_t)(u >> 16); }
DEV uint32_t pack2(float a, float b) { return (uint32_t)f2bf(a) | ((uint32_t)f2bf(b) << 16); }
#else
typedef __bf16 bf16x2_nat __attribute__((ext_vector_type(2)));
typedef float f32x2_nat __attribute__((ext_vector_type(2)));
DEV uint32_t pack2(float a, float b) { const f32x2_nat v = {a, b}; const bf16x2_nat r = __builtin_convertvector(v, bf16x2_nat); return __builtin_bit_cast(uint32_t, r); }
DEV bf16_t f2bf(float f) { return __builtin_bit_cast(bf16_t, (__bf16)f); }
#endif
#ifdef EMU
DEV float fast_exp2(float x) { return exp2f(x); }
#else
DEV float fast_exp2(float x) { return __builtin_amdgcn_exp2f(x); }
#endif
#ifdef EMU
DEV float fast_rcp(float x) { return 1.0f / x; }
#else
DEV float fast_rcp(float x) { return __builtin_amdgcn_rcpf(x); }
#endif
#ifdef EMU
#define SCHED_FENCE()
#else
#define SCHED_FENCE() __builtin_amdgcn_sched_barrier(0)
#endif
DEV float sigmoidf_(float x) { return fast_rcp(1.0f + __expf(-x)); }
DEV float siluf_(float x) { return x * sigmoidf_(x); }

#ifdef EMU
#define WAVE_SYNC() emu_wave_sync()
#else
#define WAVE_SYNC() do { asm volatile("s_waitcnt lgkmcnt(0)" ::: "memory"); __builtin_amdgcn_wave_barrier(); } while (0)
#endif

struct Params { const float* in[28]; float* out; char* ws; int ph_lo, ph_hi; };
enum { I_X = 0, I_C, I_CTX, I_CCTX, I_ADAW, I_ADAB, I_NORM1, I_NORM2, I_WIN, I_RPB, I_QNORM, I_WUQ, I_KVNORM, I_WUKV, I_WAF, I_BAF, I_WAB, I_BAB, I_ONORM,
       I_WBRA, I_WBRB, I_WBRC, I_WOUT, I_ROUTER, I_WGATE, I_WUP, I_WDOWN, I_FNORM };

#ifndef EMU
#define XB_TMO      128
#define XB_XCNT(j)  (256  + 64 * (j))
#define XB_XSUB(j)  (1280 + 64 * (j))
#define XB_XGEN(j)  (2304 + 64 * (j))
#define XB_TOP      3328
#define XB_TOPGEN   3392
#define XCD_BAR_WORDS 3456
#define XB_SPIN_CAP (1u << 22)
#define LAS __attribute__((address_space(3)))
DEV unsigned xb_ld(unsigned* p)              { return __hip_atomic_load(p, __ATOMIC_RELAXED, __HIP_MEMORY_SCOPE_AGENT); }
DEV unsigned xb_add(unsigned* p, unsigned v) { return __hip_atomic_fetch_add(p, v, __ATOMIC_RELAXED, __HIP_MEMORY_SCOPE_AGENT); }
DEV unsigned xb_xcc_id() { return (unsigned)__builtin_amdgcn_s_getreg((3 << 11) | 20) & 0xFu; }
#define XB_SPIN(cond, bar) do { unsigned _sp = 0; while (cond) { __builtin_amdgcn_s_sleep(1); \
    if ((++_sp & 255u) == 0u) { if (xb_ld(&(bar)[XB_TMO])) break; if (_sp > XB_SPIN_CAP) { atomicAdd(&(bar)[XB_TMO], 1u); break; } } } } while (0)
struct XcdBarrier { unsigned* bar; unsigned x; volatile LAS unsigned* st; };
DEV XcdBarrier xcd_barrier_post(unsigned* bar, volatile LAS unsigned* st) {
    XcdBarrier b; b.bar = bar; b.x = xb_xcc_id(); b.st = st;
    if (ltid() == 0) (void)xb_add(&bar[XB_XCNT(b.x)], 1u);
    return b;
}
DEV void xcd_barrier_complete(unsigned* bar, unsigned x, unsigned& nloc, unsigned& nx) {
    const unsigned G = gridDim.x * gridDim.y * gridDim.z;
    unsigned sum, cnt, mine, sp = 0u;
    for (;;) {
        sum = 0u; cnt = 0u; mine = 0u;
#pragma unroll
        for (unsigned j = 0; j < 16; ++j) { const unsigned c = xb_ld(&bar[XB_XCNT(j)]); sum += c; cnt += (c > 0u) ? 1u : 0u; mine = (j == x) ? c : mine; }
        if (sum == G) break;
        __builtin_amdgcn_s_sleep(1);
        if ((++sp & 255u) == 0u) { if (xb_ld(&bar[XB_TMO])) break; if (sp > XB_SPIN_CAP) { atomicAdd(&bar[XB_TMO], 1u); break; } }
    }
    nloc = mine > 0u ? mine : 1u; nx = cnt > 0u ? cnt : 1u;
}
DEV void xcd_barrier(const XcdBarrier& b) {
    asm volatile("s_waitcnt vmcnt(0)" ::: "memory");
    __syncthreads();
    if (ltid() == 0) {
        unsigned* bar = b.bar;
        __builtin_amdgcn_s_waitcnt(0);
        unsigned nloc = b.st[0], nx = b.st[1];
        if (nloc == 0u) { xcd_barrier_complete(bar, b.x, nloc, nx); b.st[0] = nloc; b.st[1] = nx; }
        const unsigned old = xb_add(&bar[XB_XSUB(b.x)], 1u);
        const unsigned gen = old / nloc;
        if (old + 1u == (gen + 1u) * nloc) {
            __builtin_amdgcn_fence(__ATOMIC_RELEASE, "agent");
            asm volatile("s_waitcnt vmcnt(0)" ::: "memory");
            const unsigned og = xb_add(&bar[XB_TOP], 1u);
            const unsigned tg = og / nx;
            if (og + 1u == (tg + 1u) * nx) xb_add(&bar[XB_TOPGEN], 1u);
            else XB_SPIN(xb_ld(&bar[XB_TOPGEN]) == tg, bar);
            __builtin_amdgcn_fence(__ATOMIC_ACQUIRE, "agent");
            xb_add(&bar[XB_XGEN(b.x)], 1u);
            asm volatile("s_waitcnt vmcnt(0)" ::: "memory");
        } else {
            XB_SPIN(xb_ld(&bar[XB_XGEN(b.x)]) == gen, bar);
            __builtin_amdgcn_fence(__ATOMIC_ACQUIRE, "agent");
            asm volatile("s_waitcnt vmcnt(0)" ::: "memory");
        }
    }
    __syncthreads();
}
#endif

constexpr int LDS_BYTES = 147456;
constexpr int LDS_MISC = LDS_BYTES - 64;
constexpr int GS = 72;

DEV void acc_zero(f32x4 (&acc)[4][2]) {
#pragma unroll
    for (int mi = 0; mi < 4; ++mi)
#pragma unroll
        for (int ni = 0; ni < 2; ++ni) acc[mi][ni] = f32x4{0.f, 0.f, 0.f, 0.f};
}

#ifdef EMU
static Params emu_params;
DEV const Params* KP() { return &emu_params; }
#else
typedef const Params __attribute__((address_space(4))) CParams;
DEV CParams* KP() { CParams* p = (CParams*)__builtin_amdgcn_kernarg_segment_ptr(); asm volatile("" : "+s"(p)); return p; }
#endif
struct Ctx {
    char* smem; int layer;
    DEV const float* in(int i) const { return KP()->in[i]; }
    DEV float* out() const { return KP()->out; }
    DEV char* ws() const { return KP()->ws; }
    DEV float* mod(int l, int brow) const { return (float*)(ws() + WS_MOD) + ((size_t)l * (BATCH + 1) + brow) * D6; }
};

DEV void p0_mod_item(const Ctx& c, int item) {
    const int l = item / (D6 / 64), cc = item % (D6 / 64);
    float* sc = (float*)c.smem;
    float* red = sc + (BATCH + 1) * D;
    const int tid = ltid();
    __syncthreads();
    { constexpr int NC4 = BATCH * D / 4, NL = (NC4 + NTHR - 1) / NTHR;
      const f32x4* c4 = (const f32x4*)c.in(I_C); f32x4 cv[NL];
#pragma unroll
      for (int i = 0; i < NL; ++i) { const int ix = tid + i * NTHR; cv[i] = c4[ix < NC4 ? ix : NC4 - 1]; }
      const f32x4 cx = ((const f32x4*)c.in(I_CCTX))[tid & (D / 4 - 1)];
#pragma unroll
      for (int i = 0; i < NL; ++i) { const int ix = tid + i * NTHR; if (ix < NC4) { f32x4 o; o[0] = siluf_(cv[i][0]); o[1] = siluf_(cv[i][1]); o[2] = siluf_(cv[i][2]); o[3] = siluf_(cv[i][3]); *(f32x4*)(sc + ix * 4) = o; } }
      if (tid < D / 4) { f32x4 o; o[0] = siluf_(cx[0]); o[1] = siluf_(cx[1]); o[2] = siluf_(cx[2]); o[3] = siluf_(cx[3]); *(f32x4*)(sc + BATCH * D + tid * 4) = o; } }
    __syncthreads();
    const int col = tid & 63, kg = tid >> 6;
    const float* W = c.in(I_ADAW) + (size_t)l * D * D6 + cc * 64 + col;
    typedef float f32x16 __attribute__((ext_vector_type(16)));
    static_assert(BATCH + 1 <= 16, "mod rows");
    float a[BATCH + 1];
#pragma unroll
    for (int r = 0; r <= BATCH; ++r) a[r] = 0.f;
    {
        constexpr int UB = 16, NB = D / 8 / UB;
        static_assert(NB % 2 == 0, "mod batches");
        float w[UB], wn[UB];
#ifdef EMU
#define MOD_FMAC(acc, x, y) acc += (x) * (y)
#else
#define MOD_FMAC(acc, x, y) asm("v_fmac_f32 %0, %1, %2" : "+v"(acc) : "v"(x), "v"(y))
#endif
#define MOD_LD(dst, kbase) _Pragma("unroll") for (int u = 0; u < UB; ++u) dst[u] = NT_LOAD1(W + (size_t)((kbase) + 8 * u) * D6);
#define MOD_FMA(src, kbase) _Pragma("unroll") for (int u = 0; u < UB; ++u) { _Pragma("unroll") for (int r = 0; r <= BATCH; ++r) MOD_FMAC(a[r], sc[r * D + (kbase) + 8 * u], src[u]); }
        MOD_LD(w, kg)
        for (int bt = 0; bt < NB - 2; bt += 2) {
            const int kb = kg + bt * 8 * UB;
            MOD_LD(wn, kb + 8 * UB) SCHED_FENCE(); MOD_FMA(w, kb) SCHED_FENCE();
            MOD_LD(w, kb + 16 * UB) SCHED_FENCE(); MOD_FMA(wn, kb + 8 * UB) SCHED_FENCE();
        }
        { const int kb = kg + (NB - 2) * 8 * UB;
          MOD_LD(wn, kb + 8 * UB) SCHED_FENCE(); MOD_FMA(w, kb) SCHED_FENCE(); MOD_FMA(wn, kb + 8 * UB) }
#undef MOD_LD
#undef MOD_FMA
#undef MOD_FMAC
    }
#pragma unroll
    for (int r = 0; r <= BATCH; ++r) red[(kg * (BATCH + 1) + r) * 64 + col] = a[r];
    __syncthreads();
    for (int i = tid; i < (BATCH + 1) * 64; i += NTHR) { int r = i / 64, cl = i % 64; float s = 0.f;
        for (int g = 0; g < 8; ++g) s += red[(g * (BATCH + 1) + r) * 64 + cl];
        c.mod(l, r)[cc * 64 + cl] = s + c.in(I_ADAB)[(size_t)l * D6 + cc * 64 + cl]; }
}

template <class Map> DEV void convT_tile(char* smem, const float* src, int sstride, const float* gain, bf16_t* dst, int dstride, int n0, int k0, Map map) {
    float* t = (float*)smem;
    const int tid = ltid();
    __syncthreads();
    { float vv[4096 / NTHR], gg[4096 / NTHR];
#pragma unroll
      for (int q = 0; q < 4096 / NTHR; ++q) { const int i = tid + q * NTHR, k = i >> 6, n = i & 63; const int sc = map(n0 + n);
          vv[q] = src[(size_t)(k0 + k) * sstride + (sc < 0 ? 0 : sc)]; gg[q] = gain ? gain[k0 + k] : 1.f; if (sc < 0) vv[q] = 0.f; }
#pragma unroll
      for (int q = 0; q < 4096 / NTHR; ++q) { const int i = tid + q * NTHR, k = i >> 6, n = i & 63; t[k * 65 + n] = vv[q] * gg[q]; } }
    __syncthreads();
    { int n = tid >> 3, kc = (tid & 7) * 8; U4 o;
      o.x = pack2(t[(kc + 0) * 65 + n], t[(kc + 1) * 65 + n]); o.y = pack2(t[(kc + 2) * 65 + n], t[(kc + 3) * 65 + n]);
      o.z = pack2(t[(kc + 4) * 65 + n], t[(kc + 5) * 65 + n]); o.w = pack2(t[(kc + 6) * 65 + n], t[(kc + 7) * 65 + n]);
      *(U4*)(dst + (size_t)(n0 + n) * dstride + k0 + kc) = o; }
}
DEV int rope_perm32(int j) { int blk = j >> 3; blk = (blk == 1) ? 2 : (blk == 2) ? 1 : blk; return blk * 8 + (j & 7); }
struct MapWin { DEV int operator()(int n) const {
    if (n < 256) return 256 + n;
    if (n < 512) return 1440 + (n - 256);
    if (n < 640) return 1024 + (n - 512);
    if (n < 672) return 1152 + rope_perm32(n - 640);
    if (n < 688) return 2208 + (n - 672);
    if (n < 704) return 2224 + (n - 688);
    if (n < 768) return -1;
    if (n < 1024) return n - 768;
    if (n < 1280) return 768 + (n - 1024);
    if (n < 1536) return 1184 + (n - 1280);
    if (n < 2048) return 2240 + (n - 1536);
    if (n < ZROW) return 2752 + (n - ZMA);
    if (n < ZW) return -1;
    if (n < ZW + 256) return 512 + (n - ZW);
    return 1696 + (n - ZW - 256); } };
struct MapUq { DEV int operator()(int n) const { int h = n / 96, w = n % 96; return (w < 64) ? n : h * 96 + 64 + rope_perm32(w - 64); } };
struct MapId { DEV int operator()(int n) const { return n; } };
struct MapGU { int which; DEV int operator()(int r) const { int q = r >> 5, w = r & 31; if (which == 0) return (w < 16) ? 16 * q + w : -2; return (w >= 16) ? 16 * q + w - 16 : -2; } };

constexpr int CW_UQ = 6 * 4, CW_UKV = 8 * 2, CW_PER_LAYER = CW_UQ + CW_UKV;
DEV void p0_gatew_item(const Ctx& c, int l) {
    bf16_t* o = (bf16_t*)(c.ws() + WS_WGT) + (size_t)l * 2 * 2 * 256 * 16;
    const float* wf = c.in(I_WAF); const float* wb = c.in(I_WAB);
    constexpr int NQ = 2 * 256 * 16 / NTHR; float wv[NQ];
#pragma unroll
    for (int q = 0; q < NQ; ++q) { const int i = ltid() + q * NTHR, dir = i >> 12, d = (i >> 4) & 255, r = i & 15; wv[q] = (dir == 0 ? wf : wb)[((size_t)l * 16 + r) * 256 + d]; }
#pragma unroll
    for (int q = 0; q < NQ; ++q) { const int i = ltid() + q * NTHR, dir = i >> 12, d = (i >> 4) & 255, r = i & 15;
        const float w = wv[q]; const bf16_t hi = f2bf(w); const bf16_t lo = f2bf(w - bf2f(hi));
        o[((dir * 2 + 0) * 256 + d) * 16 + r] = hi; o[((dir * 2 + 1) * 256 + d) * 16 + r] = lo; }
}
DEV void p0_convw_item(const Ctx& c, int item) {
    const int l = item / CW_PER_LAYER; int r = item % CW_PER_LAYER;
    if (r < CW_UQ) { int tn = r / 4, tk = r % 4;
        convT_tile(c.smem, c.in(I_WUQ) + (size_t)l * 256 * 384, 384, c.in(I_QNORM) + l * 256, (bf16_t*)(c.ws() + WS_WUQ) + (size_t)l * 384 * 256, 256, tn * 64, tk * 64, MapUq()); return; }
    r -= CW_UQ;
    { int tn = r / 2, tk = r % 2;
      convT_tile(c.smem, c.in(I_WUKV) + (size_t)l * 128 * 512, 512, c.in(I_KVNORM) + l * 128, (bf16_t*)(c.ws() + WS_WUKV) + (size_t)l * 512 * 128, 128, tn * 64, tk * 64, MapId()); }
}
struct ConvJob { const float* src; bf16_t* dst; int sstride, dstride, k0, n0, mode; };
DEV int conv_row(int mode, int n) { return mode >= 2 ? n : 8 * (n >> 2) + (mode == 1 ? 4 : 0) + (n & 3); }
constexpr int CE_G = (D / 64) * (FF / 256), CE_D = (FF / 64) * (D / 256), CE_PER_E = 2 * CE_G + CE_D, CE_ITEMS = NE * CE_PER_E;
DEV ConvJob convexp_job(const Ctx& c, int l, int item) {
    ConvJob j; const int e = item / CE_PER_E; int r = item % CE_PER_E;
    bf16_t* wgu = (bf16_t*)(c.ws() + WS_EXP + EXP_WGU) + (size_t)e * 2 * FF * D;
    if (r < 2 * CE_G) { const int up = r >= CE_G; r -= up * CE_G; j.src = (up ? c.in(I_WUP) : c.in(I_WGATE)) + ((size_t)l * NE + e) * D * FF; j.sstride = FF; j.k0 = (r % (D / 64)) * 64; j.n0 = (r / (D / 64)) * 256; j.dst = wgu; j.dstride = D; j.mode = up; return j; }
    r -= 2 * CE_G;
    j.src = c.in(I_WDOWN) + ((size_t)l * NE + e) * FF * D; j.sstride = D; j.k0 = (r % (FF / 64)) * 64; j.n0 = (r / (FF / 64)) * 256; j.dst = (bf16_t*)(c.ws() + WS_EXP + EXP_WD) + (size_t)e * D * FF; j.dstride = FF; j.mode = 2; return j;
}
DEV void conv_load(const ConvJob& j, f32x4 (&v)[2][4]) {
    const int tid = ltid(), lane = tid & 63, wv = tid >> 6;
    int col = j.n0 + lane * 4; if (j.mode == 3) col = MapWin()(col);
    const bool ok = col >= 0;
    const float* base = j.src + (ok ? col : 0) + (size_t)(j.k0 + wv * 4) * j.sstride;
#pragma unroll
    for (int i = 0; i < 2; ++i)
#pragma unroll
        for (int r = 0; r < 4; ++r) v[i][r] = NT_LOAD4(base + (size_t)(32 * i + r) * j.sstride);
    if (!ok) {
#pragma unroll
        for (int i = 0; i < 2; ++i)
#pragma unroll
            for (int r = 0; r < 4; ++r) v[i][r] = f32x4{0.f, 0.f, 0.f, 0.f}; }
}
DEV void conv_finish(char* smem, const ConvJob& j, const f32x4 (&v)[2][4]) {
    constexpr int RS = 68;
    bf16_t* t = (bf16_t*)smem;
    const int tid = ltid(), lane = tid & 63, wv = tid >> 6;
    __syncthreads();
#pragma unroll
    for (int i = 0; i < 2; ++i)
#pragma unroll
        for (int q = 0; q < 4; ++q) { U2 w; w.x = pack2(v[i][0][q], v[i][1][q]); w.y = pack2(v[i][2][q], v[i][3][q]); *(U2*)(t + (q * 64 + lane) * RS + (wv + 8 * i) * 4) = w; }
    __syncthreads();
#pragma unroll
    for (int i = 0; i < 4; ++i) { const int ch = tid + i * NTHR, n = ch >> 3, kc = (ch & 7) * 8; const bf16_t* rp = t + ((n & 3) * 64 + (n >> 2)) * RS + kc;
        const U2 a = *(const U2*)rp, bq = *(const U2*)(rp + 4); U4 o; o.x = a.x; o.y = a.y; o.z = bq.x; o.w = bq.y;
        *(U4*)(j.dst + (size_t)conv_row(j.mode, j.n0 + n) * j.dstride + j.k0 + kc) = o; }
}
constexpr int CONV_RUN = 2;
DEV int conv_seq(int lo, int rank, int nb, int s) { return lo + (rank + (s / CONV_RUN) * nb) * CONV_RUN + (s % CONV_RUN); }
template <class JobFn> DEV void conv_range(const Ctx& c, JobFn jobfn, int lo, int hi, int rank, int nb) {
    int sq = 0, it = conv_seq(lo, rank, nb, 0); if (it >= hi) return;
    ConvJob j = jobfn(it); f32x4 v[2][4]; conv_load(j, v);
    for (;;) {
        const int nx = conv_seq(lo, rank, nb, sq + 1); const bool more = nx < hi;
        ConvJob jn = j; f32x4 vn[2][4];
        if (more) { jn = jobfn(nx); conv_load(jn, vn); }
        conv_finish(c.smem, j, v);
        if (!more) break;
#pragma unroll
        for (int i = 0; i < 2; ++i)
#pragma unroll
            for (int r = 0; r < 4; ++r) v[i][r] = vn[i][r];
        j = jn; it = nx; ++sq;
    }
}
struct ExpJobFn { const Ctx* c; int l; DEV ConvJob operator()(int item) const { return convexp_job(*c, l, item); } };
DEV void convexp_range(const Ctx& c, int l, int lo, int hi, int rank, int nb) { ExpJobFn f; f.c = &c; f.l = l; conv_range(c, f, lo, hi, rank, nb); }
constexpr int PJ_WIN = (NIN / 256) * (D / 64), PJ_BRA = (D / 256) * 4, PJ_BRC = (D / 256) * 8, PJ_OUT = (D / 256) * (D / 64), PJ_PER_L = PJ_WIN + 2 * PJ_BRA + PJ_BRC + PJ_OUT;
struct PrepJobFn { const Ctx* c; DEV ConvJob operator()(int item) const {
    ConvJob j; const int l = item / PJ_PER_L; int r = item % PJ_PER_L; const Ctx& cc = *c;
    if (r < PJ_WIN) { j.src = cc.in(I_WIN) + (size_t)l * D * D_IN; j.sstride = D_IN; j.k0 = (r % (D / 64)) * 64; j.n0 = (r / (D / 64)) * 256; j.dst = (bf16_t*)(cc.ws() + WS_WIN) + (size_t)l * NIN * D; j.dstride = D; j.mode = 3; return j; }
    r -= PJ_WIN; bf16_t* wbr = (bf16_t*)(cc.ws() + WS_WBR) + (size_t)l * D * 1024; j.mode = 2; j.sstride = D;
    if (r < PJ_BRA) { j.src = cc.in(I_WBRA) + (size_t)l * 256 * D; j.k0 = (r % 4) * 64; j.n0 = (r / 4) * 256; j.dst = wbr; j.dstride = 1024; return j; }
    r -= PJ_BRA;
    if (r < PJ_BRA) { j.src = cc.in(I_WBRB) + (size_t)l * 256 * D; j.k0 = (r % 4) * 64; j.n0 = (r / 4) * 256; j.dst = wbr + 256; j.dstride = 1024; return j; }
    r -= PJ_BRA;
    if (r < PJ_BRC) { j.src = cc.in(I_WBRC) + (size_t)l * 512 * D; j.k0 = (r % 8) * 64; j.n0 = (r / 8) * 256; j.dst = wbr + 512; j.dstride = 1024; return j; }
    r -= PJ_BRC;
    j.src = cc.in(I_WOUT) + (size_t)l * D * D; j.k0 = (r % (D / 64)) * 64; j.n0 = (r / (D / 64)) * 256; j.dst = (bf16_t*)(cc.ws() + WS_WOUT) + (size_t)l * D * D; j.dstride = D; return j; } };

constexpr int NV = D / 256;
DEV const float* xin_row(const Ctx& c, int grow) {
    const int b = grow / NTOK, p = grow % NTOK;
    return p < CTX_LEN ? c.in(I_CTX) + ((size_t)b * CTX_LEN + p) * D : c.in(I_X) + ((size_t)b * SEQ + (p - CTX_LEN)) * D;
}
DEV void xb_load(const Ctx& c, int grow, f32x4 (&xv)[NV]) {
    const int lane = ltid() & 63; const bf16_t* x = (const bf16_t*)(c.ws() + WS_XB) + (size_t)grow * D;
    U2 pk[NV];
#pragma unroll
    for (int i = 0; i < NV; ++i) pk[i] = *(const U2*)(x + lane * 4 + i * 256);
#pragma unroll
    for (int i = 0; i < NV; ++i) xv[i] = f32x4{bf2f((bf16_t)(pk[i].x & 0xFFFF)), bf2f((bf16_t)(pk[i].x >> 16)), bf2f((bf16_t)(pk[i].y & 0xFFFF)), bf2f((bf16_t)(pk[i].y >> 16))};
}
DEV void xb_store(const Ctx& c, int grow, const f32x4 (&xv)[NV]) {
    const int lane = ltid() & 63; bf16_t* x = (bf16_t*)(c.ws() + WS_XB) + (size_t)grow * D;
#pragma unroll
    for (int i = 0; i < NV; ++i) { U2 pk; pk.x = pack2(xv[i][0], xv[i][1]); pk.y = pack2(xv[i][2], xv[i][3]); *(U2*)(x + lane * 4 + i * 256) = pk; }
}
DEV void xrow_load(const Ctx& c, int grow, f32x4 (&xv)[NV]) {
    if (c.layer == 0) { const int lane = ltid() & 63; const float* x = xin_row(c, grow);
#pragma unroll
        for (int i = 0; i < NV; ++i) xv[i] = *(const f32x4*)(x + lane * 4 + i * 256); }
    else xb_load(c, grow, xv);
}
DEV float wave_sum(float v) { for (int m = 1; m < 64; m <<= 1) v += __shfl_xor(v, m); return v; }

DEV void moe_combine_regs(const Ctx& c, int grow, int lprev, f32x4 (&xv)[NV]) {
    const int lane = ltid() & 63;
    const int b = grow / NTOK, p = grow % NTOK;
    const float* gate = c.mod(lprev, p < CTX_LEN ? BATCH : b) + 5 * D;
    const int* inv = (const int*)(c.ws() + WS_INV) + (size_t)grow * NE;
    const bf16_t* ye = (const bf16_t*)(c.ws() + WS_YE);
    f32x4 a[NV], gt[NV];
    const int mine = (lane < NE) ? inv[lane] : -1;
#pragma unroll
    for (int i = 0; i < NV; ++i) { a[i] = f32x4{0.f, 0.f, 0.f, 0.f}; gt[i] = *(const f32x4*)(gate + lane * 4 + i * 256); }
    const int mine_unused = 0; (void)mine_unused;
    unsigned long long msk = __ballot(mine >= 0);
    while (msk) {
        const int e0 = __builtin_ctzll(msk); msk &= msk - 1;
        int e1 = -1; if (msk) { e1 = __builtin_ctzll(msk); msk &= msk - 1; }
        const int i0 = __shfl(mine, e0), i1 = __shfl(mine, e1 < 0 ? e0 : e1);
        U2 p0[NV], p1[NV];
#pragma unroll
        for (int i = 0; i < NV; ++i) { p0[i] = *(const U2*)(ye + (size_t)i0 * D + lane * 4 + i * 256); p1[i] = *(const U2*)(ye + (size_t)i1 * D + lane * 4 + i * 256); }
#pragma unroll
        for (int i = 0; i < NV; ++i) {
            a[i][0] += bf2f((bf16_t)(p0[i].x & 0xFFFF)); a[i][1] += bf2f((bf16_t)(p0[i].x >> 16)); a[i][2] += bf2f((bf16_t)(p0[i].y & 0xFFFF)); a[i][3] += bf2f((bf16_t)(p0[i].y >> 16));
            if (e1 >= 0) { a[i][0] += bf2f((bf16_t)(p1[i].x & 0xFFFF)); a[i][1] += bf2f((bf16_t)(p1[i].x >> 16)); a[i][2] += bf2f((bf16_t)(p1[i].y & 0xFFFF)); a[i][3] += bf2f((bf16_t)(p1[i].y >> 16)); } }
    }
#pragma unroll
    for (int i = 0; i < NV; ++i) xv[i] += gt[i] * a[i];
}
DEV void p1_norm_row(const Ctx& c, int grow) {
    const int lane = ltid() & 63, l = c.layer;
    const int b = grow / NTOK, p = grow % NTOK;
    const float* md = c.mod(l, p < CTX_LEN ? BATCH : b);
    const float* g = c.in(I_NORM1) + l * D;
    f32x4 xv[NV], gv[NV], scv[NV], shv[NV];
    xrow_load(c, grow, xv);
#pragma unroll
    for (int i = 0; i < NV; ++i) { const int cc = lane * 4 + i * 256; gv[i] = *(const f32x4*)(g + cc); scv[i] = *(const f32x4*)(md + D + cc); shv[i] = *(const f32x4*)(md + cc); }
    if (l > 0) { moe_combine_regs(c, grow, l - 1, xv); if (l < DEPTH - 1 || p >= CTX_LEN) xb_store(c, grow, xv); }
    float ss = 0.f;
#pragma unroll
    for (int i = 0; i < NV; ++i) ss += xv[i][0] * xv[i][0] + xv[i][1] * xv[i][1] + xv[i][2] * xv[i][2] + xv[i][3] * xv[i][3];
    ss = wave_sum(ss);
    const float r = rsqrtf(ss / D + EPS);
    bf16_t* h = (bf16_t*)(c.ws() + WS_H) + (size_t)grow * D;
#pragma unroll
    for (int i = 0; i < NV; ++i) { const int cc = lane * 4 + i * 256; float o[4];
#pragma unroll
        for (int k = 0; k < 4; ++k) o[k] = xv[i][k] * r * gv[i][k] * (1.f + scv[i][k]) + shv[i][k];
        U2 pk; pk.x = pack2(o[0], o[1]); pk.y = pack2(o[2], o[3]); *(U2*)(h + cc) = pk; }
}

#ifdef EMU
#define LDSP
#define G8_GLDS(gptr, ldsptr) memcpy((char*)(ldsptr) + (ltid() & 63) * 16, (const void*)(gptr), 16)
#define G8_WAIT_V(n)
#define G8_WAIT_L(n)
#define G8_BAR __syncthreads()
#define G8_SCHED
#define G8_PRIO(x)
#define G8_LAUNDER(v)
DEV unsigned cvt_pk_bf16(float lo, float hi) { return pack2(lo, hi); }
#else
#define LDSP __attribute__((address_space(3)))
#define G8_GLDS(gptr, ldsptr) __builtin_amdgcn_global_load_lds((const unsigned*)(gptr), (LDSP unsigned*)(ldsptr), 16, 0, 0)
#define G8_WAIT_V(n) asm volatile("s_waitcnt vmcnt(" #n ")" ::: "memory")
#define G8_WAIT_L(n) asm volatile("s_waitcnt lgkmcnt(" #n ")" ::: "memory")
#define G8_BAR __builtin_amdgcn_s_barrier()
#define G8_SCHED __builtin_amdgcn_sched_barrier(0)
#define G8_PRIO(x) __builtin_amdgcn_s_setprio(x)
#define G8_LAUNDER(v) asm volatile("" : "+v"(v))
DEV unsigned cvt_pk_bf16(float lo, float hi) { return pack2(lo, hi); }
#endif
namespace g8 {
constexpr int BM = 256, BK = 64, HALF = 128, HTB = HALF * BK * 2, STAGE_BYTES = 8 * HTB, NXCD = 8, WGM = 8;
DEV int lds_byte(int r, int c) { const int st = (r >> 4) * 2 + (c >> 5), rr = r & 15, cc = c & 31, ob = rr * 64 + cc * 2; return st * 1024 + (ob ^ (((ob >> 9) & 1) << 5)); }
DEV void stage_rc(int b, int& R, int& C) { const int st = b / 1024, sb = b % 1024, swz = sb ^ (((sb >> 9) & 1) << 5); R = (st >> 1) * 16 + swz / 64; C = (st & 1) * 32 + (swz % 64) / 2; }
DEV int perm32(int rho) { const int n = rho >> 4, i = rho & 15; return 8 * (i >> 2) + 4 * n + (i & 3); }
struct Unit { int pm, pn, aux, idx; };
DEV void order_map(int L, int nM, int nN, int& pm, int& pn) {
    const int nwg = nM * nN; int wgid = L;
    { const int q = nwg / NXCD, r = nwg % NXCD, xcd = wgid % NXCD, off = wgid / NXCD; wgid = (xcd < r ? xcd * (q + 1) : r * (q + 1) + (xcd - r) * q) + off; }
    const int nig = WGM * nN, gid = wgid / nig, fm = gid * WGM, gsz = (nM - fm) < WGM ? (nM - fm) : WGM;
    pm = fm + ((wgid % nig) % gsz); pn = (wgid % nig) / gsz;
}
typedef f32x4 Acc[2][2][4][2];
template <class P> DEV void gemm_phase(LDSP unsigned char* lds, const P& prob) {
    const int tid = ltid(), wid = __builtin_amdgcn_readfirstlane(tid >> 6), lane = tid & 63, wr = wid >> 2, wc = wid & 3, fr = lane & 15, fq = lane >> 4;
    unsigned voffB[2][2];
    prob.prologue(lds);
#define G8_RC(i, R, C) int R, C; stage_rc(ltid() * 16 + (i) * 8192, R, C)
#pragma unroll
    for (int i = 0; i < 2; ++i) { int R, C; stage_rc(tid * 16 + i * 8192, R, C); const int Rb = P::PERM ? ((R & ~31) + perm32(R & 31)) : R;
        voffB[0][i] = (unsigned)Rb * prob.ldb() + (unsigned)C * 2u; voffB[1][i] = voffB[0][i] + 128u * prob.ldb(); }
    const size_t kstep = (size_t)(BK * 2);
    const unsigned ldsw = (unsigned)wid * 1024u;
    const int aoff = lds_byte(wr * 64 + fr, fq * 8), boff = lds_byte(wc * 32 + fr, fq * 8);
#define G8_SA(b, h) (((b) * 2 + (h)) * HTB)
#define G8_SB(b, h) ((4 + (b) * 2 + (h)) * HTB)
#define G8_STAGE(bufoff, gbase, v0, v1) do { unsigned _v0 = (v0), _v1 = (v1); G8_LAUNDER(_v0); G8_LAUNDER(_v1); G8_GLDS((const char*)(gbase) + _v0, lds + (bufoff) + ldsw); G8_GLDS((const char*)(gbase) + _v1, lds + (bufoff) + ldsw + 8192); } while (0)
#define G8_LDA(dst, b, h) do { _Pragma("unroll") for (int m = 0; m < 4; ++m) _Pragma("unroll") for (int k = 0; k < 2; ++k) dst[m][k] = *(const LDSP bf16x8*)(lds + G8_SA(b, h) + aoff + m * 2048 + k * 1024); } while (0)
#define G8_LDB(dst, b, h) do { _Pragma("unroll") for (int n = 0; n < 2; ++n) _Pragma("unroll") for (int k = 0; k < 2; ++k) dst[n][k] = *(const LDSP bf16x8*)(lds + G8_SB(b, h) + boff + n * 2048 + k * 1024); } while (0)
#define G8_MMA(ai, bj, At, Bt) do { G8_PRIO(1); _Pragma("unroll") for (int m = 0; m < 4; ++m) _Pragma("unroll") for (int n = 0; n < 2; ++n) _Pragma("unroll") for (int k = 0; k < 2; ++k) \
        acc[ai][bj][m][n] = __builtin_amdgcn_mfma_f32_16x16x32_bf16(Bt[n][k], At[m][k], acc[ai][bj][m][n], 0, 0, 0); G8_PRIO(0); } while (0)
#define G8_ZERO() do { _Pragma("unroll") for (int a = 0; a < 2; ++a) _Pragma("unroll") for (int b = 0; b < 2; ++b) _Pragma("unroll") for (int m = 0; m < 4; ++m) _Pragma("unroll") for (int n = 0; n < 2; ++n) acc[a][b][m][n] = f32x4{0.f, 0.f, 0.f, 0.f}; } while (0)
    Unit cur, nxt; int ui = 0;
    if (!prob.next(0, cur)) return;
    Acc acc; G8_ZERO();
    bf16x8 At[4][2], B0[2][2], B1[2][2];
    const char* cA = prob.a_base(cur); const char* cB = prob.b_base(cur); int ntc = prob.nt(cur);
    unsigned vc00, vc01, vc10, vc11;
    { G8_RC(0, R0, C0); G8_RC(1, R1, C1); vc00 = prob.a_voff(lds, cur, 0, R0, C0); vc01 = prob.a_voff(lds, cur, 0, R1, C1); vc10 = prob.a_voff(lds, cur, 1, R0, C0); vc11 = prob.a_voff(lds, cur, 1, R1, C1); }
    G8_STAGE(G8_SB(0, 0), cB, voffB[0][0], voffB[0][1]); G8_STAGE(G8_SA(0, 0), cA, vc00, vc01); G8_STAGE(G8_SB(0, 1), cB, voffB[1][0], voffB[1][1]); G8_STAGE(G8_SA(0, 1), cA, vc10, vc11);
    if (wr == 1) G8_BAR;
    G8_WAIT_V(4); G8_BAR;
    G8_STAGE(G8_SB(1, 0), cB + kstep, voffB[0][0], voffB[0][1]); G8_STAGE(G8_SA(1, 0), cA + kstep, vc00, vc01); G8_STAGE(G8_SB(1, 1), cB + kstep, voffB[1][0], voffB[1][1]);
    G8_WAIT_V(6); G8_BAR;
    for (;;) {
        const bool has_next = prob.next(ui + 1, nxt);
        const char* nA = has_next ? prob.a_base(nxt) : cA; const char* nB = has_next ? prob.b_base(nxt) : cB;
        unsigned vn00 = vc00, vn01 = vc01, vn10 = vc10, vn11 = vc11;
        for (int t = 0; t < ntc; t += 2) {
            const bool last = (t == ntc - 2);
            if (P::GATHER && last && has_next) { G8_RC(0, R0, C0); G8_RC(1, R1, C1); vn00 = prob.a_voff(lds, nxt, 0, R0, C0); vn01 = prob.a_voff(lds, nxt, 0, R1, C1); vn10 = prob.a_voff(lds, nxt, 1, R0, C0); vn11 = prob.a_voff(lds, nxt, 1, R1, C1); }
            const char* a1 = cA + (size_t)(t + 1) * kstep;
            const char* a2 = last ? nA : cA + (size_t)(t + 2) * kstep; const char* b2 = last ? nB : cB + (size_t)(t + 2) * kstep;
            const char* a3 = a2 + kstep; const char* b3 = b2 + kstep;
            const unsigned w00 = last ? vn00 : vc00, w01 = last ? vn01 : vc01, w10 = last ? vn10 : vc10, w11 = last ? vn11 : vc11;
            G8_LDB(B0, 0, 0); G8_SCHED; G8_LDA(At, 0, 0); G8_STAGE(G8_SA(1, 1), a1, vc10, vc11);
            G8_WAIT_L(8); G8_BAR; G8_WAIT_L(0); G8_MMA(0, 0, At, B0); G8_BAR; G8_SCHED;
            G8_LDB(B1, 0, 1); G8_STAGE(G8_SB(0, 0), b2, voffB[0][0], voffB[0][1]);
            G8_BAR; G8_WAIT_L(0); G8_MMA(0, 1, At, B1); G8_BAR;
            G8_LDA(At, 0, 1); G8_STAGE(G8_SA(0, 0), a2, w00, w01);
            G8_BAR; G8_WAIT_L(0); G8_MMA(1, 0, At, B0); G8_BAR; G8_SCHED;
            G8_STAGE(G8_SB(0, 1), b2, voffB[1][0], voffB[1][1]);
            G8_WAIT_V(6); G8_BAR; G8_MMA(1, 1, At, B1); G8_BAR;
            G8_LDB(B0, 1, 0); G8_SCHED; G8_LDA(At, 1, 0); G8_STAGE(G8_SA(0, 1), a2, w10, w11);
            G8_WAIT_L(8); G8_BAR; G8_WAIT_L(0); G8_MMA(0, 0, At, B0); G8_BAR; G8_SCHED;
            G8_LDB(B1, 1, 1); G8_STAGE(G8_SB(1, 0), b3, voffB[0][0], voffB[0][1]);
            G8_BAR; G8_WAIT_L(0); G8_MMA(0, 1, At, B1); G8_BAR;
            G8_LDA(At, 1, 1); G8_STAGE(G8_SA(1, 0), a3, w00, w01);
            G8_BAR; G8_WAIT_L(0); G8_MMA(1, 0, At, B0); G8_BAR; G8_SCHED;
            G8_STAGE(G8_SB(1, 1), b3, voffB[1][0], voffB[1][1]);
            G8_WAIT_V(6); G8_BAR; G8_MMA(1, 1, At, B1); G8_BAR;
        }
        if (wr == 0) G8_BAR;
        prob.epi(acc, cur, wr, wc, fr, fq);
        if (!has_next) break;
        if (!prob.keep_acc(cur)) G8_ZERO();
        cur = nxt; cA = nA; cB = nB; vc00 = vn00; vc01 = vn01; vc10 = vn10; vc11 = vn11; ntc = prob.nt(cur); ++ui;
        if (wr == 1) G8_BAR;
    }
    G8_WAIT_V(0);
    G8_BAR;
#undef G8_RC
#undef G8_SA
#undef G8_SB
#undef G8_STAGE
#undef G8_LDA
#undef G8_LDB
#undef G8_MMA
#undef G8_ZERO
}
}

DEV int lat_unit_row0(int pm) { const int b = pm / (SEQ / 256), w = pm % (SEQ / 256); return b * NTOK + CTX_LEN + w * 256; }
struct ProbInproj {
    static constexpr bool PERM = true, GATHER = false;
    const char* A; const char* Bt; bf16_t* Z; bf16_t* navt; bf16_t* gvt; int G, c, lastl;
    DEV bool next(int i, g8::Unit& u) const { const int L = i * G + c; u.aux = 0; u.idx = i;
        if (!lastl) { if (L >= (MTOT / 256) * (NIN / 256)) return false; g8::order_map(L, MTOT / 256, NIN / 256, u.pm, u.pn); return true; }
        constexpr int NL = BATCH * (SEQ / 256) * (NIN / 256), NC = BATCH * (CTX_LEN / 256) * 6;
        if (L >= NL + NC) return false;
        if (L < NL) { int pml; g8::order_map(L, BATCH * (SEQ / 256), NIN / 256, pml, u.pn); u.pm = lat_unit_row0(pml) / 256; return true; }
        const int Lc = L - NL, bc = Lc / 6, j = Lc % 6; u.pm = ((bc / (CTX_LEN / 256)) * NTOK + (bc % (CTX_LEN / 256)) * 256) / 256; u.pn = j < 3 ? j : ZW / 256 + (j - 3); return true; }
    DEV bool swapped(const g8::Unit& u) const { return u.pn * 256 >= ZW; }
    DEV const char* a_base(const g8::Unit& u) const { return swapped(u) ? Bt + (size_t)u.pn * 256 * D * 2 : A + (size_t)u.pm * 256 * D * 2; }
    DEV const char* b_base(const g8::Unit& u) const { return swapped(u) ? A + (size_t)u.pm * 256 * D * 2 : Bt + (size_t)u.pn * 256 * D * 2; }
    DEV int nt(const g8::Unit&) const { return D / 64; }
    DEV void prologue(LDSP unsigned char*) const {}
    DEV unsigned a_voff(LDSP unsigned char*, const g8::Unit&, int h, int R, int C) const { return (unsigned)((h * 128 + R) * D + C) * 2u; }
    DEV unsigned ldb() const { return D * 2; }
    DEV bool keep_acc(const g8::Unit&) const { return false; }
    DEV void epi(g8::Acc& acc, const g8::Unit& u, int wr, int wc, int fr, int fq) const {
        if (u.pn * 256 < ZW) {
            bf16_t* base = Z + (size_t)(u.pm * 256 + wr * 64 + fr) * ZS + u.pn * 256 + wc * 32 + fq * 8;
            if (u.pn * 256 >= ZMA) {
                unsigned char* gb = (unsigned char*)Z + (size_t)(u.pm * 256 + wr * 64 + fr) * ZS * 2 + (size_t)ZMA * 2 + (u.pn * 256 - ZMA) + wc * 32 + fq * 8;
#pragma unroll
                for (int ai = 0; ai < 2; ++ai)
#pragma unroll
                    for (int m = 0; m < 4; ++m)
#pragma unroll
                        for (int bj = 0; bj < 2; ++bj) { U2 w; w.x = 0u; w.y = 0u;
#pragma unroll
                            for (int n = 0; n < 2; ++n)
#pragma unroll
                                for (int j = 0; j < 4; ++j) { const float e = fast_exp2(fmaf(acc[ai][bj][m][n][j], -1.4426950408889634f, -8.0f));
                                    const float s256 = fmaxf(__builtin_rintf(fast_rcp(e + (1.0f / 256.0f))), 1.0f);
                                    if (n == 0) w.x = pk_u8(w.x, s256, j); else w.y = pk_u8(w.y, s256, j); }
                            *(U2*)(gb + (size_t)(ai * 128 + m * 16) * ZS * 2 + bj * 128) = w; }
                return;
            }
#pragma unroll
            for (int ai = 0; ai < 2; ++ai)
#pragma unroll
                for (int m = 0; m < 4; ++m)
#pragma unroll
                    for (int bj = 0; bj < 2; ++bj) { U4 w; w.x = cvt_pk_bf16(acc[ai][bj][m][0][0], acc[ai][bj][m][0][1]); w.y = cvt_pk_bf16(acc[ai][bj][m][0][2], acc[ai][bj][m][0][3]);
                        w.z = cvt_pk_bf16(acc[ai][bj][m][1][0], acc[ai][bj][m][1][1]); w.w = cvt_pk_bf16(acc[ai][bj][m][1][2], acc[ai][bj][m][1][3]);
                        *(U4*)(base + (size_t)(ai * 128 + m * 16) * ZS + bj * 128) = w; }
        } else {
            const int b = (u.pm * 256) / NTOK, t0 = (u.pm * 256) % NTOK + wc * 32 + fq * 8;
            const int cc0 = u.pn * 256 - ZW;
            bf16_t* base = ((cc0 < 256) ? navt + (size_t)(b * 256 + cc0) * NTOK : gvt + (size_t)(b * 512 + cc0 - 256) * NTOK) + (size_t)(wr * 64 + fr) * NTOK + t0;
#pragma unroll
            for (int ai = 0; ai < 2; ++ai)
#pragma unroll
                for (int m = 0; m < 4; ++m)
#pragma unroll
                    for (int bj = 0; bj < 2; ++bj) { U4 w; w.x = cvt_pk_bf16(acc[ai][bj][m][0][0], acc[ai][bj][m][0][1]); w.y = cvt_pk_bf16(acc[ai][bj][m][0][2], acc[ai][bj][m][0][3]);
                        w.z = cvt_pk_bf16(acc[ai][bj][m][1][0], acc[ai][bj][m][1][1]); w.w = cvt_pk_bf16(acc[ai][bj][m][1][2], acc[ai][bj][m][1][3]);
                        *(U4*)(base + (size_t)(ai * 128 + m * 16) * NTOK + bj * 128) = w; }
        }
    }
};

constexpr int MT_ALL = MTOT / 128;
constexpr int MT_LAT = BATCH * (SEQ / 128);
DEV int lat_tile_m0(int t) { int b = t / (SEQ / 128), w = t % (SEQ / 128); return b * NTOK + CTX_LEN + w * 128; }

constexpr int UP_RS_OFF = 2 * 128 * (256 + 8) * 2;
static_assert(UP_RS_OFF + 128 * 4 <= LDS_MISC, "lds");
template <int K> struct UpLd { U4 a[K / 32], b[K / 32]; };
template <int K> DEV UpLd<K> up_load(const bf16_t* A, const bf16_t* Bt) {
    const int tid = ltid(), row = tid >> 2, pc = tid & 3; UpLd<K> r;
#pragma unroll
    for (int i = 0; i < K / 32; ++i) { r.a[i] = *(const U4*)(A + (size_t)row * D_IN_PAD + (pc + 4 * i) * 8); r.b[i] = *(const U4*)(Bt + (size_t)row * K + (pc + 4 * i) * 8); }
    return r;
}
template <int K> DEV void up_stage(char* smem, const UpLd<K>& ld) {
    constexpr int RS_ = K + 8;
    bf16_t* As = (bf16_t*)smem; bf16_t* Bs = As + 128 * RS_; float* rs = (float*)(smem + UP_RS_OFF);
    const int tid = ltid(), row = tid >> 2, pc = tid & 3;
    float ss = 0.f;
#pragma unroll
    for (int i = 0; i < K / 32; ++i) { *(U4*)(As + row * RS_ + (pc + 4 * i) * 8) = ld.a[i]; *(U4*)(Bs + row * RS_ + (pc + 4 * i) * 8) = ld.b[i];
#pragma unroll
        for (int q = 0; q < 4; ++q) { const float lo = bf2f((bf16_t)(ld.a[i][q] & 0xFFFF)), hi = bf2f((bf16_t)(ld.a[i][q] >> 16)); ss += lo * lo + hi * hi; } }
    ss += __shfl_xor(ss, 1); ss += __shfl_xor(ss, 2);
    if (pc == 0) rs[row] = rsqrtf(ss / K + EPS);
}
template <int K> DEV void up_mma(f32x4 (&acc)[4][2], const char* smem, bool tr) {
    constexpr int RS_ = K + 8;
    const bf16_t* As = (const bf16_t*)smem; const bf16_t* Bs = As + 128 * RS_;
    const int tid = ltid(), lane = tid & 63, wave = tid >> 6, wr = wave >> 2, wc = wave & 3;
    acc_zero(acc);
    if (tr) {
#pragma unroll
        for (int kk = 0; kk < K / 32; ++kk) { bf16x8 a[4], b[2];
#pragma unroll
            for (int mi = 0; mi < 4; ++mi) a[mi] = *(const bf16x8*)(As + (wr * 64 + mi * 16 + (lane & 15)) * RS_ + kk * 32 + (lane >> 4) * 8);
#pragma unroll
            for (int ni = 0; ni < 2; ++ni) b[ni] = *(const bf16x8*)(Bs + (wc * 32 + ni * 16 + (lane & 15)) * RS_ + kk * 32 + (lane >> 4) * 8);
#pragma unroll
            for (int mi = 0; mi < 4; ++mi)
#pragma unroll
                for (int ni = 0; ni < 2; ++ni) acc[mi][ni] = __builtin_amdgcn_mfma_f32_16x16x32_bf16(b[ni], a[mi], acc[mi][ni], 0, 0, 0); }
    } else {
#pragma unroll
        for (int kk = 0; kk < K / 32; ++kk) { bf16x8 a[4], b[2];
#pragma unroll
            for (int mi = 0; mi < 4; ++mi) a[mi] = *(const bf16x8*)(As + (wr * 64 + mi * 16 + (lane & 15)) * RS_ + kk * 32 + (lane >> 4) * 8);
#pragma unroll
            for (int ni = 0; ni < 2; ++ni) b[ni] = *(const bf16x8*)(Bs + (wc * 32 + ni * 16 + (lane & 15)) * RS_ + kk * 32 + (lane >> 4) * 8);
#pragma unroll
            for (int mi = 0; mi < 4; ++mi)
#pragma unroll
                for (int ni = 0; ni < 2; ++ni) acc[mi][ni] = __builtin_amdgcn_mfma_f32_16x16x32_bf16(a[mi], b[ni], acc[mi][ni], 0, 0, 0); }
    }
}
DEV void p3_qup_epilogue(const Ctx& c, const f32x4 (&acc)[4][2], int m0, int tn) {
    const int n0 = tn * 128;
    const int tid = ltid(), lane = tid & 63, wave = tid >> 6, wr = wave >> 2, wc = wave & 3, q4 = lane >> 4;
    const float* rs = (const float*)(c.smem + UP_RS_OFF);
    const int b = m0 / NTOK, pbase = m0 % NTOK;
    const int cb = n0 + wc * 32;
    const int hh = cb / 96, wofs = cb % 96;
    bf16_t* Q = (bf16_t*)(c.ws() + WS_MQ) + ((size_t)b * 4 + hh) * NTOK * 96;
    const float qscale = 0.10206207261596575f * 1.4426950408889634f;
    float invf[4];
#pragma unroll
    for (int j = 0; j < 4; ++j) invf[j] = __expf(-(float)(((q4 & 1) * 4 + j)) * (9.210340371976184f / 8.0f));
#pragma unroll
    for (int mi = 0; mi < 4; ++mi) {
        const int rl = wr * 64 + mi * 16 + (lane & 15), p = pbase + rl;
        const float r = rs[rl] * qscale;
        float v0[4], v1[4];
#pragma unroll
        for (int j = 0; j < 4; ++j) { v0[j] = acc[mi][0][j] * r; v1[j] = acc[mi][1][j] * r; }
        if (wofs == 64 && p >= CTX_LEN) {
            const int t = p - CTX_LEN; const float pos = (float)((q4 < 2) ? (t / GRID_W) : (t % GRID_W));
#pragma unroll
            for (int j = 0; j < 4; ++j) { const float ang = pos * invf[j], cs = __cosf(ang), sn = __sinf(ang);
                const float o0 = v0[j] * cs - v1[j] * sn, o1 = v0[j] * sn + v1[j] * cs; v0[j] = o0; v1[j] = o1; }
        }
        U2 w0, w1; w0.x = pack2(v0[0], v0[1]); w0.y = pack2(v0[2], v0[3]); w1.x = pack2(v1[0], v1[1]); w1.y = pack2(v1[2], v1[3]);
        *(U2*)(Q + (size_t)p * 96 + wofs + q4 * 4) = w0; *(U2*)(Q + (size_t)p * 96 + wofs + 16 + q4 * 4) = w1;
    }
}
DEV void p3_kvup_epilogue(const Ctx& c, const f32x4 (&acc)[4][2], int m0, int tn) {
    const int tid = ltid(), lane = tid & 63, wave = tid >> 6, wr = wave >> 2, wc = wave & 3, q4 = lane >> 4;
    const float* rs = (const float*)(c.smem + UP_RS_OFF);
    const int b = m0 / NTOK, pbase = m0 % NTOK, hh = tn;
    bf16_t* Kp = (bf16_t*)(c.ws() + WS_MK) + ((size_t)b * 4 + hh) * NTOK * 96;
    bf16_t* Vt = (bf16_t*)(c.ws() + WS_MVT) + ((size_t)b * 4 + hh) * 64 * NTOK;
    if (wc < 2) {
#pragma unroll
        for (int mi = 0; mi < 4; ++mi) { const int rl = wr * 64 + mi * 16 + (lane & 15); const float r = rs[rl];
#pragma unroll
            for (int ni = 0; ni < 2; ++ni) { U2 pk; pk.x = pack2(acc[mi][ni][0] * r, acc[mi][ni][1] * r); pk.y = pack2(acc[mi][ni][2] * r, acc[mi][ni][3] * r);
                *(U2*)(Kp + (size_t)(pbase + rl) * 96 + wc * 32 + ni * 16 + q4 * 4) = pk; } }
    } else {
#pragma unroll
        for (int ni = 0; ni < 2; ++ni) { const int cl = wc * 32 + ni * 16 + (lane & 15);
#pragma unroll
            for (int mi = 0; mi < 4; ++mi) { const int rl0 = wr * 64 + mi * 16 + q4 * 4;
                U2 pk; pk.x = pack2(acc[mi][ni][0] * rs[rl0], acc[mi][ni][1] * rs[rl0 + 1]); pk.y = pack2(acc[mi][ni][2] * rs[rl0 + 2], acc[mi][ni][3] * rs[rl0 + 3]);
                *(U2*)(Vt + (size_t)(cl - 64) * NTOK + pbase + rl0) = pk; } }
    }
}
template <bool Q> DEV void p3_up_range(const Ctx& c, int r, int n, int G, bool ctxo) {
    constexpr int K = Q ? 256 : 128, NT = Q ? 3 : 4;
    const int l = c.layer;
    const bf16_t* A = (const bf16_t*)(c.ws() + WS_Z) + (Q ? ZDQ : ZDKV);
    const bf16_t* Bt = Q ? (const bf16_t*)(c.ws() + WS_WUQ) + (size_t)l * 384 * 256 : (const bf16_t*)(c.ws() + WS_WUKV) + (size_t)l * 512 * 128;
    int m0 = Q ? (ctxo ? (r / NT) * 128 : lat_tile_m0(r / NT)) : (r / NT) * 128, tn = r % NT;
    UpLd<K> cur = up_load<K>(A + (size_t)m0 * D_IN_PAD, Bt + (size_t)tn * 128 * K);
    for (;;) {
        __syncthreads();
        up_stage<K>(c.smem, cur);
        __syncthreads();
        const int rn = r + G; const bool more = rn < n; const int rx = more ? rn : r;
        const int m0n = Q ? (ctxo ? (rx / NT) * 128 : lat_tile_m0(rx / NT)) : (rx / NT) * 128, tnn = rx % NT;
        const UpLd<K> nxt = up_load<K>(A + (size_t)m0n * D_IN_PAD, Bt + (size_t)tnn * 128 * K);
        SCHED_FENCE();
        f32x4 acc[4][2];
        const bool tr = Q || ((ltid() >> 6) & 3) < 2;
        up_mma<K>(acc, c.smem, tr);
        if (Q) p3_qup_epilogue(c, acc, m0, tn); else p3_kvup_epilogue(c, acc, m0, tn);
        if (!more) break;
        SCHED_FENCE();
        cur = nxt; r = rn; m0 = m0n; tn = tnn;
    }
}
DEV void p3_krope_item(const Ctx& c, int item, bf16_t zj, bf16_t zo) {
    const int tid = ltid(), grow = item * 16 + (tid >> 5), j = tid & 31;
    const int b = grow / NTOK, p = grow % NTOK;
    float v = bf2f(zj);
    if (p >= CTX_LEN) {
        const float other = bf2f(zo);
        const int t = p - CTX_LEN; const float pos = (float)(((j & 15) < 8) ? (t / GRID_W) : (t % GRID_W));
        const float invf = __expf(-(float)(j & 7) * (9.210340371976184f / 8.0f));
        const float ang = pos * invf, cs = __cosf(ang), sn = __sinf(ang);
        v = (j < 16) ? (v * cs - other * sn) : (other * sn + v * cs);
    }
    const bf16_t o = f2bf(v);
#pragma unroll
    for (int hh = 0; hh < 4; ++hh) ((bf16_t*)(c.ws() + WS_MK))[(((size_t)b * 4 + hh) * NTOK + p) * 96 + 64 + j] = o;
}

DEV int xcd_item(int m, int nbh, int nqb) {
    const int xcd = m & 7, slot = m >> 3, bh = xcd * (nbh >> 3) + slot / nqb, qb = slot % nqb; return bh * nqb + qb;
}
static_assert((BATCH * 4) % 8 == 0, "xcd item map");
typedef float f32x16 __attribute__((ext_vector_type(16)));
typedef short bf16x4 __attribute__((ext_vector_type(4)));
constexpr int NA_LAT_ITEMS = BATCH * 4 * (ROWS / 4), NA_CTX_ITEMS = BATCH * 4 * (CTX_LEN / 256);
constexpr int NA_TB = 64 * GS * 2, NA_BUF = 2 * NA_TB;
static_assert(ROWS % 4 == 0, "na rows");
DEV int na_rs(int r) { int rs = r - 4; return rs < 0 ? 0 : (rs > ROWS - 8 ? ROWS - 8 : rs); }
#ifdef EMU
#define NA_PIN(x)
#else
#define NA_PIN(x) asm volatile("" : "+v"(x))
#endif
template <int H> DEV void na_local_step(const f32x16 (&st)[2], const float* rrow, int cs, int lh, int lr, float& m, float& lsum, f32x16 (&o)[2], const bf16_t* vb) {
    constexpr int TF = H, TP = 1 - H, KP0 = H ? 12 : 0;
    const float SCL = 0.125f * 1.4426950408889634f;
    float sv[16], sp[4]; float mx = -1e30f;
    int base = cs - 4 * lh;
#ifndef EMU
    asm volatile("" : "+v"(base));
#endif
    const float* rb = rrow + 4 * lh;
    float bs[20];
#pragma unroll
    for (int k = 0; k < 16; ++k) bs[k] = rb[TF * 32 + (k & 3) + 8 * (k >> 2)];
#pragma unroll
    for (int q = 0; q < 4; ++q) bs[16 + q] = rb[TP * 32 + ((KP0 + q) & 3) + 8 * ((KP0 + q) >> 2)];
#pragma unroll
    for (int k = 0; k < 20; ++k) NA_PIN(bs[k]);
#pragma unroll
    for (int k = 0; k < 16; ++k) { const int kk = TF * 32 + (k & 3) + 8 * (k >> 2);
        const bool valid = (unsigned)(kk - base) < 16u;
        const float v = valid ? st[TF][k] * SCL + bs[k] : -1e30f; sv[k] = v; mx = fmaxf(mx, v); }
#pragma unroll
    for (int q = 0; q < 4; ++q) { const int k = KP0 + q; const int kk = TP * 32 + (k & 3) + 8 * (k >> 2);
        const bool valid = (unsigned)(kk - base) < 16u;
        const float v = valid ? st[TP][k] * SCL + bs[16 + q] : -1e30f; sp[q] = v; mx = fmaxf(mx, v); }
    mx = fmaxf(mx, __shfl_xor(mx, 32));
    const float mn = fmaxf(m, mx), alpha = fast_exp2(m - mn); m = mn;
    float rsum = 0.f; bf16x8 pfF[2], pfP;
#pragma unroll
    for (int s2 = 0; s2 < 2; ++s2) { U4 pk;
#pragma unroll
        for (int j = 0; j < 4; ++j) { const float p0 = fast_exp2(sv[s2 * 8 + 2 * j] - mn), p1 = fast_exp2(sv[s2 * 8 + 2 * j + 1] - mn); rsum += p0 + p1; pk[j] = cvt_pk_bf16(p0, p1); }
        pfF[s2] = __builtin_bit_cast(bf16x8, pk); }
    { const float e0 = fast_exp2(sp[0] - mn), e1 = fast_exp2(sp[1] - mn), e2 = fast_exp2(sp[2] - mn), e3 = fast_exp2(sp[3] - mn); rsum += (e0 + e1) + (e2 + e3);
      U4 pk; pk.x = 0u; pk.y = 0u; pk.z = 0u; pk.w = 0u;
      if (H == 0) { pk.x = cvt_pk_bf16(e0, e1); pk.y = cvt_pk_bf16(e2, e3); } else { pk.z = cvt_pk_bf16(e0, e1); pk.w = cvt_pk_bf16(e2, e3); }
      pfP = __builtin_bit_cast(bf16x8, pk); }
    lsum = lsum * alpha + rsum;
    if (__ballot(alpha != 1.0f) != 0ull) {
#pragma unroll
        for (int k = 0; k < 16; ++k) { o[0][k] *= alpha; o[1][k] *= alpha; } }
#pragma unroll
    for (int u = 0; u < 3; ++u) { const int ks = (u < 2) ? TF * 2 + u : TP * 2 + (H ? 1 : 0); const bf16x8 pf = (u == 0) ? pfF[0] : (u == 1) ? pfF[1] : pfP;
#pragma unroll
        for (int dt = 0; dt < 2; ++dt) { const bf16_t* vp = vb + (dt * 32 + lr) * GS + ks * 16 + lh * 4;
            const bf16x4 v0 = *(const bf16x4*)vp, v1 = *(const bf16x4*)(vp + 8);
            bf16x8 a; a[0] = v0[0]; a[1] = v0[1]; a[2] = v0[2]; a[3] = v0[3]; a[4] = v1[0]; a[5] = v1[1]; a[6] = v1[2]; a[7] = v1[3];
            o[dt] = __builtin_amdgcn_mfma_f32_32x32x16_bf16(a, pf, o[dt], 0, 0, 0); } }
}
DEV void p3_na_item(const Ctx& c, int item) {
    const int tid = ltid(), lane = tid & 63, wv = tid >> 6, lr = lane & 31, lh = lane >> 5, l = c.layer;
    const bf16_t* Z = (const bf16_t*)(c.ws() + WS_Z);
    int b, hh, q0, r = 0, rs = 0, qcol = 0, wlo = 0, nloc = 0; bool lat;
    if (item < NA_LAT_ITEMS) { lat = true; item = xcd_item(item, BATCH * 4, ROWS / 4); const int rg = item % (ROWS / 4); hh = (item / (ROWS / 4)) & 3; b = item / (ROWS / 4) / 4;
        r = rg * 4 + (wv >> 1); rs = na_rs(r); wlo = na_rs(rg * 4); nloc = na_rs(rg * 4 + 3) + 8 - wlo; q0 = CTX_LEN + r * GRID_W + (wv & 1) * 32; qcol = (wv & 1) * 32 + lr; }
    else { lat = false; const int it = item - NA_LAT_ITEMS; const int qb = it % (CTX_LEN / 256); hh = (it / (CTX_LEN / 256)) & 3; b = it / (CTX_LEN / 256) / 4; q0 = qb * 256 + wv * 32; }
    const size_t tok0 = (size_t)b * NTOK;
    bf16x8 q[4];
#pragma unroll
    for (int ks = 0; ks < 4; ++ks) q[ks] = *(const bf16x8*)(Z + (tok0 + q0 + lr) * ZS + ZQA + hh * 64 + ks * 16 + lh * 8);
    const bf16_t* Kg = Z + tok0 * ZS + ZKA + hh * 64;
    const bf16_t* Vg = (const bf16_t*)(c.ws() + WS_NAVT) + ((size_t)b * 4 + hh) * 64 * NTOK;
    float* rpb = (float*)(c.smem + 2 * NA_BUF);
    const int nstep = nloc + CTX_LEN / 64;
    const int sr = tid >> 3, sc8 = (tid & 7) * 8;
#define NA_TOK(i) ((i) < nloc ? CTX_LEN + (wlo + (i)) * GRID_W : ((i) - nloc) * 64)
    U4 rk, rv;
    { const int t0 = NA_TOK(0); rk = *(const U4*)(Kg + (size_t)(t0 + sr) * ZS + sc8); rv = *(const U4*)(Vg + (size_t)sr * NTOK + t0 + sc8); }
    __syncthreads();
    { bf16_t* kb = (bf16_t*)c.smem; bf16_t* vb = (bf16_t*)(c.smem + NA_TB); *(U4*)(kb + sr * GS + sc8) = rk; *(U4*)(vb + sr * GS + sc8) = rv;
      if (tid < 15 * 31) rpb[tid] = c.in(I_RPB)[((size_t)l * 4 + hh) * 15 * 31 + tid] * 1.4426950408889634f; }
    __syncthreads();
    f32x16 o[2]; float m = -1e30f, lsum = 0.f;
#pragma unroll
    for (int i = 0; i < 16; ++i) { o[0][i] = 0.f; o[1][i] = 0.f; }
    int cs = qcol - 8; cs = cs < 0 ? 0 : (cs > GRID_W - 16 ? GRID_W - 16 : cs);
    for (int i = 0; i < nstep; ++i) {
        const bf16_t* kb = (const bf16_t*)(c.smem + (i & 1) * NA_BUF); const bf16_t* vb = (const bf16_t*)(c.smem + (i & 1) * NA_BUF + NA_TB);
        if (i + 1 < nstep) { const int t1 = NA_TOK(i + 1); rk = *(const U4*)(Kg + (size_t)(t1 + sr) * ZS + sc8); rv = *(const U4*)(Vg + (size_t)sr * NTOK + t1 + sc8); }
        const bool local = i < nloc; const int wrow = wlo + i;
        if (!local || (lat && wrow >= rs && wrow < rs + 8)) {
            f32x16 st[2];
#pragma unroll
            for (int t = 0; t < 2; ++t) {
#pragma unroll
                for (int k = 0; k < 16; ++k) st[t][k] = 0.f;
#pragma unroll
                for (int ks = 0; ks < 4; ++ks) { const bf16x8 a = *(const bf16x8*)(kb + (t * 32 + lr) * GS + ks * 16 + lh * 8); st[t] = __builtin_amdgcn_mfma_f32_32x32x16_bf16(a, q[ks], st[t], 0, 0, 0); }
            }
            if (local) {
                const float* rrow = rpb + (wrow - r + 7) * 31 - qcol + 15;
                if ((__builtin_amdgcn_readfirstlane(wv) & 1) == 0) na_local_step<0>(st, rrow, cs, lh, lr, m, lsum, o, vb); else na_local_step<1>(st, rrow, cs, lh, lr, m, lsum, o, vb);
            } else {
                const float SCL = 0.125f * 1.4426950408889634f;
                float mx = -1e30f;
#pragma unroll
                for (int t = 0; t < 2; ++t)
#pragma unroll
                    for (int k = 0; k < 16; ++k) { const float v = st[t][k] * SCL; st[t][k] = v; mx = fmaxf(mx, v); }
                mx = fmaxf(mx, __shfl_xor(mx, 32));
                const float mn = fmaxf(m, mx), alpha = fast_exp2(m - mn); m = mn;
                float rsum = 0.f; bf16x8 pf[4];
#pragma unroll
                for (int t = 0; t < 2; ++t)
#pragma unroll
                    for (int s2 = 0; s2 < 2; ++s2) { U4 pk;
#pragma unroll
                        for (int j = 0; j < 4; ++j) { const float p0 = fast_exp2(st[t][s2 * 8 + 2 * j] - mn), p1 = fast_exp2(st[t][s2 * 8 + 2 * j + 1] - mn); rsum += p0 + p1; pk[j] = cvt_pk_bf16(p0, p1); }
                        pf[t * 2 + s2] = __builtin_bit_cast(bf16x8, pk); }
                lsum = lsum * alpha + rsum;
                if (__ballot(alpha != 1.0f) != 0ull) {
#pragma unroll
                    for (int k = 0; k < 16; ++k) { o[0][k] *= alpha; o[1][k] *= alpha; } }
#pragma unroll
                for (int ks = 0; ks < 4; ++ks)
#pragma unroll
                    for (int dt = 0; dt < 2; ++dt) { const bf16_t* vp = vb + (dt * 32 + lr) * GS + ks * 16 + lh * 4;
                        const bf16x4 v0 = *(const bf16x4*)vp, v1 = *(const bf16x4*)(vp + 8);
                        bf16x8 a; a[0] = v0[0]; a[1] = v0[1]; a[2] = v0[2]; a[3] = v0[3]; a[4] = v1[0]; a[5] = v1[1]; a[6] = v1[2]; a[7] = v1[3];
                        o[dt] = __builtin_amdgcn_mfma_f32_32x32x16_bf16(a, pf[ks], o[dt], 0, 0, 0); }
            }
        }
        if (i + 1 < nstep) { bf16_t* kn = (bf16_t*)(c.smem + ((i + 1) & 1) * NA_BUF); bf16_t* vn = (bf16_t*)(c.smem + ((i + 1) & 1) * NA_BUF + NA_TB); *(U4*)(kn + sr * GS + sc8) = rk; *(U4*)(vn + sr * GS + sc8) = rv; }
        __syncthreads();
    }
#undef NA_TOK
    const float inv = 1.0f / (lsum + __shfl_xor(lsum, 32));
    bf16_t* out = (bf16_t*)(c.ws() + WS_OCAT) + (tok0 + q0 + lr) * 1024 + hh * 64;
#pragma unroll
    for (int dt = 0; dt < 2; ++dt)
#pragma unroll
        for (int rg = 0; rg < 4; ++rg) { U2 w; w.x = pack2(o[dt][rg * 4 + 0] * inv, o[dt][rg * 4 + 1] * inv); w.y = pack2(o[dt][rg * 4 + 2] * inv, o[dt][rg * 4 + 3] * inv);
            *(U2*)(out + dt * 32 + rg * 8 + lh * 4) = w; }
}
constexpr int MLA_KS = 104, MLA_VS = 72;
constexpr int MLA_KBYTES = 64 * MLA_KS * 2, MLA_VBYTES = 64 * MLA_VS * 2, MLA_BUF = MLA_KBYTES + MLA_VBYTES;
constexpr int MLA_LAT_ITEMS = BATCH * 4 * (SEQ / 256), MLA_CTX_ITEMS = BATCH * 4 * (CTX_LEN / 256);
DEV void p4_mla_item(const Ctx& c, int item) {
    const int tid = ltid(), lane = tid & 63, wv = tid >> 6, lr = lane & 31, lh = lane >> 5;
    int b, hh, q0, nkeys;
    if (item < MLA_LAT_ITEMS) { item = xcd_item(item, BATCH * 4, SEQ / 256); const int qb = item % (SEQ / 256); hh = (item / (SEQ / 256)) & 3; b = item / (SEQ / 256) / 4; q0 = CTX_LEN + qb * 256; nkeys = NTOK; }
    else { const int it = item - MLA_LAT_ITEMS; const int qb = it % (CTX_LEN / 256); hh = (it / (CTX_LEN / 256)) & 3; b = it / (CTX_LEN / 256) / 4; q0 = qb * 256; nkeys = CTX_LEN; }
    const bf16_t* Q = (const bf16_t*)(c.ws() + WS_MQ) + ((size_t)b * 4 + hh) * NTOK * 96;
    const bf16_t* K = (const bf16_t*)(c.ws() + WS_MK) + ((size_t)b * 4 + hh) * NTOK * 96;
    const bf16_t* Vt = (const bf16_t*)(c.ws() + WS_MVT) + ((size_t)b * 4 + hh) * 64 * NTOK;
    bf16x8 q[6];
#pragma unroll
    for (int ks = 0; ks < 6; ++ks) q[ks] = *(const bf16x8*)(Q + (size_t)(q0 + wv * 32 + lr) * 96 + ks * 16 + lh * 8);
    const int kr0 = tid / 12, kc0 = (tid % 12) * 8, kr1 = (512 + tid) / 12, kc1 = ((512 + tid) % 12) * 8, vr = tid >> 3, vc = (tid & 7) * 8;
    U4 rk0, rk1, rv;
    rk0 = *(const U4*)(K + (size_t)kr0 * 96 + kc0); if (tid < 256) rk1 = *(const U4*)(K + (size_t)kr1 * 96 + kc1); rv = *(const U4*)(Vt + (size_t)vr * NTOK + vc);
    __syncthreads();
    { bf16_t* kb = (bf16_t*)c.smem; bf16_t* vb = (bf16_t*)(c.smem + MLA_KBYTES);
      *(U4*)(kb + kr0 * MLA_KS + kc0) = rk0; if (tid < 256) *(U4*)(kb + kr1 * MLA_KS + kc1) = rk1; *(U4*)(vb + vr * MLA_VS + vc) = rv; }
    __syncthreads();
    f32x16 o[2]; float m = -1e30f, lsum = 0.f;
#pragma unroll
    for (int i = 0; i < 16; ++i) { o[0][i] = 0.f; o[1][i] = 0.f; }
    const int ntile = nkeys / 64;
    for (int kt = 0; kt < ntile; ++kt) {
        const bf16_t* kb = (const bf16_t*)(c.smem + (kt & 1) * MLA_BUF); const bf16_t* vb = (const bf16_t*)(c.smem + (kt & 1) * MLA_BUF + MLA_KBYTES);
        if (kt + 1 < ntile) { const int t1 = (kt + 1) * 64;
            rk0 = *(const U4*)(K + (size_t)(t1 + kr0) * 96 + kc0); if (tid < 256) rk1 = *(const U4*)(K + (size_t)(t1 + kr1) * 96 + kc1); rv = *(const U4*)(Vt + (size_t)vr * NTOK + t1 + vc); }
        f32x16 st[2];
#pragma unroll
        for (int t = 0; t < 2; ++t) {
#pragma unroll
            for (int i = 0; i < 16; ++i) st[t][i] = 0.f;
#pragma unroll
            for (int ks = 0; ks < 6; ++ks) { const bf16x8 a = *(const bf16x8*)(kb + (t * 32 + lr) * MLA_KS + ks * 16 + lh * 8); st[t] = __builtin_amdgcn_mfma_f32_32x32x16_bf16(a, q[ks], st[t], 0, 0, 0); }
        }
        float mx = st[0][0];
#pragma unroll
        for (int t = 0; t < 2; ++t)
#pragma unroll
            for (int i = 0; i < 16; ++i) mx = fmaxf(mx, st[t][i]);
        mx = fmaxf(mx, __shfl_xor(mx, 32));
        const float mn = fmaxf(m, mx), alpha = fast_exp2(m - mn); m = mn;
        float rs = 0.f;
        bf16x8 pf[4];
#pragma unroll
        for (int t = 0; t < 2; ++t)
#pragma unroll
            for (int s2 = 0; s2 < 2; ++s2) { U4 pk;
#pragma unroll
                for (int j = 0; j < 4; ++j) { const float p0 = fast_exp2(st[t][s2 * 8 + 2 * j] - mn), p1 = fast_exp2(st[t][s2 * 8 + 2 * j + 1] - mn); rs += p0 + p1; pk[j] = cvt_pk_bf16(p0, p1); }
                pf[t * 2 + s2] = __builtin_bit_cast(bf16x8, pk); }
        lsum = lsum * alpha + rs;
        if (__ballot(alpha != 1.0f) != 0ull) {
#pragma unroll
            for (int i = 0; i < 16; ++i) { o[0][i] *= alpha; o[1][i] *= alpha; } }
#pragma unroll
        for (int ks = 0; ks < 4; ++ks)
#pragma unroll
            for (int dt = 0; dt < 2; ++dt) {
                const bf16_t* vp = vb + (dt * 32 + lr) * MLA_VS + ks * 16 + lh * 4;
                const bf16x4 v0 = *(const bf16x4*)vp, v1 = *(const bf16x4*)(vp + 8);
                bf16x8 a; a[0] = v0[0]; a[1] = v0[1]; a[2] = v0[2]; a[3] = v0[3]; a[4] = v1[0]; a[5] = v1[1]; a[6] = v1[2]; a[7] = v1[3];
                o[dt] = __builtin_amdgcn_mfma_f32_32x32x16_bf16(a, pf[ks], o[dt], 0, 0, 0);
            }
        if (kt + 1 < ntile) { bf16_t* kn = (bf16_t*)(c.smem + ((kt + 1) & 1) * MLA_BUF); bf16_t* vn = (bf16_t*)(c.smem + ((kt + 1) & 1) * MLA_BUF + MLA_KBYTES);
            *(U4*)(kn + kr0 * MLA_KS + kc0) = rk0; if (tid < 256) *(U4*)(kn + kr1 * MLA_KS + kc1) = rk1; *(U4*)(vn + vr * MLA_VS + vc) = rv; }
        __syncthreads();
    }
    const float inv = 1.0f / (lsum + __shfl_xor(lsum, 32));
    bf16_t* out = (bf16_t*)(c.ws() + WS_OCAT) + ((size_t)b * NTOK + q0 + wv * 32 + lr) * 1024 + 256 + hh * 64;
#pragma unroll
    for (int dt = 0; dt < 2; ++dt)
#pragma unroll
        for (int rg = 0; rg < 4; ++rg) { U2 w; w.x = pack2(o[dt][rg * 4 + 0] * inv, o[dt][rg * 4 + 1] * inv); w.y = pack2(o[dt][rg * 4 + 2] * inv, o[dt][rg * 4 + 3] * inv);
            *(U2*)(out + dt * 32 + rg * 8 + lh * 4) = w; }
}

constexpr int BCS = 65, BCD = 64 * BCS;
constexpr int GL_B = 0;
constexpr int GL_X0 = 33280;
static_assert(2 * BCD * 4 <= GL_X0 && GL_X0 % 16 == 0, "bc");
struct GateLd { U4 bh, bl, a0, a1, a2, a3; float bias; };
DEV GateLd gla_gates_load(const Ctx& c, int b, int hh, int ch) {
    const int tid = ltid(), lane = tid & 63, wv = tid >> 6, l = c.layer, lr = lane & 15, q4 = lane >> 4;
    const int dir = wv >> 2, dblk = (wv & 3) * 16;
    const bf16_t* Z = (const bf16_t*)(c.ws() + WS_Z) + ((size_t)b * NTOK + ch * 64) * ZS + (dir == 0 ? ZAF : ZAB);
    const bf16_t* wt = (const bf16_t*)(c.ws() + WS_WGT) + ((size_t)(l * 2 + dir) * 2 * 256 + hh * 64 + dblk + lr) * 16;
    const int qc = q4 & 1;
    GateLd g;
    g.bh = *(const U4*)(wt + qc * 8); g.bl = *(const U4*)(wt + 256 * 16 + qc * 8);
    g.a0 = *(const U4*)(Z + (size_t)(0 * 16 + lr) * ZS + qc * 8); g.a1 = *(const U4*)(Z + (size_t)(1 * 16 + lr) * ZS + qc * 8);
    g.a2 = *(const U4*)(Z + (size_t)(2 * 16 + lr) * ZS + qc * 8); g.a3 = *(const U4*)(Z + (size_t)(3 * 16 + lr) * ZS + qc * 8);
    const float* pf = c.in(I_BAF); const float* pb = c.in(I_BAB);
    g.bias = (dir == 0 ? pf : pb)[l * 256 + hh * 64 + dblk + lr];
    return g;
}
DEV void gla_gates_compute(const Ctx& c, const GateLd& g) {
    const int tid = ltid(), lane = tid & 63, wv = tid >> 6, lr = lane & 15, q4 = lane >> 4;
    const int dir = wv >> 2, dblk = (wv & 3) * 16;
    float* bc = (float*)(c.smem + GL_B);
    const uint32_t kmask = q4 < 2 ? 0xFFFFFFFFu : 0u;
    const float bias = g.bias;
    U4 ar[4]; ar[0] = g.a0; ar[1] = g.a1; ar[2] = g.a2; ar[3] = g.a3;
    const U4 bhr = g.bh & kmask, blr = g.bl & kmask;
    const bf16x8 bh = __builtin_bit_cast(bf16x8, bhr), bl = __builtin_bit_cast(bf16x8, blr);
    f32x4 z[4];
#pragma unroll
    for (int mt = 0; mt < 4; ++mt) { const bf16x8 a = __builtin_bit_cast(bf16x8, ar[mt] & kmask);
        z[mt] = f32x4{bias, bias, bias, bias};
        z[mt] = __builtin_amdgcn_mfma_f32_16x16x32_bf16(a, bh, z[mt], 0, 0, 0); z[mt] = __builtin_amdgcn_mfma_f32_16x16x32_bf16(a, bl, z[mt], 0, 0, 0); }
    float S[4];
#pragma unroll
    for (int mt = 0; mt < 4; ++mt) { S[mt] = 0.f;
#pragma unroll
        for (int j = 0; j < 4; ++j) { const float x = z[mt][j]; const float g = (fminf(x, 0.0f) - __logf(1.0f + __expf(-fabsf(x)))) * (1.0f / 16.0f); z[mt][j] = g; S[mt] += g; } }
    float off[4];
    { float x1[4], x2[4], x3[4], T[4];
#pragma unroll
      for (int mt = 0; mt < 4; ++mt) { x1[mt] = __shfl_xor(S[mt], 16); x2[mt] = __shfl_xor(S[mt], 32); x3[mt] = __shfl_xor(S[mt], 48); T[mt] = S[mt] + x1[mt] + x2[mt] + x3[mt]; }
#pragma unroll
      for (int mt = 0; mt < 4; ++mt) {
          float o;
          if (dir == 0) { o = ((q4 & 1) ? x1[mt] : 0.f) + ((q4 & 2) ? x2[mt] + x3[mt] : 0.f);
#pragma unroll
              for (int m2 = 0; m2 < 4; ++m2) if (m2 < mt) o += T[m2]; }
          else { o = ((q4 & 1) ? 0.f : x1[mt]) + ((q4 & 2) ? 0.f : x2[mt] + x3[mt]);
#pragma unroll
              for (int m2 = 0; m2 < 4; ++m2) if (m2 > mt) o += T[m2]; }
          off[mt] = o; } }
    __syncthreads();
#pragma unroll
    for (int mt = 0; mt < 4; ++mt) {
        float run = off[mt];
        if (dir == 0) {
#pragma unroll
            for (int j = 0; j < 4; ++j) { run += z[mt][j]; bc[(mt * 16 + q4 * 4 + j) * BCS + dblk + lr] = run; }
        } else {
#pragma unroll
            for (int j = 3; j >= 0; --j) { run += z[mt][j]; bc[BCD + (mt * 16 + q4 * 4 + j) * BCS + dblk + lr] = run; }
        }
    }
    __syncthreads();
}
constexpr int G1_ITEMS = BATCH * 4 * NCH;
struct G1Pre { GateLd gl; U4 kraw; };
DEV G1Pre g1_prefetch(const Ctx& c, int item) {
    const int ch = item % NCH, hh = (item / NCH) & 3, b = item / NCH / 4; const int tid = ltid();
    G1Pre p; p.gl = gla_gates_load(c, b, hh, ch);
    p.kraw = *(const U4*)((const bf16_t*)(c.ws() + WS_Z) + ((size_t)b * NTOK + ch * 64 + (tid & 63)) * ZS + ZGK + hh * 64 + (tid >> 6) * 8);
    return p;
}
DEV void p3_gla_g1_body(const Ctx& c, int item, const G1Pre& cur, int nitem, G1Pre& nxt) {
    const int ch = item % NCH, hh = (item / NCH) & 3, b = item / NCH / 4;
    const int tid = ltid(), lane = tid & 63, wave = tid >> 6, lr = lane & 15, lq = lane >> 4;
    const bf16_t* Vt = (const bf16_t*)(c.ws() + WS_GVT) + ((size_t)b * 4 + hh) * 128 * NTOK + ch * 64;
    U4 vfr[2][8];
#pragma unroll
    for (int ks = 0; ks < 2; ++ks)
#pragma unroll
        for (int nt = 0; nt < 8; ++nt) vfr[ks][nt] = *(const U4*)(Vt + (size_t)(nt * 16 + lr) * NTOK + ks * 32 + lq * 8);
    nxt = g1_prefetch(c, nitem);
    const GateLd gl = cur.gl; const U4 kraw = cur.kraw;
    SCHED_FENCE();
    gla_gates_compute(c, gl);
    const float* bc = (const float*)(c.smem + GL_B);
    bf16_t* kte = (bf16_t*)(c.smem + GL_X0);
    { const int sI = tid & 63, d0 = (tid >> 6) * 8;
#pragma unroll
      for (int dir = 0; dir < 2; ++dir) {
          const float* bl = bc + dir * BCD + (dir == 0 ? 63 * BCS : 0) + d0; const float* bs = bc + dir * BCD + sI * BCS + d0;
#pragma unroll
          for (int i = 0; i < 8; ++i) { const float kv = bf2f((bf16_t)((i & 1) ? (kraw[i >> 1] >> 16) : (kraw[i >> 1] & 0xFFFF)));
              kte[(dir * 64 + d0 + i) * GS + sI] = f2bf(kv * __expf(bl[i] - bs[i])); } } }
    __syncthreads();
    const int dir = wave >> 2, mt = wave & 3;
    f32x4 acc[8];
#pragma unroll
    for (int nt = 0; nt < 8; ++nt) acc[nt] = f32x4{0.f, 0.f, 0.f, 0.f};
#pragma unroll
    for (int ks = 0; ks < 2; ++ks) {
        const bf16x8 a = *(const bf16x8*)(kte + (dir * 64 + mt * 16 + lr) * GS + ks * 32 + lq * 8);
#pragma unroll
        for (int nt = 0; nt < 8; ++nt) acc[nt] = __builtin_amdgcn_mfma_f32_16x16x32_bf16(a, __builtin_bit_cast(bf16x8, vfr[ks][nt]), acc[nt], 0, 0, 0);
    }
    bf16_t* KV = (bf16_t*)(c.ws() + WS_EXP + GLA_KV) + ((((size_t)b * 4 + hh) * 2 + dir) * NCH + ch) * 64 * 128;
#pragma unroll
    for (int nt = 0; nt < 8; ++nt) { U2 w; w.x = pack2(acc[nt][0], acc[nt][1]); w.y = pack2(acc[nt][2], acc[nt][3]); *(U2*)(KV + (size_t)(nt * 16 + lr) * 64 + mt * 16 + lq * 4) = w; }
    if (tid < 128) { int dr = tid >> 6, d = tid & 63; ((float*)(c.ws() + WS_EXP + GLA_DEC))[((((size_t)b * 4 + hh) * 2 + dr) * NCH + ch) * 64 + d] = __expf(dr == 0 ? bc[63 * BCS + d] : bc[BCD + d]); }
}
DEV void p3_gla_g1_range(const Ctx& c, int r, int n, int G) {
    G1Pre cur = g1_prefetch(c, r);
    for (;;) {
        const int rn = r + G; const bool more = rn < n;
        G1Pre nxt; p3_gla_g1_body(c, r, cur, more ? rn : r, nxt);
        if (!more) break;
        SCHED_FENCE();
        cur = nxt; r = rn;
    }
}
constexpr int G2_ITEMS = BATCH * 4 * 2 * 4;
DEV int gla_order_chunk(int dir, int i) { if (dir == 0) return i; return (i < NCC) ? (NCC - 1 - i) : (NCH - 1 - (i - NCC)); }
DEV void p4_gla_g2_item(const Ctx& c, int item) {
    const int vq = item & 3, seq = item >> 2, dir = seq & 1;
    const int tid = ltid(), v = vq * 32 + (tid >> 4), d0 = (tid & 15) * 4;
    const bf16_t* KV = (const bf16_t*)(c.ws() + WS_EXP + GLA_KV) + (size_t)seq * NCH * 64 * 128;
    const float* DEC = (const float*)(c.ws() + WS_EXP + GLA_DEC) + (size_t)seq * NCH * 64;
    bf16_t* SP = (bf16_t*)(c.ws() + WS_EXP + GLA_SP) + (size_t)seq * NCH * 64 * 128;
    f32x4 s = f32x4{0.f, 0.f, 0.f, 0.f};
    constexpr int HB = NCH / 2; static_assert(NCH % 2 == 0, "g2 batches");
#pragma unroll 1
    for (int half = 0; half < 2; ++half) {
        U2 kvr[HB]; f32x4 dec[HB];
#pragma unroll
        for (int i = 0; i < HB; ++i) { const int n = gla_order_chunk(dir, half * HB + i); kvr[i] = *(const U2*)(KV + ((size_t)n * 128 + v) * 64 + d0); dec[i] = *(const f32x4*)(DEC + n * 64 + d0); }
#pragma unroll
        for (int i = 0; i < HB; ++i) { const int n = gla_order_chunk(dir, half * HB + i);
            U2 pk; pk.x = pack2(s[0], s[1]); pk.y = pack2(s[2], s[3]);
            *(U2*)(SP + ((size_t)n * 128 + v) * 64 + d0) = pk;
            const f32x4 kv = f32x4{bf2f((bf16_t)(kvr[i].x & 0xFFFF)), bf2f((bf16_t)(kvr[i].x >> 16)), bf2f((bf16_t)(kvr[i].y & 0xFFFF)), bf2f((bf16_t)(kvr[i].y >> 16))};
            s = dec[i] * s + kv; }
    }
}
constexpr int G3_QD = GL_X0;
constexpr int G3_KD = G3_QD + 2 * 64 * GS * 2;
constexpr int G3_AM = G3_KD + 2 * 64 * GS * 2;
constexpr int G3_SS = G3_AM + 2 * 64 * GS * 2;
static_assert(G3_SS + 64 * 2 * 4 <= LDS_MISC, "lds");
struct G3Pre { GateLd gl; U4 qraw, kraw; };
DEV G3Pre g3_prefetch(const Ctx& c, int b, int hh, int ch) {
    const int tid = ltid();
    G3Pre p; p.gl = gla_gates_load(c, b, hh, ch);
    const bf16_t* Z = (const bf16_t*)(c.ws() + WS_Z) + ((size_t)b * NTOK + ch * 64) * ZS;
    p.qraw = *(const U4*)(Z + (size_t)(tid >> 3) * ZS + ZGQ + hh * 64 + (tid & 7) * 8); p.kraw = *(const U4*)(Z + (size_t)(tid >> 3) * ZS + ZGK + hh * 64 + (tid & 7) * 8);
    return p;
}
DEV void p5_gla_g3_body(const Ctx& c, int b, int hh, int ch, const G3Pre& cur, int bn, int hn, int cn, G3Pre& nxt) {
    const int tid = ltid(), lane = tid & 63, wave = tid >> 6, lr = lane & 15, lq = lane >> 4, l = c.layer;
    const size_t row0 = (size_t)b * NTOK + ch * 64;
    const bf16_t* Z = (const bf16_t*)(c.ws() + WS_Z) + row0 * ZS;
    const int tt = wave & 3, vb = (wave >> 2) * 4;
    U4 avr[2][4], asr[2][2][4];
    { const bf16_t* Vt = (const bf16_t*)(c.ws() + WS_GVT) + ((size_t)b * 4 + hh) * 128 * NTOK + ch * 64;
      const bf16_t* SP = (const bf16_t*)(c.ws() + WS_EXP + GLA_SP);
#pragma unroll
      for (int ks = 0; ks < 2; ++ks)
#pragma unroll
          for (int nt = 0; nt < 4; ++nt) avr[ks][nt] = *(const U4*)(Vt + (size_t)((vb + nt) * 16 + lr) * NTOK + ks * 32 + lq * 8);
#pragma unroll
      for (int dir = 0; dir < 2; ++dir) { const bf16_t* spd = SP + ((((size_t)b * 4 + hh) * 2 + dir) * NCH + ch) * 128 * 64;
#pragma unroll
          for (int ks = 0; ks < 2; ++ks)
#pragma unroll
              for (int nt = 0; nt < 4; ++nt) asr[dir][ks][nt] = *(const U4*)(spd + (size_t)((vb + nt) * 16 + lr) * 64 + ks * 32 + lq * 8); } }
    nxt = g3_prefetch(c, bn, hn, cn);
    const GateLd gl = cur.gl; const U4 qraw = cur.qraw, kraw = cur.kraw;
    SCHED_FENCE();
    gla_gates_compute(c, gl);
    const float* bc = (const float*)(c.smem + GL_B);
    bf16_t* qd = (bf16_t*)(c.smem + G3_QD); bf16_t* kd = (bf16_t*)(c.smem + G3_KD); bf16_t* am = (bf16_t*)(c.smem + G3_AM);
    float* ssq = (float*)(c.smem + G3_SS);
    { const int t = tid >> 3, d0 = (tid & 7) * 8;
#pragma unroll
      for (int dir = 0; dir < 2; ++dir) { const float* bp = bc + dir * BCD + t * BCS + d0; U4 qo, ko;
#pragma unroll
          for (int i = 0; i < 4; ++i) { const float e0 = __expf(bp[2 * i]), e1 = __expf(bp[2 * i + 1]);
              qo[i] = pack2(bf2f((bf16_t)(qraw[i] & 0xFFFF)) * 0.125f * e0, bf2f((bf16_t)(qraw[i] >> 16)) * 0.125f * e1);
              ko[i] = pack2(bf2f((bf16_t)(kraw[i] & 0xFFFF)) * fast_rcp(e0), bf2f((bf16_t)(kraw[i] >> 16)) * fast_rcp(e1)); }
          *(U4*)(qd + (dir * 64 + t) * GS + d0) = qo; *(U4*)(kd + (dir * 64 + t) * GS + d0) = ko; } }
    __syncthreads();
    { const int dir = wave >> 2, stl = wave & 3;
      f32x4 a4[4];
#pragma unroll
      for (int nt = 0; nt < 4; ++nt) a4[nt] = f32x4{0.f, 0.f, 0.f, 0.f};
#pragma unroll
      for (int ks = 0; ks < 2; ++ks) { const bf16x8 a = *(const bf16x8*)(kd + (dir * 64 + stl * 16 + lr) * GS + ks * 32 + lq * 8);
#pragma unroll
          for (int nt = 0; nt < 4; ++nt) { bf16x8 qf = *(const bf16x8*)(qd + (dir * 64 + nt * 16 + lr) * GS + ks * 32 + lq * 8); a4[nt] = __builtin_amdgcn_mfma_f32_16x16x32_bf16(a, qf, a4[nt], 0, 0, 0); } }
#pragma unroll
      for (int nt = 0; nt < 4; ++nt) { const int t = nt * 16 + lr, s0 = stl * 16 + lq * 4; float o[4];
#pragma unroll
          for (int j = 0; j < 4; ++j) { const int sI = s0 + j; const bool keep = (dir == 0) ? (sI <= t) : (sI >= t); o[j] = keep ? a4[nt][j] : 0.f; }
          U2 w; w.x = pack2(o[0], o[1]); w.y = pack2(o[2], o[3]); *(U2*)(am + (dir * 64 + t) * GS + s0) = w; } }
    __syncthreads();
    const float* on = c.in(I_ONORM) + l * 128;
    const bf16_t* ogp = Z + (size_t)(tt * 16 + lr) * ZS + ZOG + hh * 128;
    U2 ogr[4]; f32x4 g4r[4];
#pragma unroll
    for (int nt = 0; nt < 4; ++nt) { const int v0 = (vb + nt) * 16 + lq * 4; ogr[nt] = *(const U2*)(ogp + v0); g4r[nt] = *(const f32x4*)(on + v0); }
    f32x4 o[4];
#pragma unroll
    for (int nt = 0; nt < 4; ++nt) o[nt] = f32x4{0.f, 0.f, 0.f, 0.f};
#pragma unroll
    for (int dir = 0; dir < 2; ++dir) {
#pragma unroll
        for (int ks = 0; ks < 2; ++ks) {
            const bf16x8 ba = *(const bf16x8*)(am + (dir * 64 + tt * 16 + lr) * GS + ks * 32 + lq * 8);
            const bf16x8 bq = *(const bf16x8*)(qd + (dir * 64 + tt * 16 + lr) * GS + ks * 32 + lq * 8);
#pragma unroll
            for (int nt = 0; nt < 4; ++nt) {
                o[nt] = __builtin_amdgcn_mfma_f32_16x16x32_bf16(__builtin_bit_cast(bf16x8, avr[ks][nt]), ba, o[nt], 0, 0, 0);
                o[nt] = __builtin_amdgcn_mfma_f32_16x16x32_bf16(__builtin_bit_cast(bf16x8, asr[dir][ks][nt]), bq, o[nt], 0, 0, 0);
            }
        }
    }
    { float ss = 0.f;
#pragma unroll
      for (int nt = 0; nt < 4; ++nt) ss += o[nt][0] * o[nt][0] + o[nt][1] * o[nt][1] + o[nt][2] * o[nt][2] + o[nt][3] * o[nt][3];
      ss += __shfl_xor(ss, 16); ss += __shfl_xor(ss, 32);
      if (lq == 0) ssq[(tt * 16 + lr) * 2 + (wave >> 2)] = ss; }
    __syncthreads();
    const int t = tt * 16 + lr;
    const float r = rsqrtf((ssq[t * 2] + ssq[t * 2 + 1]) * (1.0f / 128.0f) + EPS);
    bf16_t* oc = (bf16_t*)(c.ws() + WS_OCAT) + (row0 + t) * 1024 + 512 + hh * 128;
#pragma unroll
    for (int nt = 0; nt < 4; ++nt) { const int v0 = (vb + nt) * 16 + lq * 4; const U2 og = ogr[nt]; const f32x4 g4 = g4r[nt];
        const float g0 = bf2f((bf16_t)(og.x & 0xFFFF)), g1 = bf2f((bf16_t)(og.x >> 16)), g2 = bf2f((bf16_t)(og.y & 0xFFFF)), g3 = bf2f((bf16_t)(og.y >> 16));
        U2 w; w.x = pack2(o[nt][0] * r * g4[0] * siluf_(g0), o[nt][1] * r * g4[1] * siluf_(g1)); w.y = pack2(o[nt][2] * r * g4[2] * siluf_(g2), o[nt][3] * r * g4[3] * siluf_(g3));
        *(U2*)(oc + v0) = w; }
}

struct ProbMerge {
    static constexpr bool PERM = true, GATHER = false;
    const char* A; const char* Bt; const bf16_t* Z; bf16_t* Y; int G, c, lat_only;
    DEV int row0(const g8::Unit& u) const { return lat_only ? lat_unit_row0(u.pm) : u.pm * 256; }
    DEV bool next(int i, g8::Unit& u) const { const int it = i >> 2, L = it * G + c; const int nM = lat_only ? BATCH * (SEQ / 256) : MTOT / 256;
        if (L >= nM * (D / 256)) return false; g8::order_map(L, nM, D / 256, u.pm, u.pn); u.aux = i & 3; u.idx = i; return true; }
    DEV int koff(const g8::Unit& u) const { return u.aux * 256; }
    DEV const char* a_base(const g8::Unit& u) const { return A + ((size_t)row0(u) * 1024 + koff(u)) * 2; }
    DEV const char* b_base(const g8::Unit& u) const { return Bt + ((size_t)u.pn * 256 * 1024 + koff(u)) * 2; }
    DEV int nt(const g8::Unit&) const { return 4; }
    DEV void prologue(LDSP unsigned char*) const {}
    DEV unsigned a_voff(LDSP unsigned char*, const g8::Unit&, int h, int R, int C) const { return (unsigned)((h * 128 + R) * 1024 + C) * 2u; }
    DEV unsigned ldb() const { return 1024 * 2; }
    DEV bool keep_acc(const g8::Unit& u) const { return u.aux < 3; }
    DEV void epi(g8::Acc& acc, const g8::Unit& u, int wr, int wc, int fr, int fq) const {
        if (u.aux == 2) return;
        const int r0 = row0(u) + wr * 64 + fr, c0 = u.pn * 256 + wc * 32 + fq * 8;
        const unsigned char* zb = (const unsigned char*)Z + (size_t)r0 * ZS * 2 + (size_t)ZMA * 2 + c0;
        if (u.aux < 2) {
            const unsigned char* zs = zb + u.aux * D;
#pragma unroll
            for (int ai = 0; ai < 2; ++ai) {
                U2 g0[4][2], g1[4][2];
#pragma unroll
                for (int m = 0; m < 4; ++m)
#pragma unroll
                    for (int bj = 0; bj < 2; ++bj) { const unsigned char* zp = zs + (size_t)(ai * 128 + m * 16) * ZS * 2 + bj * 128; g0[m][bj] = *(const U2*)zp; g1[m][bj] = *(const U2*)(zp + D); }
                G8_SCHED;
#pragma unroll
                for (int m = 0; m < 4; ++m)
#pragma unroll
                    for (int bj = 0; bj < 2; ++bj)
#pragma unroll
                        for (int n = 0; n < 2; ++n)
#pragma unroll
                            for (int j = 0; j < 4; ++j) { const uint32_t wa = n == 0 ? g0[m][bj].x : g0[m][bj].y, wb = n == 0 ? g1[m][bj].x : g1[m][bj].y;
                                acc[ai][bj][m][n][j] *= u8f(wa, j) * fast_rcp(u8f(wb, j)); }
            }
        } else {
            const unsigned char* zs = zb + 2 * D;
#pragma unroll
            for (int ai = 0; ai < 2; ++ai) {
                U2 g0[4][2];
#pragma unroll
                for (int m = 0; m < 4; ++m)
#pragma unroll
                    for (int bj = 0; bj < 2; ++bj) g0[m][bj] = *(const U2*)(zs + (size_t)(ai * 128 + m * 16) * ZS * 2 + bj * 128);
                G8_SCHED;
#pragma unroll
                for (int m = 0; m < 4; ++m)
#pragma unroll
                    for (int bj = 0; bj < 2; ++bj) { float o[8];
#pragma unroll
                        for (int n = 0; n < 2; ++n)
#pragma unroll
                            for (int j = 0; j < 4; ++j) o[n * 4 + j] = acc[ai][bj][m][n][j] * (u8f(n == 0 ? g0[m][bj].x : g0[m][bj].y, j) * (1.0f / 256.0f));
                        U4 w; w.x = cvt_pk_bf16(o[0], o[1]); w.y = cvt_pk_bf16(o[2], o[3]); w.z = cvt_pk_bf16(o[4], o[5]); w.w = cvt_pk_bf16(o[6], o[7]);
                        *(U4*)(Y + (size_t)(r0 + ai * 128 + m * 16) * D + c0 + bj * 128) = w; }
            }
        }
    }
};
struct ProbWout {
    static constexpr bool PERM = true, GATHER = false;
    const char* A; const char* Bt; Ctx cx; int G, c, lat_only;
    DEV int row0(const g8::Unit& u) const { return lat_only ? lat_unit_row0(u.pm) : u.pm * 256; }
    DEV bool next(int i, g8::Unit& u) const { const int L = i * G + c; const int nM = lat_only ? BATCH * (SEQ / 256) : MTOT / 256;
        if (L >= nM * (D / 256)) return false; g8::order_map(L, nM, D / 256, u.pm, u.pn); u.aux = 0; u.idx = i; return true; }
    DEV const char* a_base(const g8::Unit& u) const { return A + (size_t)row0(u) * D * 2; }
    DEV const char* b_base(const g8::Unit& u) const { return Bt + (size_t)u.pn * 256 * D * 2; }
    DEV int nt(const g8::Unit&) const { return D / 64; }
    DEV void prologue(LDSP unsigned char*) const {}
    DEV unsigned a_voff(LDSP unsigned char*, const g8::Unit&, int h, int R, int C) const { return (unsigned)((h * 128 + R) * D + C) * 2u; }
    DEV unsigned ldb() const { return D * 2; }
    DEV bool keep_acc(const g8::Unit&) const { return false; }
    DEV void epi(g8::Acc& acc, const g8::Unit& u, int wr, int wc, int fr, int fq) const {
        const int rbase = row0(u), b = rbase / NTOK, pb = rbase % NTOK;
        const int cof = u.pn * 256 + wc * 32 + fq * 8;
        const float* gate = cx.mod(cx.layer, pb < CTX_LEN ? BATCH : b) + 2 * D + cof;
        f32x4 gv[2][2];
#pragma unroll
        for (int bj = 0; bj < 2; ++bj)
#pragma unroll
            for (int n = 0; n < 2; ++n) gv[bj][n] = *(const f32x4*)(gate + bj * 128 + n * 4);
        bf16_t* xb = (bf16_t*)(cx.ws() + WS_XB) + (size_t)(rbase + wr * 64 + fr) * D + cof;
        if (cx.layer == 0) {
            const float* xin = xin_row(cx, rbase + wr * 64 + fr) + cof;
#pragma unroll
            for (int ai = 0; ai < 2; ++ai) {
                f32x4 xv[4][2][2];
#pragma unroll
                for (int m = 0; m < 4; ++m)
#pragma unroll
                    for (int bj = 0; bj < 2; ++bj)
#pragma unroll
                        for (int n = 0; n < 2; ++n) xv[m][bj][n] = *(const f32x4*)(xin + (size_t)(ai * 128 + m * 16) * D + bj * 128 + n * 4);
                G8_SCHED;
#pragma unroll
                for (int m = 0; m < 4; ++m)
#pragma unroll
                    for (int bj = 0; bj < 2; ++bj) { const f32x4 o0 = xv[m][bj][0] + gv[bj][0] * acc[ai][bj][m][0], o1 = xv[m][bj][1] + gv[bj][1] * acc[ai][bj][m][1];
                        U4 w; w.x = cvt_pk_bf16(o0[0], o0[1]); w.y = cvt_pk_bf16(o0[2], o0[3]); w.z = cvt_pk_bf16(o1[0], o1[1]); w.w = cvt_pk_bf16(o1[2], o1[3]);
                        *(U4*)(xb + (size_t)(ai * 128 + m * 16) * D + bj * 128) = w; }
            }
        } else {
#pragma unroll
            for (int ai = 0; ai < 2; ++ai) {
                U4 xr[4][2];
#pragma unroll
                for (int m = 0; m < 4; ++m)
#pragma unroll
                    for (int bj = 0; bj < 2; ++bj) xr[m][bj] = *(const U4*)(xb + (size_t)(ai * 128 + m * 16) * D + bj * 128);
                G8_SCHED;
#pragma unroll
                for (int m = 0; m < 4; ++m)
#pragma unroll
                    for (int bj = 0; bj < 2; ++bj) { float o[8];
#pragma unroll
                        for (int q = 0; q < 4; ++q) { o[2 * q] = bf2f((bf16_t)(xr[m][bj][q] & 0xFFFF)) + gv[bj][q >> 1][(q & 1) * 2] * acc[ai][bj][m][q >> 1][(q & 1) * 2];
                            o[2 * q + 1] = bf2f((bf16_t)(xr[m][bj][q] >> 16)) + gv[bj][q >> 1][(q & 1) * 2 + 1] * acc[ai][bj][m][q >> 1][(q & 1) * 2 + 1]; }
                        U4 w; w.x = cvt_pk_bf16(o[0], o[1]); w.y = cvt_pk_bf16(o[2], o[3]); w.z = cvt_pk_bf16(o[4], o[5]); w.w = cvt_pk_bf16(o[6], o[7]);
                        *(U4*)(xb + (size_t)(ai * 128 + m * 16) * D + bj * 128) = w; }
            }
        }
    }
};
DEV void p8_load_router(const Ctx& c) {
    float* w = (float*)c.smem; const float* src = c.in(I_ROUTER) + (size_t)c.layer * D * NE;
    __syncthreads();
    { constexpr int NQ = (D * NE / 4 + NTHR - 1) / NTHR; f32x4 rv[NQ];
#pragma unroll
      for (int q = 0; q < NQ; ++q) { const int i = (ltid() + q * NTHR) * 4; rv[q] = *(const f32x4*)(src + (i < D * NE ? i : 0)); }
#pragma unroll
      for (int q = 0; q < NQ; ++q) { const int i = (ltid() + q * NTHR) * 4; if (i < D * NE) { const int k = i / NE, e4 = (i % NE) >> 2; *(f32x4*)(w + ((size_t)(e4 * 4 + (k & 3)) * (D / 4) + (k >> 2)) * 4) = rv[q]; } } }
    __syncthreads();
}
DEV void p8_norm2_row(const Ctx& c, int grow) {
    const int lane = ltid() & 63, l = c.layer;
    const int b = grow / NTOK, p = grow % NTOK;
    const float* md = c.mod(l, p < CTX_LEN ? BATCH : b);
    const float* g = c.in(I_NORM2) + l * D;
    const float* wr = (const float*)c.smem;
    static_assert(NE == 16 || NE == 4, "router butterfly");
    f32x4 xv[NV], gv[NV], scv[NV], shv[NV]; float ss = 0.f;
    xb_load(c, grow, xv);
#pragma unroll
    for (int i = 0; i < NV; ++i) { const int cc = lane * 4 + i * 256; gv[i] = *(const f32x4*)(g + cc); scv[i] = *(const f32x4*)(md + 4 * D + cc); shv[i] = *(const f32x4*)(md + 3 * D + cc); }
#pragma unroll
    for (int i = 0; i < NV; ++i) { ss += xv[i][0] * xv[i][0] + xv[i][1] * xv[i][1] + xv[i][2] * xv[i][2] + xv[i][3] * xv[i][3]; }
    ss = wave_sum(ss);
    const float r = rsqrtf(ss / D + EPS);
    bf16_t* h = (bf16_t*)(c.ws() + WS_OCAT) + (size_t)grow * D;
    float lg[NE];
#pragma unroll
    for (int e = 0; e < NE; ++e) lg[e] = 0.f;
#pragma unroll
    for (int i = 0; i < NV; ++i) { const int cc = lane * 4 + i * 256; float o[4];
        const f32x4 gg = gv[i], sc = scv[i], sh = shv[i];
#pragma unroll
        for (int k = 0; k < 4; ++k) { o[k] = xv[i][k] * r * gg[k] * (1.f + sc[k]) + sh[k];
#pragma unroll
            for (int e4 = 0; e4 < NE / 4; ++e4) { const f32x4 w4 = *(const f32x4*)(wr + ((size_t)(e4 * 4 + k) * (D / 4) + (cc >> 2)) * 4);
#pragma unroll
                for (int q = 0; q < 4; ++q) lg[e4 * 4 + q] += o[k] * w4[q]; } }
        U2 pk; pk.x = pack2(o[0], o[1]); pk.y = pack2(o[2], o[3]); *(U2*)(h + cc) = pk; }
    float v8[8], v4[4], v2[2], v1;
    if (NE == 16) {
#pragma unroll
        for (int q = 0; q < 8; ++q) { const bool hi = (lane & 32) != 0; const float keep = hi ? lg[q + 8] : lg[q], give = hi ? lg[q] : lg[q + 8]; v8[q] = keep + __shfl_xor(give, 32); }
#pragma unroll
        for (int q = 0; q < 4; ++q) { const bool hi = (lane & 16) != 0; const float keep = hi ? v8[q + 4] : v8[q], give = hi ? v8[q] : v8[q + 4]; v4[q] = keep + __shfl_xor(give, 16); }
    } else {
#pragma unroll
        for (int q = 0; q < 4; ++q) { float t = lg[q % NE]; t += __shfl_xor(t, 32); t += __shfl_xor(t, 16); v4[q] = t; }
    }
#pragma unroll
    for (int q = 0; q < 2; ++q) { const bool hi = (lane & 8) != 0; const float keep = hi ? v4[q + 2] : v4[q], give = hi ? v4[q] : v4[q + 2]; v2[q] = keep + __shfl_xor(give, 8); }
    { const bool hi = (lane & 4) != 0; const float keep = hi ? v2[1] : v2[0], give = hi ? v2[0] : v2[1]; v1 = keep + __shfl_xor(give, 4); }
    v1 += __shfl_xor(v1, 2); v1 += __shfl_xor(v1, 1);
    const int eh = (NE == 16) ? (((lane >> 5) & 1) * 8 + ((lane >> 4) & 1) * 4 + ((lane >> 3) & 1) * 2 + ((lane >> 2) & 1)) : (((lane >> 3) & 1) * 2 + ((lane >> 2) & 1));
    float mx = v1;
    mx = fmaxf(mx, __shfl_xor(mx, 4)); mx = fmaxf(mx, __shfl_xor(mx, 8));
    if (NE == 16) { mx = fmaxf(mx, __shfl_xor(mx, 16)); mx = fmaxf(mx, __shfl_xor(mx, 32)); }
    const float ex = expf(v1 - mx);
    float sum = ex; sum += __shfl_xor(sum, 4); sum += __shfl_xor(sum, 8);
    if (NE == 16) { sum += __shfl_xor(sum, 16); sum += __shfl_xor(sum, 32); }
    const bool writer = (lane & 3) == 0 && (NE == 16 || lane < 16);
    if (writer) { ((float*)(c.ws() + WS_AFF))[(size_t)grow * NE + eh] = ex / sum; ((int*)(c.ws() + WS_INV))[(size_t)grow * NE + eh] = -1; }
}
DEV void p9_topk_item(const Ctx& c, int set, int b, int e) {
    unsigned* key = (unsigned*)c.smem;
    unsigned* hist = key + 2048;
    unsigned* misc = hist + 256;
    const int tid = ltid(), lane = tid & 63, wv = tid >> 6;
    const int n = set == 0 ? SEQ : CTX_LEN, cap = set == 0 ? CAPL : CAPC, p0 = set == 0 ? CTX_LEN : 0;
    static_assert(SEQ <= 2048 && CTX_LEN <= 2048, "topk buffer");
    const float* aff = (const float*)(c.ws() + WS_AFF) + ((size_t)b * NTOK + p0) * NE + e;
    __syncthreads();
    { unsigned kv[2048 / NTHR];
#pragma unroll
      for (int q = 0; q < 2048 / NTHR; ++q) { const int i = tid + q * NTHR; kv[q] = __builtin_bit_cast(unsigned, aff[(size_t)(i < n ? i : n - 1) * NE]); }
#pragma unroll
      for (int q = 0; q < 2048 / NTHR; ++q) { const int i = tid + q * NTHR; key[i] = i < n ? kv[q] : 0u; } }
    if (tid == 0) { misc[0] = 0u; misc[1] = (unsigned)cap; }
    __syncthreads();
    unsigned kk[4];
#pragma unroll
    for (int q = 0; q < 4; ++q) kk[q] = key[tid * 4 + q];
#pragma unroll 1
    for (int pass = 0; pass < 4; ++pass) {
        const int shift = 24 - 8 * pass; const unsigned mask = pass == 0 ? 0u : (0xFFFFFFFFu << (shift + 8));
        if (tid < 256) hist[tid] = 0u;
        __syncthreads();
        const unsigned prefix = misc[0];
#pragma unroll
        for (int q = 0; q < 4; ++q) if (tid * 4 + q < n && (kk[q] & mask) == prefix) atomicAdd(&hist[(kk[q] >> shift) & 255u], 1u);
        __syncthreads();
        if (tid < 64) {
            const unsigned rem = misc[1];
            const unsigned h0 = hist[tid * 4], h1 = hist[tid * 4 + 1], h2 = hist[tid * 4 + 2], h3 = hist[tid * 4 + 3];
            const unsigned own = h0 + h1 + h2 + h3; unsigned suf = own;
#pragma unroll
            for (int dd = 1; dd < 64; dd <<= 1) { const unsigned o2 = __shfl_down(suf, dd); if (lane + dd < 64) suf += o2; }
            const unsigned ab3 = suf - own, ab2 = ab3 + h3, ab1 = ab2 + h2, ab0 = ab1 + h1;
            int bsel = -1; unsigned above = 0u;
            if (ab3 < rem && ab3 + h3 >= rem) { bsel = tid * 4 + 3; above = ab3; }
            else if (ab2 < rem && ab2 + h2 >= rem) { bsel = tid * 4 + 2; above = ab2; }
            else if (ab1 < rem && ab1 + h1 >= rem) { bsel = tid * 4 + 1; above = ab1; }
            else if (ab0 < rem && ab0 + h0 >= rem) { bsel = tid * 4; above = ab0; }
            if (bsel >= 0) { misc[0] = prefix | ((unsigned)bsel << shift); misc[1] = rem - above; }
        }
        __syncthreads();
    }
    const unsigned T = misc[0], need_eq = misc[1];
    unsigned cg = 0, ce = 0;
#pragma unroll
    for (int q = 0; q < 4; ++q) { const bool v = tid * 4 + q < n; cg += (v && kk[q] > T) ? 1u : 0u; ce += (v && kk[q] == T) ? 1u : 0u; }
    unsigned sg = cg, se = ce;
#pragma unroll
    for (int d = 1; d < 64; d <<= 1) { const unsigned a = __shfl_up(sg, d), bq = __shfl_up(se, d); if (lane >= d) { sg += a; se += bq; } }
    if (lane == 63) { misc[8 + wv] = sg; misc[16 + wv] = se; }
    __syncthreads();
    unsigned og = 0, oe = 0;
    for (int w = 0; w < wv; ++w) { og += misc[8 + w]; oe += misc[16 + w]; }
    unsigned pg = og + sg - cg, pe = oe + se - ce;
    int* rmap = (int*)(c.ws() + WS_RMAP) + (size_t)e * RPE + (set == 0 ? b * CAPL : RPE_L + b * CAPC);
    float* slw = (float*)(c.ws() + WS_SLW) + (size_t)e * RPE + (set == 0 ? b * CAPL : RPE_L + b * CAPC);
    int* inv = (int*)(c.ws() + WS_INV);
#pragma unroll
    for (int q = 0; q < 4; ++q) { const int i = tid * 4 + q; if (i < n) {
        const bool gt = kk[q] > T, eq = kk[q] == T; const bool sel = gt || (eq && pe < need_eq);
        if (sel) { const int slot = (int)(pg + (pe < need_eq ? pe : need_eq)); const int tok = b * NTOK + p0 + i;
            rmap[slot] = tok; slw[slot] = __builtin_bit_cast(float, kk[q]); inv[(size_t)tok * NE + e] = e * RPE + (set == 0 ? b * CAPL : RPE_L + b * CAPC) + slot; }
        pg += gt ? 1u : 0u; pe += eq ? 1u : 0u; } }
}
struct ProbMoe1 {
    static constexpr bool PERM = true, GATHER = true;
    static constexpr int MAXU = 12;
    const char* A; const char* Bt; const int* rmap; bf16_t* hid; int G, c, nMe;
    DEV bool next(int i, g8::Unit& u) const { const int L = i * G + c; if (L >= NE * nMe * (2 * FF / 256)) return false; int pmt; g8::order_map(L, NE * nMe, 2 * FF / 256, pmt, u.pn); u.aux = pmt / nMe; u.pm = pmt % nMe; u.idx = i; return true; }
    DEV const char* a_base(const g8::Unit&) const { return A; }
    DEV const char* b_base(const g8::Unit& u) const { return Bt + ((size_t)u.aux * 2 * FF + u.pn * 256) * D * 2; }
    DEV int nt(const g8::Unit&) const { return D / 64; }
    DEV void prologue(LDSP unsigned char* lds) const {
        LDSP unsigned* tab = (LDSP unsigned*)(lds + g8::STAGE_BYTES); g8::Unit u;
        for (int i = 0; i < MAXU && next(i, u); ++i) for (int t = ltid(); t < 256; t += NTHR) tab[i * 256 + t] = (unsigned)rmap[(size_t)u.aux * RPE + u.pm * 256 + t] * (unsigned)(D * 2);
        __syncthreads();
    }
    DEV unsigned a_voff(LDSP unsigned char* lds, const g8::Unit& u, int h, int R, int C) const { return ((const LDSP unsigned*)(lds + g8::STAGE_BYTES))[u.idx * 256 + h * 128 + R] + (unsigned)C * 2u; }
    DEV unsigned ldb() const { return D * 2; }
    DEV bool keep_acc(const g8::Unit&) const { return false; }
    DEV void epi(g8::Acc& acc, const g8::Unit& u, int wr, int wc, int fr, int fq) const {
        bf16_t* base = hid + ((size_t)u.aux * RPE + u.pm * 256 + wr * 64 + fr) * FF + (u.pn * 256 + wc * 32 + fq * 8) / 2;
#pragma unroll
        for (int ai = 0; ai < 2; ++ai)
#pragma unroll
            for (int m = 0; m < 4; ++m)
#pragma unroll
                for (int bj = 0; bj < 2; ++bj) { const f32x4 g = acc[ai][bj][m][0], uu = acc[ai][bj][m][1]; U2 w;
                    w.x = cvt_pk_bf16(siluf_(g[0]) * uu[0], siluf_(g[1]) * uu[1]); w.y = cvt_pk_bf16(siluf_(g[2]) * uu[2], siluf_(g[3]) * uu[3]);
                    *(U2*)(base + (size_t)(ai * 128 + m * 16) * FF + bj * 64) = w; }
    }
};
struct ProbMoe2 {
    static constexpr bool PERM = true, GATHER = false;
    const char* A; const char* Bt; const float* slw; bf16_t* ye; int G, c, nMe;
    DEV bool next(int i, g8::Unit& u) const { const int L = i * G + c; if (L >= NE * nMe * (D / 256)) return false; int pmt; g8::order_map(L, NE * nMe, D / 256, pmt, u.pn); u.aux = pmt / nMe; u.pm = pmt % nMe; u.idx = i; return true; }
    DEV const char* a_base(const g8::Unit& u) const { return A + ((size_t)u.aux * RPE + u.pm * 256) * FF * 2; }
    DEV const char* b_base(const g8::Unit& u) const { return Bt + ((size_t)u.aux * D + u.pn * 256) * FF * 2; }
    DEV int nt(const g8::Unit&) const { return FF / 64; }
    DEV void prologue(LDSP unsigned char*) const {}
    DEV unsigned a_voff(LDSP unsigned char*, const g8::Unit&, int h, int R, int C) const { return (unsigned)((h * 128 + R) * FF + C) * 2u; }
    DEV unsigned ldb() const { return FF * 2; }
    DEV bool keep_acc(const g8::Unit&) const { return false; }
    DEV void epi(g8::Acc& acc, const g8::Unit& u, int wr, int wc, int fr, int fq) const {
        const size_t r0 = (size_t)u.aux * RPE + u.pm * 256 + wr * 64 + fr;
        bf16_t* base = ye + r0 * D + u.pn * 256 + wc * 32 + fq * 8;
        float wv[2][4];
#pragma unroll
        for (int ai = 0; ai < 2; ++ai)
#pragma unroll
            for (int m = 0; m < 4; ++m) wv[ai][m] = slw[r0 + ai * 128 + m * 16];
        G8_SCHED;
#pragma unroll
        for (int ai = 0; ai < 2; ++ai)
#pragma unroll
            for (int m = 0; m < 4; ++m) { const float w8 = wv[ai][m];
#pragma unroll
                for (int bj = 0; bj < 2; ++bj) { U4 w; w.x = cvt_pk_bf16(acc[ai][bj][m][0][0] * w8, acc[ai][bj][m][0][1] * w8); w.y = cvt_pk_bf16(acc[ai][bj][m][0][2] * w8, acc[ai][bj][m][0][3] * w8);
                    w.z = cvt_pk_bf16(acc[ai][bj][m][1][0] * w8, acc[ai][bj][m][1][1] * w8); w.w = cvt_pk_bf16(acc[ai][bj][m][1][2] * w8, acc[ai][bj][m][1][3] * w8);
                    *(U4*)(base + (size_t)(ai * 128 + m * 16) * D + bj * 128) = w; } }
    }
};
DEV void pf_final_row(const Ctx& c, int lrow) {
    const int lane = ltid() & 63;
    float* x = c.out() + (size_t)lrow * D; const float* g = c.in(I_FNORM);
    const int grow = (lrow / SEQ) * NTOK + CTX_LEN + lrow % SEQ;
    f32x4 xv[NV];
    xb_load(c, grow, xv);
    f32x4 gv[NV];
#pragma unroll
    for (int i = 0; i < NV; ++i) gv[i] = *(const f32x4*)(g + lane * 4 + i * 256);
    moe_combine_regs(c, grow, DEPTH - 1, xv);
    float ss = 0.f;
#pragma unroll
    for (int i = 0; i < NV; ++i) ss += xv[i][0] * xv[i][0] + xv[i][1] * xv[i][1] + xv[i][2] * xv[i][2] + xv[i][3] * xv[i][3];
    ss = wave_sum(ss);
    const float r = rsqrtf(ss / D + EPS);
#pragma unroll
    for (int i = 0; i < NV; ++i) NT_STORE4(x + lane * 4 + i * 256, xv[i] * r * gv[i]);
}

constexpr bool DEFER_PREP = DEPTH > 1;
constexpr bool CTX_ITEMS_LATE = true;
constexpr int PH_PER_LAYER = 11, N_PHASES = 1 + DEPTH * PH_PER_LAYER + 1;
__global__ void __launch_bounds__(NTHR) mk_forward(Params prm) {
#ifdef EMU
    char* smem = emu_lds();
#else
    extern __shared__ __attribute__((aligned(16))) char smem[];
#endif
    Ctx c; c.smem = smem; c.layer = 0;
    const int bid = blockIdx.x, G = gridDim.x, tid = threadIdx.x;
#define wave (ltid() >> 6)
    const int lo = prm.ph_lo, hi = prm.ph_hi;
#ifdef EMU
    emu_params = prm;
#endif
#ifdef EMU
#define GRID_BAR() emu_grid_sync()
#else
    XcdBarrier bar; bar.bar = (unsigned*)(prm.ws + WS_BAR); bar.x = 0; bar.st = nullptr;
    if (hi - lo > 1) {
        if (tid < 4) ((volatile LAS unsigned*)(smem + LDS_MISC))[tid] = 0u;
        __syncthreads();
        bar = xcd_barrier_post((unsigned*)(prm.ws + WS_BAR), (volatile LAS unsigned*)(smem + LDS_MISC));
    }
#define GRID_BAR() xcd_barrier(bar)
#endif
#ifdef PH_ONLY
#define PHSEL(j) ((j) == PH_ONLY)
#elif defined(PH_SKIP)
#define PHSEL(j) ((j) != PH_SKIP)
#else
#define PHSEL(j) true
#endif
#ifndef PROBE_PHASE
#define PROBE_PHASE -1
#endif
#ifndef PROBE_REPS
#define PROBE_REPS 1
#endif
#ifndef PROBE_L0
#define PROBE_L0 0
#endif
#define REPS(j) for (int rep_ = 0; rep_ < (((j) == PROBE_PHASE && (!PROBE_L0 || c.layer == 0)) ? PROBE_REPS : 1); ++rep_)
#ifndef PROBE_SUB
#define PROBE_SUB -1
#endif
#define SUBREP(id) for (int srep_ = 0; srep_ < (((id) == PROBE_SUB && (!PROBE_L0 || c.layer == 0)) ? PROBE_REPS : 1); ++srep_)
#define IN(k) (lo <= (k) && (k) < hi)
#ifndef PROBE_BAR
#define PROBE_BAR 0
#endif
#define SEAM(k) do { if (IN(k) && IN((k) + 1)) { GRID_BAR(); for (int pb_ = 0; pb_ < PROBE_BAR; ++pb_) GRID_BAR(); } } while (0)
#define pl ((bf16_t*)(smem + wave * (16 * GS * 2)))

    if (PHSEL(100) && IN(0)) REPS(100) {
        const int n_mod = (DEFER_PREP ? 1 : DEPTH) * (D6 / 64), n_cw = DEPTH * CW_PER_LAYER;
        for (int it = bid; it < n_mod + n_cw + DEPTH; it += G) { if (it < n_mod) p0_mod_item(c, it); else if (it < n_mod + n_cw) p0_convw_item(c, it - n_mod); else p0_gatew_item(c, it - n_mod - n_cw); }
        { PrepJobFn f; f.c = &c; const int nmodb = n_mod < G ? n_mod : 0;
          conv_range(c, f, 0, (DEFER_PREP ? 1 : DEPTH) * PJ_PER_L, bid >= nmodb ? bid - nmodb : G - nmodb + bid, G); }
    }
    SEAM(0);
    for (int l = 0; l < DEPTH; ++l) {
        c.layer = l;
        const int P = 1 + l * PH_PER_LAYER;
        const bool ctxo = (l < DEPTH - 1);
        const int mt_n = ctxo ? MT_ALL : MT_LAT;
        if (PHSEL(0) && IN(P + 0)) REPS(0) { for (int it = bid; it < MTOT / 8; it += G) p1_norm_row(c, it * 8 + wave); }
        SEAM(P + 0);
        if (PHSEL(1) && IN(P + 1)) REPS(1) { ProbInproj pr; pr.A = c.ws() + WS_H; pr.Bt = c.ws() + WS_WIN + (size_t)l * NIN * D * 2; pr.Z = (bf16_t*)(c.ws() + WS_Z); pr.navt = (bf16_t*)(c.ws() + WS_NAVT); pr.gvt = (bf16_t*)(c.ws() + WS_GVT); pr.G = G; pr.c = bid; pr.lastl = ctxo ? 0 : 1;
            g8::gemm_phase((LDSP unsigned char*)smem, pr);
        }
        SEAM(P + 1);
        if (PHSEL(2) && IN(P + 2)) REPS(2) {
            const int n_q = mt_n * 3, n_kv = MT_ALL * 4, n_g1 = G1_ITEMS, n_na = NA_LAT_ITEMS + ((ctxo && !CTX_ITEMS_LATE) ? NA_CTX_ITEMS : 0), n_kr = MTOT / 16;
            const int tot = n_g1 + n_q + n_kv + n_na + n_kr;
            int it = bid;
            for (; it < n_na; it += G) { SUBREP(23) p3_na_item(c, it); }
            if (it < n_na + n_g1) { SUBREP(20) p3_gla_g1_range(c, it - n_na, n_g1, G); it += ((n_na + n_g1 - 1 - it) / G + 1) * G; }
            { const int e = n_na + n_g1 + n_q; if (it < e) { SUBREP(21) p3_up_range<true>(c, it - (e - n_q), n_q, G, ctxo); it += ((e - 1 - it) / G + 1) * G; } }
            {
                constexpr int KRMAX = 6; const int kbase = n_na + n_g1 + n_q + n_kv; bf16_t zj[KRMAX], zo[KRMAX];
                const int itk = it < kbase ? it + ((kbase - 1 - it) / G + 1) * G : it;
#define KR_LOAD(it0) _Pragma("unroll") for (int q = 0; q < KRMAX; ++q) { const int itq = (it0) + q * G; const int item = (itq < tot ? itq : (it0) < tot ? (it0) : kbase) - kbase; \
                        const bf16_t* z = (const bf16_t*)(c.ws() + WS_Z) + (size_t)(item * 16 + (ltid() >> 5)) * D_IN_PAD + ZKR; zj[q] = z[ltid() & 31]; zo[q] = z[(ltid() & 31) ^ 16]; }
                KR_LOAD(itk)
                { const int e = kbase; if (it < e) { SUBREP(22) p3_up_range<false>(c, it - (e - n_kv), n_kv, G, ctxo); it += ((e - 1 - it) / G + 1) * G; } }
                while (it < tot) {
#pragma unroll
                    for (int q = 0; q < KRMAX; ++q) { const int itq = it + q * G; if (itq < tot) p3_krope_item(c, itq - kbase, zj[q], zo[q]); }
                    it += KRMAX * G;
                    if (it < tot) { KR_LOAD(it) }
                }
#undef KR_LOAD
            }
        }
        SEAM(P + 2);
        if (PHSEL(3) && IN(P + 3)) REPS(3) {
            const int n_g2 = G2_ITEMS, n_att = MLA_LAT_ITEMS + ((ctxo && !CTX_ITEMS_LATE) ? MLA_CTX_ITEMS : 0);
            for (int it = bid; it < n_g2 + n_att; it += G) {
                if (it < n_g2) { SUBREP(30) p4_gla_g2_item(c, it); continue; }
                SUBREP(31) p4_mla_item(c, it - n_g2);
            }
        }
        SEAM(P + 3);
        if (PHSEL(4) && IN(P + 4)) REPS(4) {
            const int chs = ctxo ? NCH : (NCH - NCC);
            const int n3 = BATCH * 4 * chs, ch0 = ctxo ? 0 : NCC;
            if (bid < n3) {
                int it = bid;
                G3Pre cur = g3_prefetch(c, it / chs / 4, (it / chs) & 3, (it % chs) + ch0);
                for (;;) {
                    const int itn = it + G; const bool more = itn < n3; const int ix = more ? itn : it;
                    G3Pre nxt; p5_gla_g3_body(c, it / chs / 4, (it / chs) & 3, (it % chs) + ch0, cur, ix / chs / 4, (ix / chs) & 3, (ix % chs) + ch0, nxt);
                    if (!more) break;
                    SCHED_FENCE();
                    cur = nxt; it = itn;
                }
            }
            if (CTX_ITEMS_LATE && ctxo) {
                const int nx = n3 % G, nb = G - nx, rk = bid >= nx ? bid - nx : nb;
                if (rk < nb) for (int it = rk; it < MLA_CTX_ITEMS + NA_CTX_ITEMS; it += nb) {
                    if (it < MLA_CTX_ITEMS) p4_mla_item(c, MLA_LAT_ITEMS + it); else p3_na_item(c, NA_LAT_ITEMS + (it - MLA_CTX_ITEMS)); }
            }
        }
        SEAM(P + 4);
        if (PHSEL(5) && IN(P + 5)) REPS(5) {
            { ProbMerge pr; pr.A = c.ws() + WS_OCAT; pr.Bt = c.ws() + WS_WBR + (size_t)l * D * 1024 * 2; pr.Z = (const bf16_t*)(c.ws() + WS_Z); pr.Y = (bf16_t*)(c.ws() + WS_H); pr.G = G; pr.c = bid; pr.lat_only = ctxo ? 0 : 1;
              SUBREP(50) g8::gemm_phase((LDSP unsigned char*)smem, pr); }
            { const int nu = (ctxo ? MTOT / 256 : BATCH * (SEQ / 256)) * (D / 256), dbl = nu % G;
              if (bid >= dbl) SUBREP(51) convexp_range(c, l, 0, CE_ITEMS / 2, bid - dbl, G - dbl); }
        }
        SEAM(P + 5);
        if (PHSEL(6) && IN(P + 6)) REPS(6) { ProbWout pr; pr.A = c.ws() + WS_H; pr.Bt = c.ws() + WS_WOUT + (size_t)l * D * D * 2; pr.cx = c; pr.G = G; pr.c = bid; pr.lat_only = ctxo ? 0 : 1;
            SUBREP(52) g8::gemm_phase((LDSP unsigned char*)smem, pr);
            { const int nu = (ctxo ? MTOT / 256 : BATCH * (SEQ / 256)) * (D / 256), dbl = nu % G;
              if (bid >= dbl) SUBREP(53) convexp_range(c, l, CE_ITEMS / 2, CE_ITEMS, bid - dbl, G - dbl); } }
        SEAM(P + 6);
        if (PHSEL(7) && IN(P + 7)) REPS(7) {
            p8_load_router(c);
            if (ctxo) { for (int it = bid; it < MTOT / 8; it += G) p8_norm2_row(c, it * 8 + wave); }
            else { for (int it = bid; it < BATCH * SEQ / 8; it += G) { const int lr = it * 8 + wave; p8_norm2_row(c, (lr / SEQ) * NTOK + CTX_LEN + lr % SEQ); } }
        }
        SEAM(P + 7);
        if (PHSEL(8) && IN(P + 8)) REPS(8) { const int tot = BATCH * NE * (ctxo ? 2 : 1); for (int it = bid; it < tot; it += G) { const int set = it / (BATCH * NE), r = it % (BATCH * NE); p9_topk_item(c, set, r / NE, r % NE); } }
        SEAM(P + 8);
        const int mt_e = (ctxo ? RPE : RPE_L) / 256;
        if (PHSEL(9) && IN(P + 9)) REPS(9) { ProbMoe1 pr; pr.A = c.ws() + WS_OCAT; pr.Bt = c.ws() + WS_EXP + EXP_WGU; pr.rmap = (const int*)(c.ws() + WS_RMAP); pr.hid = (bf16_t*)(c.ws() + WS_Z); pr.G = G; pr.c = bid; pr.nMe = mt_e;
            g8::gemm_phase((LDSP unsigned char*)smem, pr);
            if (DEFER_PREP && l == 0) {
                const int busy = (NE * mt_e * (2 * FF / 256)) % G;
                if (bid >= busy) { const int nid = G - busy, rk = bid - busy;
                    const int n_mod1 = (DEPTH - 1) * (D6 / 64);
                    for (int it = rk; it < n_mod1; it += nid) p0_mod_item(c, D6 / 64 + it); } } }
        SEAM(P + 9);
        if (PHSEL(10) && IN(P + 10)) REPS(10) { ProbMoe2 pr; pr.A = c.ws() + WS_Z; pr.Bt = c.ws() + WS_EXP + EXP_WD; pr.slw = (const float*)(c.ws() + WS_SLW); pr.ye = (bf16_t*)(c.ws() + WS_YE); pr.G = G; pr.c = bid; pr.nMe = mt_e;
            g8::gemm_phase((LDSP unsigned char*)smem, pr);
            if (DEFER_PREP && l == 0) {
                const int busy = (NE * mt_e * (D / 256)) % G;
                if (bid >= busy) { const int nid = G - busy, rk = bid - busy;
                    PrepJobFn f; f.c = &c; conv_range(c, f, PJ_PER_L, DEPTH * PJ_PER_L, rk, nid); } } }
        SEAM(P + 10);
    }
    if (PHSEL(101) && IN(N_PHASES - 1)) { for (int it = bid; it < BATCH * SEQ / 8; it += G) pf_final_row(c, it * 8 + wave); }
#undef wave
#undef pl
}

#ifdef EMU
static void emu_dump_map(FILE* f) {
    fprintf(f, "MOD %zu\nCCUR %zu\nH %zu\nZ %zu\nWIN %zu\nWUQ %zu\nWUKV %zu\nWBR %zu\nWOUT %zu\nEXP %zu\nMQ %zu\nMK %zu\nMVT %zu\nNAVT %zu\nGVT %zu\nOCAT %zu\nAFF %zu\nRMAP %zu\nSLW %zu\nTOTAL %zu\n",
            WS_MOD, WS_XB, WS_H, WS_Z, WS_WIN, WS_WUQ, WS_WUKV, WS_WBR, WS_WOUT, WS_EXP, WS_MQ, WS_MK, WS_MVT, WS_NAVT, WS_GVT, WS_OCAT, WS_AFF, WS_RMAP, WS_SLW, WS_TOTAL_BYTES);
    fprintf(f, "D_IN_PAD %d\nNTOK %d\nMTOT %d\nRPE %d\n", D_IN_PAD, NTOK, MTOT, RPE);
}
#endif

extern "C" void kernel_launch(void* const* d_in, const int* in_sizes, int n_in, void* d_out, int out_size, void* d_ws, size_t ws_size, hipStream_t stream) {
    Params p{};
    for (int i = 0; i < 28; ++i) p.in[i] = (const float*)d_in[i];
    p.out = (float*)d_out; p.ws = (char*)d_ws;
#ifdef EMU
    int emu_stop = N_PHASES; if (getenv("EMU_STOP")) emu_stop = atoi(getenv("EMU_STOP"));
    hipMemsetAsync((char*)d_ws + WS_BAR, 0, WS_BAR_BYTES, stream);
    if (getenv("EMU_ONE")) { p.ph_lo = 0; p.ph_hi = emu_stop; emu_launch(mk_forward, 3, NTHR, LDS_BYTES, p, true); }
    else for (int k = 0; k < emu_stop; ++k) { p.ph_lo = k; p.ph_hi = k + 1; emu_launch(mk_forward, 5, NTHR, LDS_BYTES, p, false); }
#else
    static int grid = 0;
    if (grid == 0) {
        if (n_in != 28 || out_size != BATCH * SEQ * D || ws_size < WS_TOTAL_BYTES) { fprintf(stderr, "kernel_launch: unexpected shapes (n_in %d out %d ws %zu need %zu)\n", n_in, out_size, ws_size, (size_t)WS_TOTAL_BYTES); grid = -1; return; }
        int dev = 0, cus = 0, per_cu = 0;
        hipGetDevice(&dev); hipDeviceGetAttribute(&cus, hipDeviceAttributeMultiprocessorCount, dev);
        hipFuncSetAttribute((const void*)mk_forward, hipFuncAttributeMaxDynamicSharedMemorySize, LDS_BYTES);
        hipOccupancyMaxActiveBlocksPerMultiprocessor(&per_cu, (const void*)mk_forward, NTHR, LDS_BYTES);
        if (per_cu < 1) { fprintf(stderr, "kernel_launch: occupancy query says %d blocks/CU\n", per_cu); grid = -1; return; }
        grid = cus;
    }
    if (grid < 0) return;
    hipMemsetAsync((char*)d_ws + WS_BAR, 0, WS_BAR_BYTES, stream);
#if MK_ONE_LAUNCH
    p.ph_lo = 0; p.ph_hi = N_PHASES;
    void* args[] = {&p};
    hipError_t e = hipLaunchCooperativeKernel((const void*)mk_forward, dim3(grid), dim3(NTHR), args, LDS_BYTES, stream);
    if (e != hipSuccess) fprintf(stderr, "cooperative launch failed: %s (grid %d)\n", hipGetErrorString(e), grid);
#else
    for (int k = 0; k < N_PHASES; ++k) { p.ph_lo = k; p.ph_hi = k + 1; hipLaunchKernelGGL(mk_forward, dim3(grid), dim3(NTHR), LDS_BYTES, stream, p); }
#endif
#endif
}
```
